# Optimizing an MI355X kernel written in HIP

```python
import math
import jax
import jax.numpy as jnp
from jax import lax
import numpy as np

D_MODEL = 1024
BATCH = 8
SEQ = 2048
DEPTH = 2

CTX_LEN = 256
GRID_W = 64
EPS = 1e-6
N_MOD = 6

D_RNN = 1024
RNN_BLOCKS = 8
RNN_BLOCK = D_RNN // RNN_BLOCKS
CONV_W = 4
LRU_C = 8.0

FOURIER_GROUPS = 8
FOURIER_GD = 128
D_FOURIER = FOURIER_GROUPS * FOURIER_GD

N_HEADS = 8
HEAD_DIM = 64
V_DIM = 2 * HEAD_DIM
D_ATTN = N_HEADS * V_DIM
ROPE_BASE = 10000.0
Q_BLOCK = 128

N_BRANCH = 3
D_MIX = D_RNN + D_FOURIER + D_ATTN
D_IN = 2 * D_RNN + D_FOURIER + 3 * D_ATTN
SPLITS = (D_RNN, 2 * D_RNN, 2 * D_RNN + D_FOURIER, 2 * D_RNN + D_FOURIER + D_ATTN, 2 * D_RNN + D_FOURIER + 2 * D_ATTN)
D_FF = ((8 * D_MODEL + 3 * 256 - 1) // (3 * 256)) * 256

kernel_name = 'hybrid_rglru_fourier_diffattn_dit'


def rmsnorm(x, g=None):
    xf = x.astype(jnp.float32)
    y = xf * lax.rsqrt(jnp.mean(xf * xf, axis=-1, keepdims=True) + EPS)
    if g is not None:
        y = y * g.astype(jnp.float32)
    return y.astype(x.dtype)


def adaln_params(cond, w, b):
    m = jax.nn.silu(cond) @ w + b
    return jnp.split(m[..., None, :], N_MOD, axis=-1)


def modulate(x, shift, scale):
    return rmsnorm(x) * (1 + scale) + shift


def dwconv_centred(x, w, b):
    n = x.shape[1]
    left = CONV_W // 2
    xp = jnp.pad(x, ((0, 0), (left, CONV_W - 1 - left), (0, 0)))
    out = xp[:, 0:n] * w[0]
    for k in range(1, CONV_W):
        out = out + xp[:, k:k + n] * w[k]
    return out + b


def block_diag_linear(x, w, b):
    xb = x.reshape(x.shape[:-1] + (RNN_BLOCKS, RNN_BLOCK))
    y = jnp.einsum('blgi,gij->blgj', xb, w.astype(jnp.float32))
    return y.reshape(x.shape) + b.astype(jnp.float32)


def rglru_coeffs(u, wr, br, wi, bi, lam):
    uf = u.astype(jnp.float32)
    r = jax.nn.sigmoid(block_diag_linear(uf, wr, br))
    i = jax.nn.sigmoid(block_diag_linear(uf, wi, bi))
    log_a = LRU_C * r * jax.nn.log_sigmoid(lam.astype(jnp.float32))
    a = jnp.exp(log_a)
    mult = jnp.sqrt(-jnp.expm1(2.0 * log_a))
    return a, mult * i * uf


def _lru_combine(e1, e2):
    a1, b1 = e1
    a2, b2 = e2
    return a1 * a2, a2 * b1 + b2


def linear_scan(a, b, h0, reverse):
    if h0 is not None:
        edge = -1 if reverse else 0
        b = b.at[:, edge].add(a[:, edge] * h0)
    _, h = lax.associative_scan(_lru_combine, (a, b), reverse=reverse, axis=1)
    return h


def rglru_mixer(xr_c, gr_c, xr_l, gr_l, conv_w, conv_b, wr, br, wi, bi, lam, need_ctx_out):
    uc = dwconv_centred(xr_c, conv_w, conv_b)
    ul = dwconv_centred(xr_l, conv_w, conv_b)
    lat_dirs, ctx_dirs = [], []
    for d, reverse in ((0, False), (1, True)):
        ac, bc = rglru_coeffs(uc, wr[d], br[d], wi[d], bi[d], lam[d])
        hc = linear_scan(ac, bc, None, reverse)
        state = hc[:, 0] if reverse else hc[:, -1]
        al, bl = rglru_coeffs(ul, wr[d], br[d], wi[d], bi[d], lam[d])
        lat_dirs.append(linear_scan(al, bl, state, reverse))
        ctx_dirs.append(hc)
    yl = ((lat_dirs[0] + lat_dirs[1]) * jax.nn.gelu(gr_l.astype(jnp.float32))).astype(xr_l.dtype)
    if not need_ctx_out:
        return yl, None
    yc = ((ctx_dirs[0] + ctx_dirs[1]) * jax.nn.gelu(gr_c.astype(jnp.float32))).astype(xr_c.dtype)
    return yl, yc


def fourier_mix(xf):
    b, n, _ = xf.shape
    xg = xf.astype(jnp.float32).reshape(b, n, FOURIER_GROUPS, FOURIER_GD)
    y = jnp.fft.fft2(xg, axes=(1, 3), norm='ortho').real
    return y.reshape(b, n, D_FOURIER).astype(xf.dtype)


def axial_rope(n_lat):
    rows_count = n_lat // GRID_W
    rows = jnp.repeat(jnp.arange(rows_count), GRID_W).astype(jnp.float32)
    cols = jnp.tile(jnp.arange(GRID_W), rows_count).astype(jnp.float32)
    n_freq = HEAD_DIM // 4
    inv = ROPE_BASE ** (-jnp.arange(n_freq, dtype=jnp.float32) / n_freq)
    ang = jnp.concatenate([rows[:, None] * inv, cols[:, None] * inv], axis=-1)
    return jnp.cos(ang), jnp.sin(ang)


def apply_rope(t, cos, sin):
    c = cos[None, :, None, None, :]
    s = sin[None, :, None, None, :]
    t1, t2 = jnp.split(t.astype(jnp.float32), 2, axis=-1)
    return jnp.concatenate([t1 * c - t2 * s, t1 * s + t2 * c], axis=-1).astype(t.dtype)


def split_qk_heads(t):
    return t.reshape(t.shape[:2] + (N_HEADS, 2, HEAD_DIM))


def split_v_heads(t):
    return t.reshape(t.shape[:2] + (N_HEADS, V_DIM))


def diff_attend(q, k, v, lam, lam_init):
    s = jnp.einsum('bqhcd,bkhcd->bhcqk', q.astype(jnp.float32), k.astype(jnp.float32)) * HEAD_DIM ** -0.5
    p = jax.nn.softmax(s, axis=-1)
    w = p[:, :, 0] - lam * p[:, :, 1]
    o = jnp.einsum('bhqk,bkhv->bqhv', w, v.astype(jnp.float32))
    o = o * lax.rsqrt(jnp.mean(o * o, axis=-1, keepdims=True) + EPS)
    return o * (1.0 - lam_init)


def diff_attention(q_c, k_c, v_c, q_l, k_l, v_l, lam_vec, lam_init, need_ctx_out):
    b, n_lat = q_l.shape[0], q_l.shape[1]
    cos, sin = axial_rope(n_lat)
    ql = apply_rope(split_qk_heads(q_l), cos, sin)
    kl = apply_rope(split_qk_heads(k_l), cos, sin)
    kc = split_qk_heads(k_c)
    vc = split_v_heads(v_c)
    k_all = jnp.concatenate([kl, kc], axis=1)
    v_all = jnp.concatenate([split_v_heads(v_l), vc], axis=1)
    lv = lam_vec.astype(jnp.float32)
    lam = jnp.exp(jnp.sum(lv[0] * lv[1])) - jnp.exp(jnp.sum(lv[2] * lv[3])) + lam_init
    n_blk = n_lat // Q_BLOCK
    qb = ql.reshape(b, n_blk, Q_BLOCK, N_HEADS, 2, HEAD_DIM).swapaxes(0, 1)
    ob = lax.map(lambda qi: diff_attend(qi, k_all, v_all, lam, lam_init), qb)
    yl = ob.swapaxes(0, 1).reshape(b, n_lat, D_ATTN).astype(q_l.dtype)
    if not need_ctx_out:
        return yl, None
    yc = diff_attend(split_qk_heads(q_c), kc, vc, lam, lam_init)
    return yl, yc.reshape(b, q_c.shape[1], D_ATTN).astype(q_c.dtype)


def merge_branches(h, ya, yb, yc, w_branch, w_gate, b_gate, w_out):
    pa = ya @ w_branch[:D_RNN]
    pb = yb @ w_branch[D_RNN:D_RNN + D_FOURIER]
    pc = yc @ w_branch[D_RNN + D_FOURIER:]
    g = jax.nn.sigmoid((h @ w_gate + b_gate).astype(jnp.float32)).astype(h.dtype)
    ga, gb, gc = jnp.split(g, N_BRANCH, axis=-1)
    return (ga * pa + gb * pb + gc * pc) @ w_out


def swiglu(h, w1, w3, w2):
    return (jax.nn.silu(h @ w1) * (h @ w3)) @ w2


def setup_inputs(seed: int = 0) -> dict:
    key = jax.random.key(seed)
    ks = jax.random.split(key, 24)
    f32 = jnp.float32

    def nrm(k, shape, fan_in, gain=1.0):
        return gain * fan_in ** -0.5 * jax.random.normal(k, shape, f32)

    def small(k, shape):
        return 0.02 * jax.random.normal(k, shape, f32)

    u = jax.random.uniform(ks[13], (DEPTH, 2, D_RNN), f32, 0.9, 0.999)
    a_base = u ** (1.0 / LRU_C)
    return {
        'x': jax.random.normal(ks[0], (BATCH, SEQ, D_MODEL), f32),
        'c': jax.random.normal(ks[1], (BATCH, D_MODEL), f32),
        'ctx': jax.random.normal(ks[2], (BATCH, CTX_LEN, D_MODEL), f32),
        'c_ctx': jax.random.normal(ks[3], (D_MODEL,), f32),
        'ada_w': nrm(ks[4], (DEPTH, D_MODEL, N_MOD * D_MODEL), D_MODEL, 0.5),
        'ada_b': small(ks[5], (DEPTH, N_MOD * D_MODEL)),
        'w_in': nrm(ks[6], (DEPTH, D_MODEL, D_IN), D_MODEL),
        'rnn_conv_w': nrm(ks[7], (DEPTH, CONV_W, D_RNN), CONV_W),
        'rnn_conv_b': small(ks[8], (DEPTH, D_RNN)),
        'rnn_wr': nrm(ks[9], (DEPTH, 2, RNN_BLOCKS, RNN_BLOCK, RNN_BLOCK), RNN_BLOCK),
        'rnn_br': small(ks[10], (DEPTH, 2, D_RNN)),
        'rnn_wi': nrm(ks[11], (DEPTH, 2, RNN_BLOCKS, RNN_BLOCK, RNN_BLOCK), RNN_BLOCK),
        'rnn_bi': small(ks[12], (DEPTH, 2, D_RNN)),
        'rnn_lambda': jnp.log(a_base) - jnp.log1p(-a_base),
        'attn_lambda': 0.1 * jax.random.normal(ks[14], (DEPTH, 4, HEAD_DIM), f32),
        'w_branch': nrm(ks[15], (DEPTH, D_MIX, D_MODEL), D_RNN),
        'w_gate': nrm(ks[16], (DEPTH, D_MODEL, N_BRANCH * D_MODEL), D_MODEL),
        'b_gate': small(ks[17], (DEPTH, N_BRANCH * D_MODEL)),
        'w_out': nrm(ks[18], (DEPTH, D_MODEL, D_MODEL), D_MODEL),
        'ffn_w1': nrm(ks[19], (DEPTH, D_MODEL, D_FF), D_MODEL),
        'ffn_w3': nrm(ks[20], (DEPTH, D_MODEL, D_FF), D_MODEL),
        'ffn_w2': nrm(ks[21], (DEPTH, D_FF, D_MODEL), D_FF),
        'final_g': 1.0 + small(ks[22], (D_MODEL,)),
    }


def reference(x, c, ctx, c_ctx, ada_w, ada_b, w_in, rnn_conv_w, rnn_conv_b, rnn_wr, rnn_br, rnn_wi, rnn_bi, rnn_lambda, attn_lambda, w_branch, w_gate, b_gate, w_out, ffn_w1, ffn_w3, ffn_w2, final_g):
    xl, xc = x, ctx
    for l in range(DEPTH):
        last = l == DEPTH - 1
        lam_init = 0.8 - 0.6 * math.exp(-0.3 * l)
        sh1_l, sc1_l, g1_l, sh2_l, sc2_l, g2_l = adaln_params(c, ada_w[l], ada_b[l])
        sh1_c, sc1_c, g1_c, sh2_c, sc2_c, g2_c = adaln_params(c_ctx, ada_w[l], ada_b[l])

        hl = modulate(xl, sh1_l, sc1_l)
        hc = modulate(xc, sh1_c, sc1_c)
        xr_l, gr_l, xf_l, q_l, k_l, v_l = jnp.split(hl @ w_in[l], SPLITS, axis=-1)
        if last:
            xr_c = hc @ w_in[l][:, :SPLITS[0]]
            k_c, v_c = jnp.split(hc @ w_in[l][:, SPLITS[3]:], 2, axis=-1)
            gr_c = xf_c = q_c = None
        else:
            xr_c, gr_c, xf_c, q_c, k_c, v_c = jnp.split(hc @ w_in[l], SPLITS, axis=-1)

        ya_l, ya_c = rglru_mixer(xr_c, gr_c, xr_l, gr_l, rnn_conv_w[l], rnn_conv_b[l], rnn_wr[l], rnn_br[l], rnn_wi[l], rnn_bi[l], rnn_lambda[l], not last)
        yc_l, yc_c = diff_attention(q_c, k_c, v_c, q_l, k_l, v_l, attn_lambda[l], lam_init, not last)
        yb_l = fourier_mix(xf_l)
        xl = xl + g1_l * merge_branches(hl, ya_l, yb_l, yc_l, w_branch[l], w_gate[l], b_gate[l], w_out[l])

        xl = xl + g2_l * swiglu(modulate(xl, sh2_l, sc2_l), ffn_w1[l], ffn_w3[l], ffn_w2[l])

        if not last:
            yb_c = fourier_mix(xf_c)
            xc = xc + g1_c * merge_branches(hc, ya_c, yb_c, yc_c, w_branch[l], w_gate[l], b_gate[l], w_out[l])
            xc = xc + g2_c * swiglu(modulate(xc, sh2_c, sc2_c), ffn_w1[l], ffn_w3[l], ffn_w2[l])

    return rmsnorm(xl, final_g)
```

```cpp
#include <hip/hip_runtime.h>
#include <hip/hip_cooperative_groups.h>
#include <cstdio>
#include <cstdint>
namespace cg = cooperative_groups;

#define LAS __attribute__((address_space(3)))
#define DEVINL __device__ __forceinline__
typedef unsigned short bf16_t;
typedef short bf16x8 __attribute__((ext_vector_type(8)));
typedef float f32x2 __attribute__((ext_vector_type(2)));
typedef float f32x4 __attribute__((ext_vector_type(4)));
typedef float f32x16 __attribute__((ext_vector_type(16)));
typedef unsigned u32x2 __attribute__((ext_vector_type(2)));
typedef unsigned u32x4 __attribute__((ext_vector_type(4)));
typedef __bf16 bf16x2_t __attribute__((ext_vector_type(2)));

constexpr int DM = 1024, NB = 8, SEQ = 2048, CTX = 256, TL = NB * SEQ, TC = NB * CTX, TT = TL + TC;
constexpr int DFF = 2816, NMOD = 6144;
constexpr float EPS = 1e-6f;
constexpr float C2 = 0.125f * 1.4426950408889634f;

constexpr size_t MiB = 1u << 20;
constexpr size_t WS_MOD = 0;
constexpr size_t WS_COS = 512 * 1024, WS_SIN = 768 * 1024;
constexpr size_t WS_XCTX = 2 * MiB;
constexpr size_t WS_T = 10 * MiB;
constexpr size_t WS_TC = 26 * MiB;
constexpr size_t WS_W = 27 * MiB;
constexpr size_t W_RG = WS_W, W_QK = WS_W + 4 * MiB, W_V = WS_W + 8 * MiB, W_Z = WS_W + 10 * MiB, W_G = WS_W + 14 * MiB,
                 W_M = WS_W + 20 * MiB, W_O = WS_W + 26 * MiB, W_13 = WS_W + 28 * MiB, W_2 = WS_W + 39 * MiB, W_RNN = WS_W + 44 * MiB + 512 * 1024;
constexpr size_t SLOT = 36 * MiB;
constexpr size_t WS_S0 = 73 * MiB, WS_S1 = WS_S0 + SLOT, WS_S2 = WS_S1 + SLOT, WS_S3 = WS_S2 + SLOT, WS_S4 = WS_S3 + SLOT;
constexpr int LDS_BYTES = 132096;

struct Params { const float* in[23]; float* out; unsigned char* ws; };

DEVINL unsigned cvtpk(float lo, float hi) { f32x2 v = {lo, hi}; bf16x2_t b = __builtin_convertvector(v, bf16x2_t); return __builtin_bit_cast(unsigned, b); }
DEVINL float bf2f(unsigned short b) { return __builtin_bit_cast(float, (unsigned)b << 16); }
DEVINL float bflo(unsigned w) { return __builtin_bit_cast(float, w << 16); }
DEVINL float bfhi(unsigned w) { return __builtin_bit_cast(float, w & 0xffff0000u); }
DEVINL float wave_sum(float v) {
#pragma unroll
    for (int o = 1; o < 64; o <<= 1) v += __shfl_xor(v, o);
    return v;
}
DEVINL float sigmoidf_(float x) { return 1.f / (1.f + __expf(-x)); }
DEVINL float gelu_tanh(float x) { const float u = 0.7978845608028654f * (x + 0.044715f * x * x * x); const float e = __expf(2.f * u); const float t = 1.f - 2.f / (e + 1.f); return 0.5f * x * (1.f + t); }
#define LDS_WAIT() asm volatile("s_waitcnt lgkmcnt(0)" ::: "memory")
DEVINL int opaque_tid() { int t = threadIdx.x; asm volatile("" : "+v"(t)); return t; }
typedef const __attribute__((address_space(4))) Params* PP;
DEVINL PP get_params() { PP q = (PP)__builtin_amdgcn_kernarg_segment_ptr(); asm volatile("" : "+s"(q)); return q; }

constexpr int BM = 256, BK = 64, HALF = 128, HTB = HALF * BK * 2;
DEVINL int lds_byte(int r, int c) { const int st = (r >> 4) * 2 + (c >> 5), rr = r & 15, cc = c & 31, ob = rr * 64 + cc * 2; return st * 1024 + (ob ^ (((ob >> 9) & 1) << 5)); }
DEVINL void stage_rc(int b, int& R, int& C) { const int st = b / 1024, sb = b % 1024, swz = sb ^ (((sb >> 9) & 1) << 5); R = (st >> 1) * 16 + swz / 64; C = (st & 1) * 32 + (swz % 64) / 2; }
DEVINL int perm32(int rho) { const int n = rho >> 4, i = rho & 15; return 8 * (i >> 2) + 4 * n + (i & 3); }

struct Unit { const char* a; const char* b; char* o; int ldo, pm, pn; };
struct GemmK { int lda, ldb, K; };

DEVINL bool tile_order(int i, int G, int c, int nM, int nN, int& pm, int& pn) {
    const long L = (long)i * G + c; const int nwg = nM * nN; if (L >= nwg) return false;
    int wgid = (int)L; { const int q = nwg / 8, r = nwg % 8, xcd = wgid % 8, off = wgid / 8; wgid = (xcd < r ? xcd * (q + 1) : r * (q + 1) + (xcd - r) * q) + off; }
    const int nig = 8 * nN, gid = wgid / nig, fm = gid * 8, gsz = (nM - fm) < 8 ? (nM - fm) : 8;
    pm = fm + ((wgid % nig) % gsz); pn = (wgid % nig) / gsz; return true;
}

struct SchedG {
    int kind; const char* A; const char* B; char* O; char* O2; int lda, ldb, nM, nN, G, c;
    DEVINL bool next(int i, Unit& u) const {
        int pm, pn;
        if (kind >= 4) {
            const long L = (long)i * G + c;
            if (kind == 4) { if (L >= 256) return false; const int b = (int)L >> 5; pm = ((int)L >> 2) & 7; pn = (int)L & 3;
                u.a = A + (size_t)pm * 256 * 4096 * 2; u.b = B + ((size_t)b * 1024 + pn * 256) * 4096 * 2; u.o = O + (((size_t)b * 2048 + pm * 256) * 1024 + pn * 256) * 2; u.ldo = 1024; }
            else { if (L >= 32) return false; const int b = (int)L >> 2; pm = 0; pn = (int)L & 3;
                u.a = A; u.b = B + ((size_t)b * 1024 + pn * 256) * 512 * 2; u.o = O + (((size_t)TL + b * 256) * 1024 + pn * 256) * 2; u.ldo = 1024; }
            u.pm = pm; u.pn = pn; return true;
        }
        if (!tile_order(i, G, c, nM, nN, pm, pn)) return false;
        u.pm = pm; u.pn = pn; u.a = A + (size_t)pm * 256 * lda * 2; u.b = B + (size_t)pn * 256 * ldb * 2; u.o = O; u.ldo = 1024;
        if (kind == 1) { u.o = (pn < 4 ? O : O2) + ((size_t)pm * 256 * 1024 + (pn & 3) * 256) * 2; }
        else if (kind == 2) {
            const int part = pm >> 2, j0 = (pm & 3) * 256;
            if (pn < 64) { const int b = pn >> 3, n0 = (pn & 7) * 256; u.o = O + ((((size_t)b * 1024 + j0) * 2 + part) * 2048 + n0) * 2; u.ldo = 4096; }
            else { const int b = pn - 64; u.o = O2 + ((((size_t)b * 1024 + j0) * 2 + part) * 256) * 2; u.ldo = 512; }
        } else if (kind == 3) {
            int b, key0; if (pn < 64) { b = pn >> 3; key0 = (pn & 7) * 256; } else { b = pn - 64; key0 = 2048; }
            u.o = O + (((size_t)b * 1024 + pm * 256) * 2304 + key0) * 2; u.ldo = 2304;
        }
        return true;
    }
};

typedef f32x4 AccT[2][2][4][2];
struct EpiStore {
    DEVINL void operator()(const AccT& acc, const Unit& u, int wr, int wc, int fr, int fq) const {
#pragma unroll
        for (int ai = 0; ai < 2; ++ai)
#pragma unroll
            for (int m = 0; m < 4; ++m) { bf16_t* rowp = (bf16_t*)u.o + (size_t)(ai * 128 + wr * 64 + m * 16 + fr) * u.ldo + wc * 32 + 8 * fq;
#pragma unroll
                for (int bj = 0; bj < 2; ++bj) { const f32x4 v0 = acc[ai][bj][m][0], v1 = acc[ai][bj][m][1]; u32x4 w;
                    w.x = cvtpk(v0[0], v0[1]); w.y = cvtpk(v0[2], v0[3]); w.z = cvtpk(v1[0], v1[1]); w.w = cvtpk(v1[2], v1[3]); *(u32x4*)(rowp + bj * 128) = w; } }
    }
};
struct EpiQK {
    bf16_t* Q; bf16_t* K; const float* cosT; const float* sinT;
    DEVINL void operator()(const AccT& acc, const Unit& u, int wr, int wc, int fr, int fq) const {
        const bool isq = u.pn < 4; bf16_t* base = isq ? Q : K; const float sc = isq ? C2 : 1.f;
        const int hp = (u.pn & 3) * 2 + (wc >> 1), c = wc & 1, jj0 = 8 * fq;
#pragma unroll
        for (int ai = 0; ai < 2; ++ai)
#pragma unroll
            for (int m = 0; m < 4; ++m) { const int t = u.pm * 256 + ai * 128 + wr * 64 + m * 16 + fr; const bool lat = t < TL; const int pos = t & 2047;
                bf16_t* dst = base + (size_t)t * 1024 + hp * 128 + c * 64 + jj0; f32x4 o1[2], o2[2];
#pragma unroll
                for (int n = 0; n < 2; ++n) { f32x4 cs = {1.f, 1.f, 1.f, 1.f}, sn = {0.f, 0.f, 0.f, 0.f};
                    if (lat) { cs = *(const f32x4*)(cosT + pos * 32 + jj0 + 4 * n); sn = *(const f32x4*)(sinT + pos * 32 + jj0 + 4 * n); }
                    const f32x4 t1 = acc[ai][0][m][n], t2 = acc[ai][1][m][n]; o1[n] = (t1 * cs - t2 * sn) * sc; o2[n] = (t1 * sn + t2 * cs) * sc; }
                u32x4 w; w.x = cvtpk(o1[0][0], o1[0][1]); w.y = cvtpk(o1[0][2], o1[0][3]); w.z = cvtpk(o1[1][0], o1[1][1]); w.w = cvtpk(o1[1][2], o1[1][3]); *(u32x4*)dst = w;
                w.x = cvtpk(o2[0][0], o2[0][1]); w.y = cvtpk(o2[0][2], o2[0][3]); w.z = cvtpk(o2[1][0], o2[1][1]); w.w = cvtpk(o2[1][2], o2[1][3]); *(u32x4*)(dst + 32) = w; }
    }
};
struct EpiGate {
    bf16_t* Gd; const float* bias;
    DEVINL void operator()(const AccT& acc, const Unit& u, int wr, int wc, int fr, int fq) const {
        const int col0 = u.pn * 256 + wc * 32 + 8 * fq;
#pragma unroll
        for (int bj = 0; bj < 2; ++bj) { const f32x4 b0 = *(const f32x4*)(bias + col0 + bj * 128), b1 = *(const f32x4*)(bias + col0 + bj * 128 + 4);
#pragma unroll
            for (int ai = 0; ai < 2; ++ai)
#pragma unroll
                for (int m = 0; m < 4; ++m) { const int t = u.pm * 256 + ai * 128 + wr * 64 + m * 16 + fr; const f32x4 v0 = acc[ai][bj][m][0] + b0, v1 = acc[ai][bj][m][1] + b1; u32x4 w;
                    w.x = cvtpk(sigmoidf_(v0[0]), sigmoidf_(v0[1])); w.y = cvtpk(sigmoidf_(v0[2]), sigmoidf_(v0[3])); w.z = cvtpk(sigmoidf_(v1[0]), sigmoidf_(v1[1])); w.w = cvtpk(sigmoidf_(v1[2]), sigmoidf_(v1[3]));
                    *(u32x4*)(Gd + (size_t)t * 1024 + col0 + bj * 128) = w; } }
    }
};
struct EpiMerge {
    const bf16_t* Gs; bf16_t* Md; int first;
    DEVINL void operator()(const AccT& acc, const Unit& u, int wr, int wc, int fr, int fq) const {
        const int col0 = u.pn * 256 + wc * 32 + 8 * fq;
#pragma unroll
        for (int ai = 0; ai < 2; ++ai)
#pragma unroll
            for (int m = 0; m < 4; ++m) { const int t = u.pm * 256 + ai * 128 + wr * 64 + m * 16 + fr;
#pragma unroll
                for (int bj = 0; bj < 2; ++bj) { const size_t off = (size_t)t * 1024 + col0 + bj * 128; const u32x4 g = *(const u32x4*)(Gs + off); const f32x4 v0 = acc[ai][bj][m][0], v1 = acc[ai][bj][m][1];
                    float r0 = bflo(g.x) * v0[0], r1 = bfhi(g.x) * v0[1], r2 = bflo(g.y) * v0[2], r3 = bfhi(g.y) * v0[3], r4 = bflo(g.z) * v1[0], r5 = bfhi(g.z) * v1[1], r6 = bflo(g.w) * v1[2], r7 = bfhi(g.w) * v1[3];
                    if (!first) { const u32x4 o = *(const u32x4*)(Md + off); r0 += bflo(o.x); r1 += bfhi(o.x); r2 += bflo(o.y); r3 += bfhi(o.y); r4 += bflo(o.z); r5 += bfhi(o.z); r6 += bflo(o.w); r7 += bfhi(o.w); }
                    u32x4 w; w.x = cvtpk(r0, r1); w.y = cvtpk(r2, r3); w.z = cvtpk(r4, r5); w.w = cvtpk(r6, r7); *(u32x4*)(Md + off) = w; } }
    }
};
struct EpiResid {
    float* Xlat; float* Xctx; const float* gmod;
    DEVINL void operator()(const AccT& acc, const Unit& u, int wr, int wc, int fr, int fq) const {
        const int col0 = u.pn * 256 + wc * 32 + 8 * fq; const int mr = u.pm < 64 ? (u.pm >> 3) : 8;
        float* xb = u.pm < 64 ? Xlat + (size_t)u.pm * 256 * 1024 : Xctx + (size_t)(u.pm - 64) * 256 * 1024;
#pragma unroll
        for (int bj = 0; bj < 2; ++bj) { const f32x4 g0 = *(const f32x4*)(gmod + mr * NMOD + col0 + bj * 128), g1 = *(const f32x4*)(gmod + mr * NMOD + col0 + bj * 128 + 4);
#pragma unroll
            for (int ai = 0; ai < 2; ++ai)
#pragma unroll
                for (int m = 0; m < 4; ++m) { float* xp = xb + (size_t)(ai * 128 + wr * 64 + m * 16 + fr) * 1024 + col0 + bj * 128;
                    f32x4 x0 = *(f32x4*)xp, x1 = *(f32x4*)(xp + 4); x0 += g0 * acc[ai][bj][m][0]; x1 += g1 * acc[ai][bj][m][1]; *(f32x4*)xp = x0; *(f32x4*)(xp + 4) = x1; } }
    }
};
struct EpiSwiGLU {
    bf16_t* Ud;
    DEVINL void operator()(const AccT& acc, const Unit& u, int wr, int wc, int fr, int fq) const {
        const int col0 = u.pn * 128 + wc * 32 + 8 * fq;
#pragma unroll
        for (int ai = 0; ai < 2; ++ai)
#pragma unroll
            for (int m = 0; m < 4; ++m) { const int t = u.pm * 256 + ai * 128 + wr * 64 + m * 16 + fr; float r[8];
#pragma unroll
                for (int n = 0; n < 2; ++n)
#pragma unroll
                    for (int j = 0; j < 4; ++j) { const float a = acc[ai][0][m][n][j], b = acc[ai][1][m][n][j]; r[n * 4 + j] = a * sigmoidf_(a) * b; }
                u32x4 w; w.x = cvtpk(r[0], r[1]); w.y = cvtpk(r[2], r[3]); w.z = cvtpk(r[4], r[5]); w.w = cvtpk(r[6], r[7]); *(u32x4*)(Ud + (size_t)t * DFF + col0) = w; }
    }
};

template <class Epi, class Sched>
DEVINL void gemm_phase(LAS unsigned char* lds, const GemmK g, const Sched& S, const Epi& E) {
    const int tid = opaque_tid(), wid = __builtin_amdgcn_readfirstlane(tid >> 6), lane = tid & 63, wr = wid >> 2, wc = wid & 3, fr = lane & 15, fq = lane >> 4;
    const int nt = g.K / BK;
    unsigned voffA[2], voffB[2];
#pragma unroll
    for (int i = 0; i < 2; ++i) { int R, C; stage_rc(tid * 16 + i * 8192, R, C); const int Rb = (R & ~31) + perm32(R & 31);
        voffA[i] = (unsigned)(R * g.lda + C) * 2u; voffB[i] = (unsigned)(Rb * g.ldb + C) * 2u; }
    const size_t kstep = (size_t)(BK * 2);
    const size_t hstepA = (size_t)HALF * g.lda * 2, hstepB = (size_t)HALF * g.ldb * 2;
    const unsigned ldsw = (unsigned)wid * 1024u;
    const int aoff = lds_byte(wr * 64 + fr, fq * 8), boff = lds_byte(wc * 32 + fr, fq * 8);
#define PG8_SA(b, h) (((b) * 2 + (h)) * HTB)
#define PG8_SB(b, h) ((4 + (b) * 2 + (h)) * HTB)
#define PG8_STAGE(bufoff, gbase, voff) do { _Pragma("unroll") for (int _i = 0; _i < 2; ++_i) \
        __builtin_amdgcn_global_load_lds((const unsigned*)((const char*)(gbase) + (voff)[_i]), (LAS unsigned*)(lds + (bufoff) + ldsw + _i * 8192), 16, 0, 0); } while (0)
#define PG8_LDA(dst, b, h) do { _Pragma("unroll") for (int m = 0; m < 4; ++m) _Pragma("unroll") for (int k = 0; k < 2; ++k) dst[m][k] = *(const LAS bf16x8*)(lds + PG8_SA(b, h) + aoff + m * 2048 + k * 1024); } while (0)
#define PG8_LDB(dst, b, h) do { _Pragma("unroll") for (int n = 0; n < 2; ++n) _Pragma("unroll") for (int k = 0; k < 2; ++k) dst[n][k] = *(const LAS bf16x8*)(lds + PG8_SB(b, h) + boff + n * 2048 + k * 1024); } while (0)
#define PG8_MMA(ai, bj, At, Bt) do { __builtin_amdgcn_s_setprio(1); _Pragma("unroll") for (int m = 0; m < 4; ++m) _Pragma("unroll") for (int n = 0; n < 2; ++n) _Pragma("unroll") for (int k = 0; k < 2; ++k) \
        acc[ai][bj][m][n] = __builtin_amdgcn_mfma_f32_16x16x32_bf16(Bt[n][k], At[m][k], acc[ai][bj][m][n], 0, 0, 0); __builtin_amdgcn_s_setprio(0); } while (0)
#define PG8_WAIT_V(n) asm volatile("s_waitcnt vmcnt(" #n ")" ::: "memory")
#define PG8_WAIT_L(n) asm volatile("s_waitcnt lgkmcnt(" #n ")" ::: "memory")
#define PG8_BAR __builtin_amdgcn_s_barrier()
#define PG8_SCHED __builtin_amdgcn_sched_barrier(0)
    Unit cur, nxt; int ui = 0;
    if (!S.next(0, cur)) return;
    f32x4 acc[2][2][4][2];
#pragma unroll
    for (int a = 0; a < 2; ++a)
#pragma unroll
        for (int b = 0; b < 2; ++b)
#pragma unroll
            for (int m = 0; m < 4; ++m)
#pragma unroll
                for (int n = 0; n < 2; ++n) acc[a][b][m][n] = (f32x4){0.f, 0.f, 0.f, 0.f};
    bf16x8 At[4][2], B0[2][2], B1[2][2];
    const char* cA = cur.a; const char* cB = cur.b;
    PG8_STAGE(PG8_SB(0, 0), cB, voffB); PG8_STAGE(PG8_SA(0, 0), cA, voffA); PG8_STAGE(PG8_SB(0, 1), cB + hstepB, voffB); PG8_STAGE(PG8_SA(0, 1), cA + hstepA, voffA);
    if (wr == 1) PG8_BAR;
    PG8_WAIT_V(4); PG8_BAR;
    PG8_STAGE(PG8_SB(1, 0), cB + kstep, voffB); PG8_STAGE(PG8_SA(1, 0), cA + kstep, voffA); PG8_STAGE(PG8_SB(1, 1), cB + hstepB + kstep, voffB);
    PG8_WAIT_V(6); PG8_BAR;
    for (;;) {
        const bool has_next = S.next(ui + 1, nxt);
        const char* nA = has_next ? nxt.a : cA; const char* nB = has_next ? nxt.b : cB;
        for (int t = 0; t < nt; t += 2) {
            const bool last = (t == nt - 2);
            const char* a1 = cA + (size_t)(t + 1) * kstep;
            const char* a2 = last ? nA : cA + (size_t)(t + 2) * kstep; const char* b2 = last ? nB : cB + (size_t)(t + 2) * kstep;
            const char* a3 = a2 + kstep; const char* b3 = b2 + kstep;
            PG8_LDB(B0, 0, 0); PG8_SCHED; PG8_LDA(At, 0, 0); PG8_STAGE(PG8_SA(1, 1), a1 + hstepA, voffA);
            PG8_WAIT_L(8); PG8_BAR; PG8_WAIT_L(0); PG8_MMA(0, 0, At, B0); PG8_BAR; PG8_SCHED;
            PG8_LDB(B1, 0, 1); PG8_STAGE(PG8_SB(0, 0), b2, voffB);
            PG8_BAR; PG8_WAIT_L(0); PG8_MMA(0, 1, At, B1); PG8_BAR;
            PG8_LDA(At, 0, 1); PG8_STAGE(PG8_SA(0, 0), a2, voffA);
            PG8_BAR; PG8_WAIT_L(0); PG8_MMA(1, 0, At, B0); PG8_BAR; PG8_SCHED;
            PG8_STAGE(PG8_SB(0, 1), b2 + hstepB, voffB);
            PG8_WAIT_V(6); PG8_BAR; PG8_MMA(1, 1, At, B1); PG8_BAR;
            PG8_LDB(B0, 1, 0); PG8_SCHED; PG8_LDA(At, 1, 0); PG8_STAGE(PG8_SA(0, 1), a2 + hstepA, voffA);
            PG8_WAIT_L(8); PG8_BAR; PG8_WAIT_L(0); PG8_MMA(0, 0, At, B0); PG8_BAR; PG8_SCHED;
            PG8_LDB(B1, 1, 1); PG8_STAGE(PG8_SB(1, 0), b3, voffB);
            PG8_BAR; PG8_WAIT_L(0); PG8_MMA(0, 1, At, B1); PG8_BAR;
            PG8_LDA(At, 1, 1); PG8_STAGE(PG8_SA(1, 0), a3, voffA);
            PG8_BAR; PG8_WAIT_L(0); PG8_MMA(1, 0, At, B0); PG8_BAR; PG8_SCHED;
            PG8_STAGE(PG8_SB(1, 1), b3 + hstepB, voffB);
            PG8_WAIT_V(6); PG8_BAR; PG8_MMA(1, 1, At, B1); PG8_BAR;
        }
        E(acc, cur, wr, wc, fr, fq);
        if (!has_next) break;
#pragma unroll
        for (int a = 0; a < 2; ++a)
#pragma unroll
            for (int b = 0; b < 2; ++b)
#pragma unroll
                for (int m = 0; m < 4; ++m)
#pragma unroll
                    for (int n = 0; n < 2; ++n) acc[a][b][m][n] = (f32x4){0.f, 0.f, 0.f, 0.f};
        cur = nxt; cA = nA; cB = nB; ++ui;
    }
    PG8_WAIT_V(0);
    if (wr == 0) PG8_BAR;
    PG8_BAR;
#undef PG8_SA
#undef PG8_SB
#undef PG8_STAGE
#undef PG8_LDA
#undef PG8_LDB
#undef PG8_MMA
#undef PG8_WAIT_V
#undef PG8_WAIT_L
#undef PG8_BAR
#undef PG8_SCHED
}

DEVINL void transpose_item(const float* W, int ldw, bf16_t* WT, int ldt, LAS float* scr, int lane) {
#pragma unroll 8
    for (int i = 0; i < 32; ++i) { const int kk = 2 * i + (lane >> 5); scr[kk * 33 + (lane & 31)] = W[(size_t)kk * ldw + (lane & 31)]; }
    LDS_WAIT();
    const int c = lane & 7;
#pragma unroll
    for (int j = 0; j < 4; ++j) { const int n = (lane >> 3) + 8 * j; const LAS float* s = scr + (8 * c) * 33 + n;
        u32x4 o; o.x = cvtpk(s[0 * 33], s[1 * 33]); o.y = cvtpk(s[2 * 33], s[3 * 33]); o.z = cvtpk(s[4 * 33], s[5 * 33]); o.w = cvtpk(s[6 * 33], s[7 * 33]);
        *(u32x4*)(WT + (size_t)n * ldt + 8 * c) = o; }
    LDS_WAIT();
}

DEVINL void phase_convert(LAS unsigned char* lds, int l) {
    PP q = get_params();
    const int tid = opaque_tid(), lane = tid & 63, wave = __builtin_amdgcn_readfirstlane(tid >> 6), G = gridDim.x, blk = blockIdx.x;
    unsigned char* ws = q->ws;
    const float* w_in = q->in[6] + (size_t)l * 1024 * 6144;
    LAS float* scr = (LAS float*)(lds + wave * 8448);
    const int gw = blk * 8 + wave, NGW = G * 8;
    constexpr int N_RG = 1024, N_QK = 1024, N_V = 512, N_G = 1536, N_M = 1536, N_O = 512, N_1 = 1408, N_3 = 1408, N_2 = 1408, N_R = 256;
    constexpr int NIT = N_RG + N_QK + N_V + N_G + N_M + N_O + N_1 + N_3 + N_2 + N_R;
    for (int it = gw; it < NIT; it += NGW) {
        int r = it;
        if (r < N_RG) { const int kb = r >> 6, nb = r & 63; transpose_item(w_in + (size_t)kb * 64 * 6144 + nb * 32, 6144, (bf16_t*)(ws + W_RG) + (size_t)nb * 32 * 1024 + kb * 64, 1024, scr, lane); continue; } r -= N_RG;
        if (r < N_QK) { const int kb = r >> 6, nb = r & 63; const int isk = nb >> 5, cc = (nb & 31) * 32, hh = cc >> 7, c = (cc >> 6) & 1, half = (cc >> 5) & 1;
            const int drow = (isk * 4 + (hh >> 1)) * 256 + half * 128 + (hh & 1) * 64 + c * 32;
            transpose_item(w_in + (size_t)kb * 64 * 6144 + 3072 + nb * 32, 6144, (bf16_t*)(ws + W_QK) + (size_t)drow * 1024 + kb * 64, 1024, scr, lane); continue; } r -= N_QK;
        if (r < N_V) { const int kb = r >> 5, nb = r & 31; transpose_item(w_in + (size_t)kb * 64 * 6144 + 5120 + nb * 32, 6144, (bf16_t*)(ws + W_V) + (size_t)nb * 32 * 1024 + kb * 64, 1024, scr, lane); continue; } r -= N_V;
        if (r < N_G) { const int kb = r / 96, nb = r % 96; transpose_item(q->in[16] + (size_t)l * 1024 * 3072 + (size_t)kb * 64 * 3072 + nb * 32, 3072, (bf16_t*)(ws + W_G) + (size_t)nb * 32 * 1024 + kb * 64, 1024, scr, lane); continue; } r -= N_G;
        if (r < N_M) { const int i = r / 512, rr = r % 512, kb = rr >> 5, nb = rr & 31;
            transpose_item(q->in[15] + (size_t)l * 3072 * 1024 + ((size_t)i * 1024 + kb * 64) * 1024 + nb * 32, 1024, (bf16_t*)(ws + W_M) + ((size_t)i * 1024 + nb * 32) * 1024 + kb * 64, 1024, scr, lane); continue; } r -= N_M;
        if (r < N_O) { const int kb = r >> 5, nb = r & 31; transpose_item(q->in[18] + (size_t)l * 1024 * 1024 + (size_t)kb * 64 * 1024 + nb * 32, 1024, (bf16_t*)(ws + W_O) + (size_t)nb * 32 * 1024 + kb * 64, 1024, scr, lane); continue; } r -= N_O;
        if (r < N_1 + N_3) { const int w3 = r >= N_1; if (w3) r -= N_1; const int kb = r / 88, nb = r % 88; const float* src = (w3 ? q->in[20] : q->in[19]) + (size_t)l * 1024 * DFF + (size_t)kb * 64 * DFF + nb * 32;
            const int drow = (nb >> 2) * 256 + w3 * 128 + (nb & 3) * 32;
            transpose_item(src, DFF, (bf16_t*)(ws + W_13) + (size_t)drow * 1024 + kb * 64, 1024, scr, lane); continue; } r -= N_1 + N_3;
        if (r < N_2) { const int kb = r >> 5, nb = r & 31; transpose_item(q->in[21] + (size_t)l * DFF * 1024 + (size_t)kb * 64 * 1024 + nb * 32, 1024, (bf16_t*)(ws + W_2) + (size_t)nb * 32 * DFF + kb * 64, DFF, scr, lane); continue; } r -= N_2;
        {
            const int mat = r >> 3, sub = r & 7, kb = sub >> 2, nb = sub & 3; const int dir = mat >> 4, ri = (mat >> 3) & 1, g = mat & 7;
            const float* src = (ri ? q->in[11] : q->in[9]) + ((size_t)((l * 2 + dir) * 8 + g)) * 16384 + (size_t)kb * 64 * 128 + nb * 32;
            transpose_item(src, 128, (bf16_t*)(ws + W_RNN) + ((size_t)((dir * 2 + ri) * 8 + g)) * 16384 + (size_t)nb * 32 * 128 + kb * 64, 128, scr, lane);
        }
    }
    __syncthreads();
    LAS float* wt = (LAS float*)lds; LAS float* ct = wt + 128 * 65;
    for (int it = blk; it < 128; it += G) {
        const int g = it >> 4, k0 = (it & 15) * 64;
        __syncthreads();
#pragma unroll 4
        for (int i = 0; i < 16; ++i) { const int e = tid + 512 * i, kk = e >> 7, c = e & 127; wt[c * 65 + kk] = w_in[(size_t)(k0 + kk) * 6144 + 2048 + g * 128 + c]; }
        if (tid < 128) { ct[tid] = cospif((float)tid * (1.f / 64.f)); ct[128 + tid] = sinpif((float)tid * (1.f / 64.f)); }
        __syncthreads();
        const int kl = tid & 63, mg = wave;
        float ac[16], as[16];
#pragma unroll
        for (int i = 0; i < 16; ++i) { ac[i] = 0.f; as[i] = 0.f; }
        for (int c = 0; c < 128; ++c) { const float w = wt[c * 65 + kl];
#pragma unroll
            for (int mi = 0; mi < 16; ++mi) { const int idx = ((mg * 16 + mi) * c) & 127; ac[mi] += w * ct[idx]; as[mi] += w * ct[128 + idx]; } }
        bf16_t* wz = (bf16_t*)(ws + W_Z);
#pragma unroll
        for (int mi = 0; mi < 16; ++mi) { const int m = mg * 16 + mi; const unsigned pc = cvtpk(ac[mi] * 0.08838834764831845f, as[mi] * 0.08838834764831845f);
            wz[(size_t)(g * 128 + m) * 1024 + k0 + kl] = (bf16_t)(pc & 0xffffu); wz[(size_t)(1024 + g * 128 + m) * 1024 + k0 + kl] = (bf16_t)(pc >> 16); }
    }
    __syncthreads();
}

DEVINL void phase_init(LAS unsigned char* lds) {
    PP q = get_params();
    const int tid = opaque_tid(), G = gridDim.x, blk = blockIdx.x;
    const size_t gtid = (size_t)blk * 512 + tid, gsz = (size_t)G * 512;
    unsigned char* ws = q->ws;
    { const f32x4* s = (const f32x4*)q->in[0]; f32x4* d = (f32x4*)q->out; for (size_t i = gtid; i < (size_t)TL * 256; i += gsz) d[i] = s[i]; }
    { const f32x4* s = (const f32x4*)q->in[2]; f32x4* d = (f32x4*)(ws + WS_XCTX); for (size_t i = gtid; i < (size_t)TC * 256; i += gsz) d[i] = s[i]; }
    { float* cT = (float*)(ws + WS_COS); float* sT = (float*)(ws + WS_SIN);
      for (size_t i = gtid; i < 65536; i += gsz) { const int pos = (int)i >> 5, jj = (int)i & 31, f = jj & 15; const float inv = powf(10000.f, -(float)f * (1.f / 16.f));
          const float crd = (jj < 16) ? (float)(pos >> 6) : (float)(pos & 63); const float ang = crd * inv; cT[i] = cosf(ang); sT[i] = sinf(ang); } }
    { bf16_t* T = (bf16_t*)(ws + WS_T);
      for (size_t i = gtid; i < (size_t)2048 * 4096 / 2; i += gsz) { const int k = (int)(i >> 11), col = ((int)i & 2047) * 2; float v[2];
#pragma unroll
          for (int e = 0; e < 2; ++e) { const int cc = col + e, n = cc & 2047, m = (k * n) & 2047; const float x = (float)m * (1.f / 1024.f); v[e] = (cc < 2048 ? cospif(x) : -sinpif(x)) * 0.022097086912079608f; }
          ((unsigned*)T)[i] = cvtpk(v[0], v[1]); } }
    { bf16_t* T = (bf16_t*)(ws + WS_TC);
      for (size_t i = gtid; i < (size_t)256 * 512 / 2; i += gsz) { const int k = (int)(i >> 8), col = ((int)i & 255) * 2; float v[2];
#pragma unroll
          for (int e = 0; e < 2; ++e) { const int cc = col + e, n = cc & 255, m = (k * n) & 255; const float x = (float)m * (1.f / 128.f); v[e] = (cc < 256 ? cospif(x) : -sinpif(x)) * 0.0625f; }
          ((unsigned*)T)[i] = cvtpk(v[0], v[1]); } }
    LAS float* sc = (LAS float*)lds; float* part = (float*)(ws + WS_S0);
    for (int item = blk; item < 384; item += G) {
        const int l = item / 192, rem = item % 192, kc = rem / 24, nb = rem % 24;
        __syncthreads();
        for (int e = tid; e < 9 * 128; e += 512) { const int r = e >> 7, kk = e & 127; const float c = (r < 8) ? q->in[1][r * 1024 + kc * 128 + kk] : q->in[3][kc * 128 + kk]; sc[e] = c / (1.f + __expf(-c)); }
        __syncthreads();
        const int n = nb * 256 + (tid & 255), kh = tid >> 8; const float* w = q->in[4] + ((size_t)l * 1024 + kc * 128 + kh * 64) * NMOD + n;
        float acc[9];
#pragma unroll
        for (int r = 0; r < 9; ++r) acc[r] = 0.f;
#pragma unroll 4
        for (int kk = 0; kk < 64; ++kk) { const float wv = w[(size_t)kk * NMOD];
#pragma unroll
            for (int r = 0; r < 9; ++r) acc[r] += sc[r * 128 + kh * 64 + kk] * wv; }
#pragma unroll
        for (int r = 0; r < 9; ++r) part[((size_t)((kc * 2 + kh) * 2 + l) * 9 + r) * NMOD + n] = acc[r];
    }
}

DEVINL void phase_modreduce() {
    PP q = get_params();
    const size_t gtid = (size_t)blockIdx.x * 512 + opaque_tid(), gsz = (size_t)gridDim.x * 512;
    const float* part = (const float*)(q->ws + WS_S0); float* mod = (float*)(q->ws + WS_MOD);
    for (size_t i = gtid; i < 2 * 9 * NMOD; i += gsz) { const int l = (int)(i / (9 * NMOD)), n = (int)(i % NMOD); float s = q->in[5][l * NMOD + n];
#pragma unroll
        for (int j = 0; j < 16; ++j) s += part[(size_t)j * 2 * 9 * NMOD + i];
        mod[i] = s; }
}

DEVINL void phase_modulate(int l, int shoff, int scoff, int ntok) {
    PP q = get_params(); const float* modl = (const float*)(q->ws + WS_MOD) + (size_t)l * 9 * NMOD; bf16_t* H = (bf16_t*)(q->ws + WS_S0);
    const int tid = opaque_tid(), lane = tid & 63, wave = tid >> 6; const int gw = blockIdx.x * 8 + wave, NGW = gridDim.x * 8;
    const float* Xctx = (const float*)(q->ws + WS_XCTX);
    for (int t = gw; t < ntok; t += NGW) {
        const float* xr = t < TL ? q->out + (size_t)t * 1024 : Xctx + (size_t)(t - TL) * 1024; const int r = t < TL ? (t >> 11) : 8;
        f32x4 v[4]; float ss = 0.f;
#pragma unroll
        for (int j = 0; j < 4; ++j) { v[j] = ((const f32x4*)xr)[lane + 64 * j]; ss += v[j].x * v[j].x + v[j].y * v[j].y + v[j].z * v[j].z + v[j].w * v[j].w; }
        ss = wave_sum(ss); const float rinv = rsqrtf(ss * (1.f / 1024.f) + EPS);
        u32x2* o = (u32x2*)(H + (size_t)t * 1024);
#pragma unroll
        for (int j = 0; j < 4; ++j) { const int col = (lane + 64 * j) * 4; const f32x4 sc = *(const f32x4*)(modl + r * NMOD + scoff + col), sh = *(const f32x4*)(modl + r * NMOD + shoff + col);
            const f32x4 y = v[j] * rinv * (sc + 1.f) + sh; u32x2 w; w.x = cvtpk(y.x, y.y); w.y = cvtpk(y.z, y.w); o[lane + 64 * j] = w; }
    }
}

DEVINL void phase_final() {
    PP q = get_params();
    const int tid = opaque_tid(), lane = tid & 63, wave = tid >> 6; const int gw = blockIdx.x * 8 + wave, NGW = gridDim.x * 8;
    for (int t = gw; t < TL; t += NGW) {
        float* xr = q->out + (size_t)t * 1024; f32x4 v[4]; float ss = 0.f;
#pragma unroll
        for (int j = 0; j < 4; ++j) { v[j] = ((const f32x4*)xr)[lane + 64 * j]; ss += v[j].x * v[j].x + v[j].y * v[j].y + v[j].z * v[j].z + v[j].w * v[j].w; }
        ss = wave_sum(ss); const float rinv = rsqrtf(ss * (1.f / 1024.f) + EPS);
#pragma unroll
        for (int j = 0; j < 4; ++j) { const f32x4 g = ((const f32x4*)q->in[22])[lane + 64 * j]; ((f32x4*)xr)[lane + 64 * j] = v[j] * rinv * g; }
    }
}

constexpr int NCHUNK = 576;
DEVINL void phase_rnn(LAS unsigned char* lds, int l, int pass, bool skip_ctx) {
    PP q = get_params();
    const bf16_t* XR = (const bf16_t*)(q->ws + WS_S1); const bf16_t* GR = (const bf16_t*)(q->ws + WS_S2); bf16_t* Ya = (bf16_t*)(q->ws + WS_S3); f32x2* totals = (f32x2*)(q->ws + WS_S3); const float* carry = (const float*)(q->ws + WS_S4);
    const int tid = opaque_tid(), lane = tid & 63, wave = __builtin_amdgcn_readfirstlane(tid >> 6), cl = lane & 15, fq = lane >> 4;
    const int G = gridDim.x, blk = blockIdx.x;
    LAS unsigned char* Us = lds;
    LAS f32x2* coef = (LAS f32x2*)(lds + 16384);
    const bf16_t* wrn = (const bf16_t*)(q->ws + W_RNN);
    const int per = (8 * NCHUNK + G - 1) / G;
    const int it0 = blk * per, it1 = (it0 + per) < 8 * NCHUNK ? (it0 + per) : 8 * NCHUNK;
    int gcur = -1; bf16x8 bfr[4][4];
    for (int it = it0; it < it1; ++it) {
        const int g = it / NCHUNK, ck = it % NCHUNK;
        if (skip_ctx && ck >= 512) continue;
        int t0, s0, s1;
        if (ck < 512) { const int b = ck >> 6, cc = ck & 63; s0 = b * 2048; s1 = s0 + 2048; t0 = s0 + cc * 32; }
        else { const int b = (ck - 512) >> 3, cc = (ck - 512) & 7; s0 = TL + b * 256; s1 = s0 + 256; t0 = s0 + cc * 32; }
        if (g != gcur) { gcur = g;
#pragma unroll
            for (int ty = 0; ty < 4; ++ty)
#pragma unroll
                for (int ks = 0; ks < 4; ++ks) bfr[ty][ks] = *(const bf16x8*)(wrn + ((size_t)(ty * 8 + g)) * 16384 + (size_t)(wave * 16 + cl) * 128 + ks * 32 + fq * 8); }
        { const int tok = tid >> 4, ch8 = (tid & 15) * 8, gc = g * 128 + ch8; float u[8];
          const float* cb = q->in[8] + l * 1024 + gc; const f32x4 b0 = *(const f32x4*)cb, b1 = *(const f32x4*)(cb + 4);
          u[0] = b0.x; u[1] = b0.y; u[2] = b0.z; u[3] = b0.w; u[4] = b1.x; u[5] = b1.y; u[6] = b1.z; u[7] = b1.w;
#pragma unroll
          for (int k = 0; k < 4; ++k) { const int t = t0 + tok + k - 2;
              if (t >= s0 && t < s1) { const u32x4 x = *(const u32x4*)(XR + (size_t)t * 1024 + gc); const float* cw = q->in[7] + (size_t)(l * 4 + k) * 1024 + gc; const f32x4 w0 = *(const f32x4*)cw, w1 = *(const f32x4*)(cw + 4);
                  u[0] += w0.x * bflo(x.x); u[1] += w0.y * bfhi(x.x); u[2] += w0.z * bflo(x.y); u[3] += w0.w * bfhi(x.y); u[4] += w1.x * bflo(x.z); u[5] += w1.y * bfhi(x.z); u[6] += w1.z * bflo(x.w); u[7] += w1.w * bfhi(x.w); } }
          u32x4 w; w.x = cvtpk(u[0], u[1]); w.y = cvtpk(u[2], u[3]); w.z = cvtpk(u[4], u[5]); w.w = cvtpk(u[6], u[7]); *(LAS u32x4*)(Us + tok * 272 + ch8 * 2) = w; }
        __syncthreads();
        f32x4 acc[4][2];
#pragma unroll
        for (int ty = 0; ty < 4; ++ty) { acc[ty][0] = (f32x4){0.f, 0.f, 0.f, 0.f}; acc[ty][1] = (f32x4){0.f, 0.f, 0.f, 0.f}; }
#pragma unroll
        for (int ks = 0; ks < 4; ++ks) {
            const bf16x8 a0 = *(const LAS bf16x8*)(Us + cl * 272 + (ks * 32 + fq * 8) * 2), a1 = *(const LAS bf16x8*)(Us + (16 + cl) * 272 + (ks * 32 + fq * 8) * 2);
#pragma unroll
            for (int ty = 0; ty < 4; ++ty) { acc[ty][0] = __builtin_amdgcn_mfma_f32_16x16x32_bf16(a0, bfr[ty][ks], acc[ty][0], 0, 0, 0); acc[ty][1] = __builtin_amdgcn_mfma_f32_16x16x32_bf16(a1, bfr[ty][ks], acc[ty][1], 0, 0, 0); } }
        { const int ch = wave * 16 + cl, gc = g * 128 + ch;
#pragma unroll
          for (int dir = 0; dir < 2; ++dir) { const int pi = (l * 2 + dir) * 1024 + gc; const float br = q->in[10][pi], bi = q->in[12][pi], lm = q->in[13][pi];
              const float lsl = -8.f * log1pf(__expf(-lm));
#pragma unroll
              for (int mt = 0; mt < 2; ++mt)
#pragma unroll
                  for (int r = 0; r < 4; ++r) { const int tok = mt * 16 + fq * 4 + r; const float u = bf2f(*(const LAS bf16_t*)(Us + tok * 272 + ch * 2));
                      const float rr = sigmoidf_(acc[dir * 2][mt][r] + br), ii = sigmoidf_(acc[dir * 2 + 1][mt][r] + bi); const float la = lsl * rr;
                      const float mult = sqrtf(fmaxf(1.f - __expf(2.f * la), 0.f)); coef[(dir * 32 + tok) * 128 + ch] = (f32x2){la * 1.4426950408889634f, mult * ii * u}; } } }
        __syncthreads();
        if (tid < 256) { const int dir = tid >> 7, ch = tid & 127, gc = g * 128 + ch;
            if (pass == 1) { float P2 = 0.f, h = 0.f;
                for (int s = 0; s < 32; ++s) { const int tok = dir ? 31 - s : s; const f32x2 cf = coef[(dir * 32 + tok) * 128 + ch]; h = __builtin_amdgcn_exp2f(cf.x) * h + cf.y; P2 += cf.x; }
                totals[((size_t)dir * NCHUNK + ck) * 1024 + gc] = (f32x2){P2, h}; }
            else { float h = carry[((size_t)dir * NCHUNK + ck) * 1024 + gc];
                for (int s = 0; s < 32; ++s) { const int tok = dir ? 31 - s : s; const f32x2 cf = coef[(dir * 32 + tok) * 128 + ch]; h = __builtin_amdgcn_exp2f(cf.x) * h + cf.y; coef[(dir * 32 + tok) * 128 + ch].y = h; } } }
        if (pass == 2) {
            __syncthreads();
            const int tok = tid >> 4, ch8 = (tid & 15) * 8, gc = g * 128 + ch8; const size_t off = (size_t)(t0 + tok) * 1024 + gc;
            const u32x4 gr = *(const u32x4*)(GR + off); float y[8];
            const float gv[8] = {bflo(gr.x), bfhi(gr.x), bflo(gr.y), bfhi(gr.y), bflo(gr.z), bfhi(gr.z), bflo(gr.w), bfhi(gr.w)};
#pragma unroll
            for (int e = 0; e < 8; ++e) { const float hs = coef[(0 * 32 + tok) * 128 + ch8 + e].y + coef[(1 * 32 + tok) * 128 + ch8 + e].y; y[e] = hs * gelu_tanh(gv[e]); }
            u32x4 w; w.x = cvtpk(y[0], y[1]); w.y = cvtpk(y[2], y[3]); w.z = cvtpk(y[4], y[5]); w.w = cvtpk(y[6], y[7]); *(u32x4*)(Ya + off) = w;
        }
        __syncthreads();
    }
}

DEVINL void phase_rnn_carry() {
    PP q = get_params(); const f32x2* totals = (const f32x2*)(q->ws + WS_S3); float* carry = (float*)(q->ws + WS_S4);
    const int gtid = blockIdx.x * 512 + opaque_tid();
    if (gtid >= NB * 2 * 1024) return;
    const int b = gtid >> 11, dir = (gtid >> 10) & 1, gc = gtid & 1023;
    float st = 0.f;
    for (int s = 0; s < 72; ++s) { int ck; if (s < 8) { const int cc = dir ? 7 - s : s; ck = 512 + b * 8 + cc; } else { const int cc = dir ? 63 - (s - 8) : (s - 8); ck = b * 64 + cc; }
        const size_t idx = ((size_t)dir * NCHUNK + ck) * 1024 + gc; carry[idx] = st; const f32x2 t = totals[idx]; st = __builtin_amdgcn_exp2f(t.x) * st + t.y; }
}

DEVINL void phase_attn(LAS unsigned char* lds, int l, bool do_ctx) {
    PP q = get_params(); bf16_t* Q = (bf16_t*)(q->ws + WS_S1); const bf16_t* K = (const bf16_t*)(q->ws + WS_S2); const bf16_t* VT = (const bf16_t*)(q->ws + WS_S3);
    const int tid = opaque_tid(), lane = tid & 63, wave = __builtin_amdgcn_readfirstlane(tid >> 6), r32 = lane & 31, hi = lane >> 5;
    const int G = gridDim.x, blk = blockIdx.x;
    const float* lv = q->in[14] + l * 256;
    const float s1 = wave_sum(lv[lane] * lv[64 + lane]), s2 = wave_sum(lv[128 + lane] * lv[192 + lane]);
    const float lam_init = 0.8f - 0.6f * expf(-0.3f * (float)l); const float lam = expf(s1) - expf(s2) + lam_init;
    const int nit = 1024 + (do_ctx ? 128 : 0);
    const int c = wave >> 2, qs = wave & 3;
    const int kperm = (r32 & ~12) | ((r32 & 4) << 1) | ((r32 & 8) >> 1);
    constexpr int STG = 35840, VOFF = 17408;
    for (int item = blk; item < nit; item += G) {
        int b, h, q0, kt0;
        if (item < 1024) { b = item >> 7; h = (item >> 4) & 7; q0 = b * 2048 + (item & 15) * 128; kt0 = 0; }
        else { const int j = item - 1024; b = j >> 4; h = (j >> 1) & 7; q0 = TL + b * 256 + (j & 1) * 128; kt0 = 32; }
        const int tq = q0 + qs * 32 + r32;
        bf16x8 qf[4];
#pragma unroll
        for (int ks = 0; ks < 4; ++ks) qf[ks] = *(const bf16x8*)(Q + (size_t)tq * 1024 + h * 128 + c * 64 + ks * 16 + hi * 8);
        f32x16 O[4];
#pragma unroll
        for (int n = 0; n < 4; ++n)
#pragma unroll
            for (int i = 0; i < 16; ++i) O[n][i] = 0.f;
        float mrun = -1e30f, lsum = 0.f;
        const int kkey = tid >> 3, kpart = tid & 7, vvd = tid >> 2, vpart = tid & 3;
        u32x4 kr0, kr1, vr0, vr1;
#define ATT_LOAD(kt) do { const int tk_ = ((kt) < 32 ? b * 2048 + (kt) * 64 : TL + b * 256 + ((kt) - 32) * 64) + kkey; const bf16_t* ks_ = K + (size_t)tk_ * 1024 + h * 128 + kpart * 16; \
            kr0 = *(const u32x4*)ks_; kr1 = *(const u32x4*)(ks_ + 8); const bf16_t* vs_ = VT + ((size_t)(b * 1024 + h * 128 + vvd)) * 2304 + (kt) * 64 + vpart * 16; vr0 = *(const u32x4*)vs_; vr1 = *(const u32x4*)(vs_ + 8); } while (0)
#define ATT_STORE(s) do { LAS unsigned char* kb_ = lds + (s) * STG + kkey * 272 + kpart * 32; *(LAS u32x4*)kb_ = kr0; *(LAS u32x4*)(kb_ + 16) = kr1; \
            LAS unsigned char* vb_ = lds + (s) * STG + VOFF + vvd * 144 + vpart * 32; *(LAS u32x4*)vb_ = vr0; *(LAS u32x4*)(vb_ + 16) = vr1; } while (0)
        ATT_LOAD(kt0); ATT_STORE(0);
        __syncthreads();
        for (int kt = kt0; kt < 36; ++kt) {
            const int cur = (kt - kt0) & 1;
            if (kt + 1 < 36) ATT_LOAD(kt + 1);
            const LAS unsigned char* Kb = lds + cur * STG; const LAS unsigned char* Vb = Kb + VOFF;
            f32x16 S0, S1;
#pragma unroll
            for (int i = 0; i < 16; ++i) { S0[i] = 0.f; S1[i] = 0.f; }
#pragma unroll
            for (int ks = 0; ks < 4; ++ks) { const bf16x8 k0 = *(const LAS bf16x8*)(Kb + kperm * 272 + (c * 64 + ks * 16 + hi * 8) * 2), k1 = *(const LAS bf16x8*)(Kb + (32 + kperm) * 272 + (c * 64 + ks * 16 + hi * 8) * 2);
                S0 = __builtin_amdgcn_mfma_f32_32x32x16_bf16(k0, qf[ks], S0, 0, 0, 0); S1 = __builtin_amdgcn_mfma_f32_32x32x16_bf16(k1, qf[ks], S1, 0, 0, 0); }
            float mx = S0[0];
#pragma unroll
            for (int i = 1; i < 16; ++i) mx = fmaxf(mx, S0[i]);
#pragma unroll
            for (int i = 0; i < 16; ++i) mx = fmaxf(mx, S1[i]);
            mx = fmaxf(mx, __shfl_xor(mx, 32));
            const float mnew = fmaxf(mrun, mx), alpha = __builtin_amdgcn_exp2f(mrun - mnew); mrun = mnew;
            float ps = 0.f;
#pragma unroll
            for (int i = 0; i < 16; ++i) { S0[i] = __builtin_amdgcn_exp2f(S0[i] - mnew); S1[i] = __builtin_amdgcn_exp2f(S1[i] - mnew); ps += S0[i] + S1[i]; }
            lsum = lsum * alpha + ps;
#pragma unroll
            for (int n = 0; n < 4; ++n)
#pragma unroll
                for (int i = 0; i < 16; ++i) O[n][i] *= alpha;
            bf16x8 pf[2][2];
#pragma unroll
            for (int s = 0; s < 2; ++s) { u32x4 w0, w1;
                w0.x = cvtpk(S0[8 * s + 0], S0[8 * s + 1]); w0.y = cvtpk(S0[8 * s + 2], S0[8 * s + 3]); w0.z = cvtpk(S0[8 * s + 4], S0[8 * s + 5]); w0.w = cvtpk(S0[8 * s + 6], S0[8 * s + 7]);
                w1.x = cvtpk(S1[8 * s + 0], S1[8 * s + 1]); w1.y = cvtpk(S1[8 * s + 2], S1[8 * s + 3]); w1.z = cvtpk(S1[8 * s + 4], S1[8 * s + 5]); w1.w = cvtpk(S1[8 * s + 6], S1[8 * s + 7]);
                pf[0][s] = __builtin_bit_cast(bf16x8, w0); pf[1][s] = __builtin_bit_cast(bf16x8, w1); }
#pragma unroll
            for (int n = 0; n < 4; ++n)
#pragma unroll
                for (int sub = 0; sub < 2; ++sub)
#pragma unroll
                    for (int s = 0; s < 2; ++s) { const bf16x8 vf = *(const LAS bf16x8*)(Vb + (n * 32 + r32) * 144 + (sub * 32 + s * 16 + hi * 8) * 2);
                        O[n] = __builtin_amdgcn_mfma_f32_32x32x16_bf16(vf, pf[sub][s], O[n], 0, 0, 0); }
            if (kt + 1 < 36) ATT_STORE(cur ^ 1);
            __syncthreads();
        }
#undef ATT_LOAD
#undef ATT_STORE
        lsum += __shfl_xor(lsum, 32);
        const float inv = 1.f / lsum;
        LAS float* xb = (LAS float*)lds + qs * (32 * 132) + r32 * 132;
        if (c == 1) { const float f = inv * lam;
#pragma unroll
            for (int n = 0; n < 4; ++n)
#pragma unroll
                for (int gq = 0; gq < 4; ++gq) { const int vd = n * 32 + 8 * gq + 4 * hi; *(LAS f32x4*)(xb + vd) = (f32x4){O[n][4 * gq] * f, O[n][4 * gq + 1] * f, O[n][4 * gq + 2] * f, O[n][4 * gq + 3] * f}; } }
        __syncthreads();
        if (c == 0) { float ss = 0.f;
#pragma unroll
            for (int n = 0; n < 4; ++n)
#pragma unroll
                for (int gq = 0; gq < 4; ++gq) { const int vd = n * 32 + 8 * gq + 4 * hi; const f32x4 o1 = *(const LAS f32x4*)(xb + vd);
#pragma unroll
                    for (int j = 0; j < 4; ++j) { const float o = O[n][4 * gq + j] * inv - o1[j]; O[n][4 * gq + j] = o; ss += o * o; } }
            ss += __shfl_xor(ss, 32);
            const float rn = rsqrtf(ss * (1.f / 128.f) + EPS) * (1.f - lam_init);
            bf16_t* dst = Q + (size_t)tq * 1024 + h * 128;
#pragma unroll
            for (int n = 0; n < 4; ++n)
#pragma unroll
                for (int gq = 0; gq < 4; ++gq) { const int vd = n * 32 + 8 * gq + 4 * hi; u32x2 w; w.x = cvtpk(O[n][4 * gq] * rn, O[n][4 * gq + 1] * rn); w.y = cvtpk(O[n][4 * gq + 2] * rn, O[n][4 * gq + 3] * rn); *(u32x2*)(dst + vd) = w; } }
        __syncthreads();
    }
}

__global__ void __launch_bounds__(512) mega_fwd(Params p_unused) {
    extern __shared__ __attribute__((aligned(16))) unsigned char lds_raw[];
    LAS unsigned char* lds = (LAS unsigned char*)lds_raw;
    cg::grid_group grid = cg::this_grid();
#define GSETUP PP q = get_params(); unsigned char* ws = q->ws; const int G = gridDim.x, blk = blockIdx.x; (void)ws; (void)G; (void)blk
#define SL(i) (ws + WS_S0 + (size_t)(i) * SLOT)

    phase_init(lds);
    grid.sync();
    phase_modreduce();

#pragma unroll 1
    for (int l = 0; l < 2; ++l) {
        const bool last = (l == 1);
        const int nMt = last ? 64 : 72;
        phase_convert(lds, l);
        grid.sync();
        phase_modulate(l, 0, 1024, TT);
        grid.sync();
        {
            GSETUP; SchedG S{1, (const char*)SL(0), (const char*)(ws + W_RG), (char*)SL(1), (char*)SL(2), 1024, 1024, 72, 8, G, blk};
            gemm_phase(lds, GemmK{1024, 1024, 1024}, S, EpiStore{});
        }
        grid.sync();
        phase_rnn(lds, l, 1, false);
        grid.sync();
        phase_rnn_carry();
        grid.sync();
        phase_rnn(lds, l, 2, last);
        grid.sync();
        {
            GSETUP; SchedG S{0, (const char*)SL(0), (const char*)(ws + W_G), nullptr, nullptr, 1024, 1024, nMt, 4, G, blk};
            gemm_phase(lds, GemmK{1024, 1024, 1024}, S, EpiGate{(bf16_t*)SL(1), q->in[17] + l * 3072});
        }
        grid.sync();
        {
            GSETUP; SchedG S{0, (const char*)SL(3), (const char*)(ws + W_M), nullptr, nullptr, 1024, 1024, nMt, 4, G, blk};
            gemm_phase(lds, GemmK{1024, 1024, 1024}, S, EpiMerge{(const bf16_t*)SL(1), (bf16_t*)SL(4), 1});
        }
        grid.sync();
        {
            GSETUP; SchedG S{2, (const char*)(ws + W_Z), (const char*)SL(0), (char*)SL(1), (char*)SL(1) + 64 * MiB, 1024, 1024, 8, last ? 64 : 72, G, blk};
            gemm_phase(lds, GemmK{1024, 1024, 1024}, S, EpiStore{});
        }
        grid.sync();
        {
            GSETUP; SchedG S{4, (const char*)(ws + WS_T), (const char*)SL(1), (char*)SL(3), nullptr, 4096, 4096, 0, 0, G, blk};
            gemm_phase(lds, GemmK{4096, 4096, 4096}, S, EpiStore{});
        }
        if (!last) { GSETUP; SchedG Sc{5, (const char*)(ws + WS_TC), (const char*)SL(1) + 64 * MiB, (char*)SL(3), nullptr, 512, 512, 0, 0, G, (blk + 128) % G};
            gemm_phase(lds, GemmK{512, 512, 512}, Sc, EpiStore{}); }
        grid.sync();
        {
            GSETUP; SchedG S{0, (const char*)SL(0), (const char*)(ws + W_G + 2 * MiB), nullptr, nullptr, 1024, 1024, nMt, 4, G, blk};
            gemm_phase(lds, GemmK{1024, 1024, 1024}, S, EpiGate{(bf16_t*)SL(1), q->in[17] + l * 3072 + 1024});
        }
        grid.sync();
        {
            GSETUP; SchedG S{0, (const char*)SL(3), (const char*)(ws + W_M + 2 * MiB), nullptr, nullptr, 1024, 1024, nMt, 4, G, blk};
            gemm_phase(lds, GemmK{1024, 1024, 1024}, S, EpiMerge{(const bf16_t*)SL(1), (bf16_t*)SL(4), 0});
        }
        grid.sync();
        {
            GSETUP; SchedG S{0, (const char*)SL(0), (const char*)(ws + W_QK), nullptr, nullptr, 1024, 1024, 72, 8, G, blk};
            gemm_phase(lds, GemmK{1024, 1024, 1024}, S, EpiQK{(bf16_t*)SL(1), (bf16_t*)SL(2), (const float*)(ws + WS_COS), (const float*)(ws + WS_SIN)});
        }
        {
            GSETUP; SchedG Sv{3, (const char*)(ws + W_V), (const char*)SL(0), (char*)SL(3), nullptr, 1024, 1024, 4, 72, G, (G - 1) - blk};
            gemm_phase(lds, GemmK{1024, 1024, 1024}, Sv, EpiStore{});
        }
        grid.sync();
        phase_attn(lds, l, !last);
        grid.sync();
        {
            GSETUP; SchedG S{0, (const char*)SL(0), (const char*)(ws + W_G + 4 * MiB), nullptr, nullptr, 1024, 1024, nMt, 4, G, blk};
            gemm_phase(lds, GemmK{1024, 1024, 1024}, S, EpiGate{(bf16_t*)SL(2), q->in[17] + l * 3072 + 2048});
        }
        grid.sync();
        {
            GSETUP; SchedG S{0, (const char*)SL(1), (const char*)(ws + W_M + 4 * MiB), nullptr, nullptr, 1024, 1024, nMt, 4, G, blk};
            gemm_phase(lds, GemmK{1024, 1024, 1024}, S, EpiMerge{(const bf16_t*)SL(2), (bf16_t*)SL(4), 0});
        }
        grid.sync();
        {
            GSETUP; SchedG S{0, (const char*)SL(4), (const char*)(ws + W_O), nullptr, nullptr, 1024, 1024, nMt, 4, G, blk};
            gemm_phase(lds, GemmK{1024, 1024, 1024}, S, EpiResid{q->out, (float*)(ws + WS_XCTX), (const float*)(ws + WS_MOD) + (size_t)l * 9 * NMOD + 2048});
        }
        grid.sync();
        phase_modulate(l, 3072, 4096, last ? TL : TT);
        grid.sync();
        {
            GSETUP; SchedG S{0, (const char*)SL(0), (const char*)(ws + W_13), nullptr, nullptr, 1024, 1024, nMt, 22, G, blk};
            gemm_phase(lds, GemmK{1024, 1024, 1024}, S, EpiSwiGLU{(bf16_t*)SL(1)});
        }
        grid.sync();
        {
            GSETUP; SchedG S{0, (const char*)SL(1), (const char*)(ws + W_2), nullptr, nullptr, DFF, DFF, nMt, 4, G, blk};
            gemm_phase(lds, GemmK{DFF, DFF, DFF}, S, EpiResid{q->out, (float*)(ws + WS_XCTX), (const float*)(ws + WS_MOD) + (size_t)l * 9 * NMOD + 5120});
        }
        grid.sync();
    }
    phase_final();
}

extern "C" void kernel_launch(void* const* d_in, const int* in_sizes, int n_in, void* d_out, int out_size, void* d_ws, size_t ws_size, hipStream_t stream) {
    static int grid = 0;
    if (grid == 0) {
        int dev = 0, cus = 0, per_cu = 0;
        (void)hipGetDevice(&dev);
        (void)hipDeviceGetAttribute(&cus, hipDeviceAttributeMultiprocessorCount, dev);
        (void)hipFuncSetAttribute((const void*)mega_fwd, hipFuncAttributeMaxDynamicSharedMemorySize, LDS_BYTES);
        (void)hipOccupancyMaxActiveBlocksPerMultiprocessor(&per_cu, (const void*)mega_fwd, 512, LDS_BYTES);
        if (per_cu < 1) { fprintf(stderr, "kernel_launch: occupancy query says %d blocks per CU\n", per_cu); per_cu = 1; }
        if (per_cu > 1) per_cu = 1;
        grid = cus * per_cu;
        if (n_in != 23 || ws_size < 253 * MiB) fprintf(stderr, "kernel_launch: unexpected n_in %d / ws_size %zu\n", n_in, ws_size);
    }
    Params p{};
    for (int i = 0; i < 23; ++i) p.in[i] = (const float*)d_in[i];
    p.out = (float*)d_out; p.ws = (unsigned char*)d_ws;
    void* args[] = {&p};
    hipError_t e = hipLaunchCooperativeKernel((const void*)mega_fwd, dim3(grid), dim3(512), args, LDS_BYTES, stream);
    if (e != hipSuccess) fprintf(stderr, "cooperative launch failed: %s (grid %d)\n", hipGetErrorString(e), grid);
}
```

```cpp
#include <hip/hip_runtime.h>
#include <hip/hip_cooperative_groups.h>
#include <cstdio>
#include <cstdint>
namespace cg = cooperative_groups;
#define PROBE 0
#define DT(a, b) ((float)(ts[b] - ts[a]) * 1e-4f)
#define PROBE_EXPR x1 = DT(2 + 20, 2 + 21); x2 = DT(2 + 21, 2 + 22);

#define LAS __attribute__((address_space(3)))
#define DEVINL __device__ __forceinline__
typedef unsigned short bf16_t;
typedef short bf16x8 __attribute__((ext_vector_type(8)));
typedef float f32x2 __attribute__((ext_vector_type(2)));
typedef float f32x4 __attribute__((ext_vector_type(4)));
typedef float f32x16 __attribute__((ext_vector_type(16)));
typedef unsigned u32x2 __attribute__((ext_vector_type(2)));
typedef unsigned u32x4 __attribute__((ext_vector_type(4)));
typedef __bf16 bf16x2_t __attribute__((ext_vector_type(2)));

constexpr int DM = 1024, NB = 8, SEQ = 2048, CTX = 256, TL = NB * SEQ, TC = NB * CTX, TT = TL + TC;
constexpr int DFF = 2816, NMOD = 6144;
constexpr float EPS = 1e-6f;
constexpr float C2 = 0.125f * 1.4426950408889634f;

constexpr size_t MiB = 1u << 20;
constexpr size_t WS_MOD = 0;
constexpr size_t WS_COS = 512 * 1024, WS_SIN = 768 * 1024;
constexpr size_t WS_BAR = 1536 * 1024;
constexpr size_t WS_XCTX = 2 * MiB;
constexpr size_t WS_T = 10 * MiB;
constexpr size_t WS_TC = 26 * MiB;
constexpr size_t WS_W = 27 * MiB;
constexpr size_t W_RG = WS_W, W_QK = WS_W + 4 * MiB, W_V = WS_W + 8 * MiB, W_Z = WS_W + 10 * MiB, W_G = WS_W + 14 * MiB,
                 W_M = WS_W + 20 * MiB, W_O = WS_W + 26 * MiB, W_13 = WS_W + 28 * MiB, W_2 = WS_W + 39 * MiB, W_RNN = WS_W + 44 * MiB + 512 * 1024;
constexpr size_t SLOT = 36 * MiB;
constexpr size_t WS_S0 = 73 * MiB, WS_S1 = WS_S0 + SLOT, WS_S2 = WS_S1 + SLOT, WS_S3 = WS_S2 + SLOT, WS_S4 = WS_S3 + SLOT;
constexpr int LDS_BYTES = 131072 + 8192;
constexpr size_t WS_CNT = WS_BAR + 16384;
constexpr size_t WS_ALT16 = WS_T + 12 * MiB + 128 * 1024;
constexpr size_t WS_XSTAT = WS_T + 13 * MiB;

struct Params { const float* in[23]; float* out; unsigned char* ws; };

DEVINL unsigned cvtpk(float lo, float hi) { f32x2 v = {lo, hi}; bf16x2_t b = __builtin_convertvector(v, bf16x2_t); return __builtin_bit_cast(unsigned, b); }
DEVINL float bf2f(unsigned short b) { return __builtin_bit_cast(float, (unsigned)b << 16); }
DEVINL float bflo(unsigned w) { return __builtin_bit_cast(float, w << 16); }
DEVINL float bfhi(unsigned w) { return __builtin_bit_cast(float, w & 0xffff0000u); }
DEVINL void bf8_unpack(const u32x4 x, float* f) { f[0] = bflo(x.x); f[1] = bfhi(x.x); f[2] = bflo(x.y); f[3] = bfhi(x.y); f[4] = bflo(x.z); f[5] = bfhi(x.z); f[6] = bflo(x.w); f[7] = bfhi(x.w); }
DEVINL u32x4 bf8_pack(const float* f) { u32x4 w; w.x = cvtpk(f[0], f[1]); w.y = cvtpk(f[2], f[3]); w.z = cvtpk(f[4], f[5]); w.w = cvtpk(f[6], f[7]); return w; }
DEVINL float shflx(float v, int mask, int lane) { return __builtin_bit_cast(float, __builtin_amdgcn_ds_bpermute((lane ^ mask) << 2, __builtin_bit_cast(int, v))); }
DEVINL float wave_sum(float v, int lane) {
#pragma unroll
    for (int o = 1; o < 64; o <<= 1) v += shflx(v, o, lane);
    return v;
}
DEVINL float max3f_(float a, float b, float c) { float r; asm("v_max3_f32 %0, %1, %2, %3" : "=v"(r) : "v"(a), "v"(b), "v"(c)); return r; }
DEVINL float sigmoidf_(float x) { return __builtin_amdgcn_rcpf(1.f + __expf(-x)); }
DEVINL float gelu_tanh(float x) { const float u = 0.7978845608028654f * (x + 0.044715f * x * x * x); const float e = __expf(2.f * u); const float t = 1.f - 2.f * __builtin_amdgcn_rcpf(e + 1.f); return 0.5f * x * (1.f + t); }
#define LDS_WAIT() asm volatile("s_waitcnt lgkmcnt(0)" ::: "memory")
DEVINL void st16_wt(void* p, u32x4 v) { asm volatile("global_store_dwordx4 %0, %1, off sc1\n\ts_nop 1" :: "v"(p), "v"(v) : "memory"); }
#define LDS_BARRIER() asm volatile("s_waitcnt lgkmcnt(0)\n\ts_barrier" ::: "memory")
DEVINL int opaque_tid() { int t = threadIdx.x; asm volatile("" : "+v"(t)); return t; }
DEVINL int opaque_blk() { int t = blockIdx.x; asm volatile("" : "+s"(t)); return t; }
typedef const __attribute__((address_space(4))) Params* PP;
DEVINL PP get_params() { PP q = (PP)__builtin_amdgcn_kernarg_segment_ptr(); asm volatile("" : "+s"(q)); return q; }

constexpr int BM = 256, BK = 64, HALF = 128, HTB = HALF * BK * 2;
DEVINL int lds_byte(int r, int c) { const int st = (r >> 4) * 2 + (c >> 5), rr = r & 15, cc = c & 31, ob = rr * 64 + cc * 2; return st * 1024 + (ob ^ (((ob >> 9) & 1) << 5)); }
DEVINL void stage_rc(int b, int& R, int& C) { const int st = b / 1024, sb = b % 1024, swz = sb ^ (((sb >> 9) & 1) << 5); R = (st >> 1) * 16 + swz / 64; C = (st & 1) * 32 + (swz % 64) / 2; }
DEVINL int perm32(int rho) { const int n = rho >> 4, i = rho & 15; return 8 * (i >> 2) + 4 * n + (i & 3); }

struct Unit { const char* a; const char* b; char* o; int ldo, pm, pn; };
struct GemmK { int lda, ldb, K; };

DEVINL bool tile_order(int i, int G, int c, int nM, int nN, int& pm, int& pn) {
    const long L = (long)i * G + c; const int nwg = nM * nN; if (L >= nwg) return false;
    int wgid = (int)L; { const int q = nwg / 8, r = nwg % 8, xcd = wgid % 8, off = wgid / 8; wgid = (xcd < r ? xcd * (q + 1) : r * (q + 1) + (xcd - r) * q) + off; }
    const int nig = 8 * nN, gid = wgid / nig, fm = gid * 8, gsz = (nM - fm) < 8 ? (nM - fm) : 8;
    pm = fm + ((wgid % nig) % gsz); pn = (wgid % nig) / gsz; return true;
}

struct SchedG {
    int kind; const char* A; const char* B; char* O; char* O2; int lda, ldb, nM, nN, G, c, pm0;
    DEVINL bool next(int i, Unit& u) const {
        int pm, pn;
        if (kind >= 4 && kind < 9) {
            const long L = (long)i * G + c;
            if (kind == 7) {
                if (L >= 64) return false; const int Lc = (int)L; pm = Lc >> 3; const int b = Lc & 7, part = pm >> 2, j0 = (pm & 3) * 256; pn = b;
                u.a = A + (size_t)pm * 256 * 1024 * 2; u.b = B + ((size_t)TL + b * 256) * 1024 * 2; u.o = O2 + ((((size_t)b * 1024 + j0) * 2 + part) * 256) * 2; u.ldo = 512;
            } else if (kind == 6) {
                if (L < 256) { const int part = (int)L >> 7; pm = ((int)L >> 5) & 3; pn = (int)L & 31; const int b = pn >> 2, n0 = (pn & 3) * 256;
                    u.a = A + ((size_t)part * 1024 + pm * 256) * 1024 * 2; u.b = B + (size_t)part * 16 * MiB + (size_t)pn * 256 * 1024 * 2;
                    u.o = O + (size_t)part * 16 * MiB + (((size_t)b * 1024 + pm * 256) * 1024 + n0) * 2; u.ldo = 1024; pn += 32 * part; }
                else if (L < 256 + nN) { const int Lc = (int)L - 256; pm = Lc >> 3; const int b = Lc & 7, part = pm >> 2, j0 = (pm & 3) * 256; pn = b;
                    u.a = A + (size_t)pm * 256 * 1024 * 2; u.b = B - 2 * SLOT + ((size_t)TL + b * 256) * 1024 * 2;
                    u.o = O2 + ((((size_t)b * 1024 + j0) * 2 + part) * 256) * 2; u.ldo = 512; }
                else return false;
            } else if (kind == 8) {
                if (L >= 256) return false; const int part = (int)L >> 7, b = ((int)L >> 4) & 7; pm = ((int)L >> 2) & 3; pn = (int)L & 3;
                u.a = A + (size_t)part * 2 * MiB + (size_t)pm * 256 * 1024 * 2; u.b = B + (size_t)part * 16 * MiB + ((size_t)b * 1024 + pn * 256) * 1024 * 2;
                u.o = O + (size_t)part * 16 * MiB + (((size_t)b * 1024 + pm * 256) * 1024 + pn * 256) * 2; u.ldo = 1024; pn |= (b << 2) | (part << 5); }
            else { if (L >= 32) return false; const int b = (int)L >> 2; pm = 0; pn = (int)L & 3;
                u.a = A; u.b = B + ((size_t)b * 1024 + pn * 256) * 512 * 2; u.o = O + (((size_t)TL + b * 256) * 1024 + pn * 256) * 2; u.ldo = 1024; }
            u.pm = pm; u.pn = pn; return true;
        }
        if (kind == 10) {
            if (i == 0) { pm = (c & 7) * 8 + (c >> 5); pn = (c >> 3) & 3; }
            else if (i == 1 && nM == 72 && c < 32) { pm = 64 + (c & 7); pn = c >> 3; }
            else return false;
            u.pm = pm; u.pn = pn; u.a = A + (size_t)pm * 256 * lda * 2; u.b = B + (size_t)pn * 256 * ldb * 2; u.o = O; u.ldo = 1024; return true;
        }
        if (kind == 9) {
            int sub;
            if (pm0) {
                if (i < 2) { if (!tile_order(0, G, c, 64, nN, pm, pn)) return false; sub = i; }
                else if (i == 2 && c < 64) { const int p = c & 31; pm = 64 + (p >> 2); pn = p & 3; sub = (c < 32) ? 2 : 3; }
                else return false;
            } else { if (!tile_order(i >> 1, G, c, nM, nN, pm, pn)) return false; sub = i & 1; }
            u.pm = pm; u.pn = pn; u.ldo = sub; u.o = nullptr;
            u.a = ((sub & 1) ? (const char*)O : A) + (size_t)pm * 256 * lda * 2; u.b = ((sub & 1) ? (const char*)O2 : B) + (size_t)pn * 256 * ldb * 2; return true;
        }
        if (!tile_order(i, G, c, nM, nN, pm, pn)) return false;
        pm += pm0; u.pm = pm; u.pn = pn; u.a = A + (size_t)pm * 256 * lda * 2; u.b = B + (size_t)pn * 256 * ldb * 2; u.o = O; u.ldo = 1024;
        if (kind == 1) { u.o = (pn < 4 ? O : O2) + ((size_t)pm * 256 * 1024 + (pn & 3) * 256) * 2; }
        else if (kind == 2) {
            const int part = pm >> 2, j0 = (pm & 3) * 256;
            if (pn < 64) { const int b = pn >> 3, n0 = (pn & 7) * 256; u.o = O + ((((size_t)b * 1024 + j0) * 2 + part) * 2048 + n0) * 2; u.ldo = 4096; }
            else { const int b = pn - 64; u.o = O2 + ((((size_t)b * 1024 + j0) * 2 + part) * 256) * 2; u.ldo = 512; }
        } else if (kind == 3) {
            int b, key0; if (pn < 64) { b = pn >> 3; key0 = (pn & 7) * 256; } else { b = pn - 64; key0 = 2048; }
            u.o = O + (((size_t)b * 1024 + pm * 256) * 2304 + key0) * 2; u.ldo = 2304;
        }
        return true;
    }
};

typedef f32x4 AccT[2][2][4][2];
struct EpiStore {
    static constexpr bool FUSED = false;
    DEVINL void operator()(const AccT& acc, const Unit& u, int wr, int wc, int fr, int fq) const {
#pragma unroll
        for (int ai = 0; ai < 2; ++ai)
#pragma unroll
            for (int m = 0; m < 4; ++m) { bf16_t* rowp = (bf16_t*)u.o + (size_t)(ai * 128 + wr * 64 + m * 16 + fr) * u.ldo + wc * 32 + 8 * fq;
#pragma unroll
                for (int bj = 0; bj < 2; ++bj) { const f32x4 v0 = acc[ai][bj][m][0], v1 = acc[ai][bj][m][1]; u32x4 w;
                    w.x = cvtpk(v0[0], v0[1]); w.y = cvtpk(v0[2], v0[3]); w.z = cvtpk(v1[0], v1[1]); w.w = cvtpk(v1[2], v1[3]); *(u32x4*)(rowp + bj * 128) = w; } }
    }
};
struct EpiQK {
    static constexpr bool FUSED = false;
    bf16_t* Q; bf16_t* K; const float* cosT; const float* sinT;
    DEVINL void operator()(const AccT& acc, const Unit& u, int wr, int wc, int fr, int fq) const {
        const bool isq = u.pn < 4; bf16_t* base = isq ? Q : K; const float sc = isq ? C2 : 1.f;
        const int hp = (u.pn & 3) * 2 + (wc >> 1), c = wc & 1, jj0 = 8 * fq;
#pragma unroll
        for (int ai = 0; ai < 2; ++ai)
#pragma unroll
            for (int m = 0; m < 4; ++m) { const int t = u.pm * 256 + ai * 128 + wr * 64 + m * 16 + fr; const bool lat = t < TL; const int pos = t & 2047;
                bf16_t* dst = base + (size_t)t * 1024 + hp * 128 + c * 64 + jj0; f32x4 o1[2], o2[2];
#pragma unroll
                for (int n = 0; n < 2; ++n) { f32x4 cs = {1.f, 1.f, 1.f, 1.f}, sn = {0.f, 0.f, 0.f, 0.f};
                    if (lat) { cs = *(const f32x4*)(cosT + pos * 32 + jj0 + 4 * n); sn = *(const f32x4*)(sinT + pos * 32 + jj0 + 4 * n); }
                    const f32x4 t1 = acc[ai][0][m][n], t2 = acc[ai][1][m][n]; o1[n] = (t1 * cs - t2 * sn) * sc; o2[n] = (t1 * sn + t2 * cs) * sc; }
                u32x4 w; w.x = cvtpk(o1[0][0], o1[0][1]); w.y = cvtpk(o1[0][2], o1[0][3]); w.z = cvtpk(o1[1][0], o1[1][1]); w.w = cvtpk(o1[1][2], o1[1][3]); *(u32x4*)dst = w;
                w.x = cvtpk(o2[0][0], o2[0][1]); w.y = cvtpk(o2[0][2], o2[0][3]); w.z = cvtpk(o2[1][0], o2[1][1]); w.w = cvtpk(o2[1][2], o2[1][3]); *(u32x4*)(dst + 32) = w; }
    }
};
struct EpiGate {
    static constexpr bool FUSED = false;
    bf16_t* Gd; const float* bias; int wt;
    DEVINL void operator()(const AccT& acc, const Unit& u, int wr, int wc, int fr, int fq) const {
        const int col0 = u.pn * 256 + wc * 32 + 8 * fq;
#pragma unroll
        for (int bj = 0; bj < 2; ++bj) { const f32x4 b0 = *(const f32x4*)(bias + col0 + bj * 128), b1 = *(const f32x4*)(bias + col0 + bj * 128 + 4);
#pragma unroll
            for (int ai = 0; ai < 2; ++ai)
#pragma unroll
                for (int m = 0; m < 4; ++m) { const int t = u.pm * 256 + ai * 128 + wr * 64 + m * 16 + fr; const f32x4 v0 = acc[ai][bj][m][0] + b0, v1 = acc[ai][bj][m][1] + b1; u32x4 w;
                    w.x = cvtpk(sigmoidf_(v0[0]), sigmoidf_(v0[1])); w.y = cvtpk(sigmoidf_(v0[2]), sigmoidf_(v0[3])); w.z = cvtpk(sigmoidf_(v1[0]), sigmoidf_(v1[1])); w.w = cvtpk(sigmoidf_(v1[2]), sigmoidf_(v1[3]));
                    if (wt) st16_wt(Gd + (size_t)t * 1024 + col0 + bj * 128, w); else *(u32x4*)(Gd + (size_t)t * 1024 + col0 + bj * 128) = w; } }
    }
};
struct EpiMerge {
    static constexpr bool FUSED = false;
    const bf16_t* Gs; bf16_t* Md; int first;
    DEVINL void operator()(const AccT& acc, const Unit& u, int wr, int wc, int fr, int fq) const {
        const int col0 = u.pn * 256 + wc * 32 + 8 * fq;
#pragma unroll
        for (int ai = 0; ai < 2; ++ai)
#pragma unroll
            for (int m = 0; m < 4; ++m) { const int t = u.pm * 256 + ai * 128 + wr * 64 + m * 16 + fr;
#pragma unroll
                for (int bj = 0; bj < 2; ++bj) { const size_t off = (size_t)t * 1024 + col0 + bj * 128; const u32x4 g = *(const u32x4*)(Gs + off); const f32x4 v0 = acc[ai][bj][m][0], v1 = acc[ai][bj][m][1];
                    float r0 = bflo(g.x) * v0[0], r1 = bfhi(g.x) * v0[1], r2 = bflo(g.y) * v0[2], r3 = bfhi(g.y) * v0[3], r4 = bflo(g.z) * v1[0], r5 = bfhi(g.z) * v1[1], r6 = bflo(g.w) * v1[2], r7 = bfhi(g.w) * v1[3];
                    if (!first) { const u32x4 o = *(const u32x4*)(Md + off); r0 += bflo(o.x); r1 += bfhi(o.x); r2 += bflo(o.y); r3 += bfhi(o.y); r4 += bflo(o.z); r5 += bfhi(o.z); r6 += bflo(o.w); r7 += bfhi(o.w); }
                    u32x4 w; w.x = cvtpk(r0, r1); w.y = cvtpk(r2, r3); w.z = cvtpk(r4, r5); w.w = cvtpk(r6, r7); *(u32x4*)(Md + off) = w; } }
    }
};
struct EpiGateMerge {
    static constexpr bool FUSED = true;
    bf16_t* Gd; const float* bias; bf16_t* Md; int first; unsigned* cnt;
    DEVINL void operator()(AccT& acc, const Unit& u, int wr, int wc, int fr, int fq, LAS unsigned char* lds, int wid, int lane) const {
        (void)lds;
        const int role = u.ldo; unsigned* cw = cnt + 16 * ((u.pm - 64) * 4 + u.pn);
        if (role == 0) { EpiGate g{Gd, bias, 0}; g(acc, u, wr, wc, fr, fq); }
        else if (role == 2) { EpiGate g{Gd, bias, 1}; g(acc, u, wr, wc, fr, fq);
            asm volatile("s_waitcnt vmcnt(0)" ::: "memory");
            if (lane == 0) __hip_atomic_fetch_add(cw, 1u, __ATOMIC_RELAXED, __HIP_MEMORY_SCOPE_AGENT); }
        else {
            if (role == 3) {
                if (wid == 0) { unsigned spins = 0;
                    while ((unsigned)__builtin_amdgcn_readfirstlane((int)__hip_atomic_load(cw, __ATOMIC_RELAXED, __HIP_MEMORY_SCOPE_AGENT)) < 8u) { __builtin_amdgcn_s_sleep(2); if (++spins > (1u << 22)) break; }
                    __builtin_amdgcn_fence(__ATOMIC_ACQUIRE, "agent"); }
                asm volatile("s_waitcnt vmcnt(0) lgkmcnt(0)\n\ts_barrier" ::: "memory");
            }
            EpiMerge m{Gd, Md, first}; m(acc, u, wr, wc, fr, fq); }
    }
};
struct EpiResid {
    static constexpr bool FUSED = false;
    float* Xlat; float* Xctx; const float* gmod; const float* Rlat; const float* Rctx;
    DEVINL void operator()(const AccT& acc, const Unit& u, int wr, int wc, int fr, int fq) const {
        const int col0 = u.pn * 256 + wc * 32 + 8 * fq; const int mr = u.pm < 64 ? (u.pm >> 3) : 8;
        float* xb = u.pm < 64 ? Xlat + (size_t)u.pm * 256 * 1024 : Xctx + (size_t)(u.pm - 64) * 256 * 1024;
        const float* rb = u.pm < 64 ? Rlat + (size_t)u.pm * 256 * 1024 : Rctx + (size_t)(u.pm - 64) * 256 * 1024;
#pragma unroll
        for (int bj = 0; bj < 2; ++bj) { const f32x4 g0 = *(const f32x4*)(gmod + mr * NMOD + col0 + bj * 128), g1 = *(const f32x4*)(gmod + mr * NMOD + col0 + bj * 128 + 4);
#pragma unroll
            for (int ai = 0; ai < 2; ++ai)
#pragma unroll
                for (int m = 0; m < 4; ++m) { const size_t xo = (size_t)(ai * 128 + wr * 64 + m * 16 + fr) * 1024 + col0 + bj * 128; float* xp = xb + xo;
                    f32x4 x0 = *(const f32x4*)(rb + xo), x1 = *(const f32x4*)(rb + xo + 4); x0 += g0 * acc[ai][bj][m][0]; x1 += g1 * acc[ai][bj][m][1]; *(f32x4*)xp = x0; *(f32x4*)(xp + 4) = x1; } }
    }
};
struct EpiResidNorm {
    static constexpr bool FUSED = true;
    float* Xlat; float* Xctx; const float* gmod; const float* Rlat; const float* Rctx;
    int fuse; bf16_t* H; const float* nmod; int shoff, scoff; float* xstat; unsigned* cnt; const float* fg;
    DEVINL void operator()(AccT& acc, const Unit& u, int wr, int wc, int fr, int fq, LAS unsigned char* lds, int wid, int lane) const {
        const int col0 = u.pn * 256 + wc * 32 + 8 * fq; const int mr = u.pm < 64 ? (u.pm >> 3) : 8;
        float* xb = u.pm < 64 ? Xlat + (size_t)u.pm * 256 * 1024 : Xctx + (size_t)(u.pm - 64) * 256 * 1024;
        const float* rb = u.pm < 64 ? Rlat + (size_t)u.pm * 256 * 1024 : Rctx + (size_t)(u.pm - 64) * 256 * 1024;
#pragma unroll
        for (int bj = 0; bj < 2; ++bj) { const f32x4 g0 = *(const f32x4*)(gmod + mr * NMOD + col0 + bj * 128), g1 = *(const f32x4*)(gmod + mr * NMOD + col0 + bj * 128 + 4);
#pragma unroll
            for (int ai = 0; ai < 2; ++ai)
#pragma unroll
                for (int m = 0; m < 4; ++m) { const size_t xo = (size_t)(ai * 128 + wr * 64 + m * 16 + fr) * 1024 + col0 + bj * 128; float* xp = xb + xo;
                    f32x4 x0 = *(const f32x4*)(rb + xo), x1 = *(const f32x4*)(rb + xo + 4); x0 += g0 * acc[ai][bj][m][0]; x1 += g1 * acc[ai][bj][m][1];
                    acc[ai][bj][m][0] = x0; acc[ai][bj][m][1] = x1; if (!(fuse && fg)) { *(f32x4*)xp = x0; *(f32x4*)(xp + 4) = x1; } } }
        if (!fuse) return;
        LAS float* P = (LAS float*)(lds + 131072 + 1024);
        LAS float* S = (LAS float*)(lds + 131072 + 5120);
#pragma unroll
        for (int ai = 0; ai < 2; ++ai)
#pragma unroll
            for (int m = 0; m < 4; ++m) { float sq = 0.f;
#pragma unroll
                for (int bj = 0; bj < 2; ++bj)
#pragma unroll
                    for (int n = 0; n < 2; ++n) { const f32x4 x = acc[ai][bj][m][n]; sq += (x[0] * x[0] + x[1] * x[1]) + (x[2] * x[2] + x[3] * x[3]); }
                sq += shflx(sq, 16, lane); sq += shflx(sq, 32, lane);
                if (fq == 0) P[(ai * 128 + wr * 64 + m * 16 + fr) * 4 + wc] = sq; }
        LDS_BARRIER();
        const int row = wid * 32 + (lane & 31);
        if (lane < 32) { const float t = (P[row * 4 + 0] + P[row * 4 + 1]) + (P[row * 4 + 2] + P[row * 4 + 3]);
            __hip_atomic_store((unsigned*)xstat + ((size_t)(u.pm * 256 + row) * 4 + u.pn), __builtin_bit_cast(unsigned, t), __ATOMIC_RELAXED, __HIP_MEMORY_SCOPE_AGENT); }
        asm volatile("s_waitcnt vmcnt(0)" ::: "memory");
        if (lane == 0) __hip_atomic_fetch_add(cnt + 16 * u.pm, 1u, __ATOMIC_RELAXED, __HIP_MEMORY_SCOPE_AGENT);
        if (wid == 0) { unsigned spins = 0;
            while ((unsigned)__builtin_amdgcn_readfirstlane((int)__hip_atomic_load(cnt + 16 * u.pm, __ATOMIC_RELAXED, __HIP_MEMORY_SCOPE_AGENT)) < 32u) { __builtin_amdgcn_s_sleep(2); if (++spins > (1u << 22)) break; }
            __builtin_amdgcn_fence(__ATOMIC_ACQUIRE, "agent"); }
        asm volatile("s_waitcnt vmcnt(0) lgkmcnt(0)\n\ts_barrier" ::: "memory");
        if (lane < 32) { const unsigned* sl = (const unsigned*)xstat + (size_t)(u.pm * 256 + row) * 4; float tot = 0.f;
#pragma unroll
            for (int t = 0; t < 4; ++t) tot += __builtin_bit_cast(float, __hip_atomic_load(sl + t, __ATOMIC_RELAXED, __HIP_MEMORY_SCOPE_AGENT));
            S[row] = rsqrtf(tot * (1.f / 1024.f) + EPS); }
        LDS_BARRIER();
        if (fg) {
#pragma unroll
            for (int bj = 0; bj < 2; ++bj) { const f32x4 g0 = *(const f32x4*)(fg + col0 + bj * 128), g1 = *(const f32x4*)(fg + col0 + bj * 128 + 4);
#pragma unroll
                for (int ai = 0; ai < 2; ++ai)
#pragma unroll
                    for (int m = 0; m < 4; ++m) { const int r = ai * 128 + wr * 64 + m * 16 + fr; const float rinv = S[r]; float* xp = xb + (size_t)r * 1024 + col0 + bj * 128;
                        *(f32x4*)xp = acc[ai][bj][m][0] * rinv * g0; *(f32x4*)(xp + 4) = acc[ai][bj][m][1] * rinv * g1; } }
            return;
        }
#pragma unroll
        for (int bj = 0; bj < 2; ++bj) { const float* mp = nmod + mr * NMOD + col0 + bj * 128;
            const f32x4 sc0 = *(const f32x4*)(mp + scoff) + 1.f, sc1 = *(const f32x4*)(mp + scoff + 4) + 1.f, sh0 = *(const f32x4*)(mp + shoff), sh1 = *(const f32x4*)(mp + shoff + 4);
#pragma unroll
            for (int ai = 0; ai < 2; ++ai)
#pragma unroll
                for (int m = 0; m < 4; ++m) { const int r = ai * 128 + wr * 64 + m * 16 + fr; const float rinv = S[r];
                    const f32x4 y0 = acc[ai][bj][m][0] * rinv * sc0 + sh0, y1 = acc[ai][bj][m][1] * rinv * sc1 + sh1; u32x4 w;
                    w.x = cvtpk(y0[0], y0[1]); w.y = cvtpk(y0[2], y0[3]); w.z = cvtpk(y1[0], y1[1]); w.w = cvtpk(y1[2], y1[3]);
                    *(u32x4*)(H + (size_t)(u.pm * 256 + r) * 1024 + col0 + bj * 128) = w; } }
    }
};
struct EpiStoreAlt {
    static constexpr bool FUSED = false;
    float* alt16;
    DEVINL void operator()(const AccT& acc, const Unit& u, int wr, int wc, int fr, int fq) const {
        EpiStore st; st(acc, u, wr, wc, fr, fq);
        if (u.pn < 32) { const int b = u.pn >> 2, q4 = u.pn & 3, lane = fq * 16 + fr;
#pragma unroll
            for (int ai = 0; ai < 2; ++ai)
#pragma unroll
                for (int m = 0; m < 4; ++m) { float sa = 0.f;
#pragma unroll
                    for (int bj = 0; bj < 2; ++bj)
#pragma unroll
                        for (int n = 0; n < 2; ++n) { const f32x4 x = acc[ai][bj][m][n]; sa += (x[0] - x[1]) + (x[2] - x[3]); }
                    sa += shflx(sa, 16, lane); sa += shflx(sa, 32, lane);
                    if (fq == 0) alt16[((size_t)(b * 1024 + u.pm * 256 + ai * 128 + wr * 64 + m * 16 + fr)) * 16 + q4 * 4 + wc] = sa; } }
    }
};
struct EpiEO {
    static constexpr bool FUSED = true;
    bf16_t* EO; bf16_t* Yb; const float* zh; const float* alt16; unsigned* cnt; int fuse;
    DEVINL void operator()(AccT& acc, const Unit& u, int wr, int wc, int fr, int fq, LAS unsigned char* lds, int wid, int lane) const {
        (void)lds;
        const int pn = u.pn & 3, b = (u.pn >> 2) & 7, part = u.pn >> 5; const int col0 = pn * 256 + wc * 32 + 8 * fq;
        const size_t tbase = ((size_t)b * 1024 + u.pm * 256) * 1024 + col0;
        bf16_t* mine = EO + (size_t)part * 8 * MiB + tbase; const bf16_t* other = EO + (size_t)(part ^ 1) * 8 * MiB + tbase;
#pragma unroll
        for (int ai = 0; ai < 2; ++ai)
#pragma unroll
            for (int m = 0; m < 4; ++m) { const int row = ai * 128 + wr * 64 + m * 16 + fr;
#pragma unroll
                for (int bj = 0; bj < 2; ++bj) { const f32x4 v0 = acc[ai][bj][m][0], v1 = acc[ai][bj][m][1]; u32x4 w;
                    w.x = cvtpk(v0[0], v0[1]); w.y = cvtpk(v0[2], v0[3]); w.z = cvtpk(v1[0], v1[1]); w.w = cvtpk(v1[2], v1[3]);
                    if (fuse) st16_wt(mine + (size_t)row * 1024 + bj * 128, w); else *(u32x4*)(mine + (size_t)row * 1024 + bj * 128) = w; } }
        if (!fuse) return;
        unsigned* cw = cnt + 16 * ((b * 4 + u.pm) * 4 + pn);
        asm volatile("s_waitcnt vmcnt(0)" ::: "memory");
        if (lane == 0) __hip_atomic_fetch_add(cw, 1u, __ATOMIC_RELAXED, __HIP_MEMORY_SCOPE_AGENT);
        if (wid == 0) { unsigned spins = 0;
            while ((unsigned)__builtin_amdgcn_readfirstlane((int)__hip_atomic_load(cw, __ATOMIC_RELAXED, __HIP_MEMORY_SCOPE_AGENT)) < 16u) { __builtin_amdgcn_s_sleep(2); if (++spins > (1u << 22)) break; }
            __builtin_amdgcn_fence(__ATOMIC_ACQUIRE, "agent"); }
        asm volatile("s_waitcnt vmcnt(0) lgkmcnt(0)\n\ts_barrier" ::: "memory");
        constexpr float SC = 0.022097086912079608f;
#pragma unroll
        for (int bj = 0; bj < 2; ++bj) { const float* zp = zh + b * 1024 + col0 + bj * 128; const f32x4 z0 = *(const f32x4*)zp, z1 = *(const f32x4*)(zp + 4);
            const float zv[8] = {z0.x, z0.y, z0.z, z0.w, z1.x, z1.y, z1.z, z1.w};
#pragma unroll
            for (int ai = 0; ai < 2; ++ai)
#pragma unroll
                for (int m = 0; m < 4; ++m) { const int row = ai * 128 + wr * 64 + m * 16 + fr, k = u.pm * 256 + row; const float sg = (k & 1) ? -SC : SC;
                    float ov[8], y[8]; bf8_unpack(*(const u32x4*)(other + (size_t)row * 1024 + bj * 128), ov);
                    const f32x4 a0 = acc[ai][bj][m][0], a1 = acc[ai][bj][m][1]; const float av[8] = {a0[0], a0[1], a0[2], a0[3], a1[0], a1[1], a1[2], a1[3]};
                    int dest;
                    if (part == 0) { dest = k;
#pragma unroll
                        for (int e = 0; e < 8; ++e) y[e] = (av[e] + sg * zv[e]) - ov[e]; }
                    else if (k != 0) { dest = 2048 - k;
#pragma unroll
                        for (int e = 0; e < 8; ++e) y[e] = (ov[e] + sg * zv[e]) + av[e]; }
                    else { dest = 1024;
#pragma unroll
                        for (int e = 0; e < 8; ++e) { const float* ap = alt16 + ((size_t)(b * 1024 + col0 + bj * 128 + e)) * 16; float al = 0.f;
#pragma unroll
                            for (int t = 0; t < 16; ++t) al += ap[t];
                            y[e] = SC * (zv[e] + al); } }
                    *(u32x4*)(Yb + ((size_t)b * 2048 + dest) * 1024 + col0 + bj * 128) = bf8_pack(y); } }
    }
};
struct EpiSwiGLU {
    static constexpr bool FUSED = false;
    bf16_t* Ud;
    DEVINL void operator()(const AccT& acc, const Unit& u, int wr, int wc, int fr, int fq) const {
        const int col0 = u.pn * 128 + wc * 32 + 8 * fq;
#pragma unroll
        for (int ai = 0; ai < 2; ++ai)
#pragma unroll
            for (int m = 0; m < 4; ++m) { const int t = u.pm * 256 + ai * 128 + wr * 64 + m * 16 + fr; float r[8];
#pragma unroll
                for (int n = 0; n < 2; ++n)
#pragma unroll
                    for (int j = 0; j < 4; ++j) { const float a = acc[ai][0][m][n][j], b = acc[ai][1][m][n][j]; r[n * 4 + j] = a * sigmoidf_(a) * b; }
                u32x4 w; w.x = cvtpk(r[0], r[1]); w.y = cvtpk(r[2], r[3]); w.z = cvtpk(r[4], r[5]); w.w = cvtpk(r[6], r[7]); *(u32x4*)(Ud + (size_t)t * DFF + col0) = w; }
    }
};

template <class Epi, class Sched>
DEVINL void gemm_phase(LAS unsigned char* lds, const GemmK g, const Sched& S, const Epi& E) {
    const int tid = opaque_tid(), wid = __builtin_amdgcn_readfirstlane(tid >> 6), lane = tid & 63, wr = wid >> 2, wc = wid & 3, fr = lane & 15, fq = lane >> 4;
    const int nt = g.K / BK;
    unsigned voffA[2], voffB[2];
#pragma unroll
    for (int i = 0; i < 2; ++i) { int R, C; stage_rc(tid * 16 + i * 8192, R, C); const int Rb = (R & ~31) + perm32(R & 31);
        voffA[i] = (unsigned)(R * g.lda + C) * 2u; voffB[i] = (unsigned)(Rb * g.ldb + C) * 2u; }
    const size_t kstep = (size_t)(BK * 2);
    const size_t hstepA = (size_t)HALF * g.lda * 2, hstepB = (size_t)HALF * g.ldb * 2;
    const unsigned ldsw = (unsigned)wid * 1024u;
    const int aoff = lds_byte(wr * 64 + fr, fq * 8), boff = lds_byte(wc * 32 + fr, fq * 8);
#define PG8_SA(b, h) (((b) * 2 + (h)) * HTB)
#define PG8_SB(b, h) ((4 + (b) * 2 + (h)) * HTB)
#define PG8_STAGE(bufoff, gbase, voff) do { _Pragma("unroll") for (int _i = 0; _i < 2; ++_i) \
        __builtin_amdgcn_global_load_lds((const unsigned*)((const char*)(gbase) + (voff)[_i]), (LAS unsigned*)(lds + (bufoff) + ldsw + _i * 8192), 16, 0, 0); } while (0)
#define PG8_LDA(dst, b, h) do { _Pragma("unroll") for (int m = 0; m < 4; ++m) _Pragma("unroll") for (int k = 0; k < 2; ++k) dst[m][k] = *(const LAS bf16x8*)(lds + PG8_SA(b, h) + aoff + m * 2048 + k * 1024); } while (0)
#define PG8_LDB(dst, b, h) do { _Pragma("unroll") for (int n = 0; n < 2; ++n) _Pragma("unroll") for (int k = 0; k < 2; ++k) dst[n][k] = *(const LAS bf16x8*)(lds + PG8_SB(b, h) + boff + n * 2048 + k * 1024); } while (0)
#define PG8_MMA(ai, bj, At, Bt) do { __builtin_amdgcn_s_setprio(1); _Pragma("unroll") for (int m = 0; m < 4; ++m) _Pragma("unroll") for (int n = 0; n < 2; ++n) _Pragma("unroll") for (int k = 0; k < 2; ++k) \
        acc[ai][bj][m][n] = __builtin_amdgcn_mfma_f32_16x16x32_bf16(Bt[n][k], At[m][k], acc[ai][bj][m][n], 0, 0, 0); __builtin_amdgcn_s_setprio(0); } while (0)
#define PG8_WAIT_V(n) asm volatile("s_waitcnt vmcnt(" #n ")" ::: "memory")
#define PG8_WAIT_L(n) asm volatile("s_waitcnt lgkmcnt(" #n ")" ::: "memory")
#define PG8_BAR __builtin_amdgcn_s_barrier()
#define PG8_SCHED __builtin_amdgcn_sched_barrier(0)
    Unit cur, nxt; int ui = 0;
    if (!S.next(0, cur)) return;
    f32x4 acc[2][2][4][2];
#pragma unroll
    for (int a = 0; a < 2; ++a)
#pragma unroll
        for (int b = 0; b < 2; ++b)
#pragma unroll
            for (int m = 0; m < 4; ++m)
#pragma unroll
                for (int n = 0; n < 2; ++n) acc[a][b][m][n] = (f32x4){0.f, 0.f, 0.f, 0.f};
    bf16x8 At[4][2], B0[2][2], B1[2][2];
    const char* cA = cur.a; const char* cB = cur.b;
    PG8_STAGE(PG8_SB(0, 0), cB, voffB); PG8_STAGE(PG8_SB(0, 1), cB + hstepB, voffB); PG8_STAGE(PG8_SA(0, 0), cA, voffA); PG8_STAGE(PG8_SA(0, 1), cA + hstepA, voffA);
    if (wr == 1) PG8_BAR;
    PG8_WAIT_V(2); PG8_BAR;
    PG8_STAGE(PG8_SB(1, 0), cB + kstep, voffB); PG8_STAGE(PG8_SA(1, 0), cA + kstep, voffA); PG8_STAGE(PG8_SB(1, 1), cB + hstepB + kstep, voffB);
    PG8_WAIT_V(6); PG8_BAR;
    for (;;) {
        const bool has_next = S.next(ui + 1, nxt);
        const char* nA = has_next ? nxt.a : cA; const char* nB = has_next ? nxt.b : cB;
        for (int t = 0; t < nt; t += 2) {
            const bool last = (t == nt - 2);
            const char* a1 = cA + (size_t)(t + 1) * kstep;
            const char* a2 = last ? nA : cA + (size_t)(t + 2) * kstep; const char* b2 = last ? nB : cB + (size_t)(t + 2) * kstep;
            const char* a3 = a2 + kstep; const char* b3 = b2 + kstep;
            PG8_LDB(B0, 0, 0); PG8_LDB(B1, 0, 1); PG8_SCHED; PG8_LDA(At, 0, 0); PG8_STAGE(PG8_SA(1, 1), a1 + hstepA, voffA);
            PG8_WAIT_V(8); PG8_WAIT_L(0); PG8_BAR; PG8_MMA(0, 0, At, B0); PG8_MMA(0, 1, At, B1); PG8_BAR; PG8_SCHED;
            PG8_LDA(At, 0, 1); PG8_STAGE(PG8_SB(0, 0), b2, voffB); PG8_STAGE(PG8_SB(0, 1), b2 + hstepB, voffB); PG8_STAGE(PG8_SA(0, 0), a2, voffA);
            PG8_WAIT_V(8); PG8_WAIT_L(0); PG8_BAR; PG8_MMA(1, 0, At, B0); PG8_MMA(1, 1, At, B1); PG8_BAR; PG8_SCHED;
            PG8_LDB(B0, 1, 0); PG8_LDB(B1, 1, 1); PG8_SCHED; PG8_LDA(At, 1, 0); PG8_STAGE(PG8_SA(0, 1), a2 + hstepA, voffA);
            PG8_WAIT_V(8); PG8_WAIT_L(0); PG8_BAR; PG8_MMA(0, 0, At, B0); PG8_MMA(0, 1, At, B1); PG8_BAR; PG8_SCHED;
            PG8_LDA(At, 1, 1); PG8_STAGE(PG8_SB(1, 0), b3, voffB); PG8_STAGE(PG8_SB(1, 1), b3 + hstepB, voffB); PG8_STAGE(PG8_SA(1, 0), a3, voffA);
            PG8_WAIT_V(8); PG8_WAIT_L(0); PG8_BAR; PG8_MMA(1, 0, At, B0); PG8_MMA(1, 1, At, B1); PG8_BAR; PG8_SCHED;
        }
        if (wr == 0) PG8_BAR;
        { int fr2 = fr, fq2 = fq; asm volatile("" : "+v"(fr2), "+v"(fq2));
          if constexpr (Epi::FUSED) E(acc, cur, wr, wc, fr2, fq2, lds, wid, lane); else E(acc, cur, wr, wc, fr2, fq2); }
        if (!has_next) break;
#pragma unroll
        for (int a = 0; a < 2; ++a)
#pragma unroll
            for (int b = 0; b < 2; ++b)
#pragma unroll
                for (int m = 0; m < 4; ++m)
#pragma unroll
                    for (int n = 0; n < 2; ++n) acc[a][b][m][n] = (f32x4){0.f, 0.f, 0.f, 0.f};
        cur = nxt; cA = nA; cB = nB; ++ui;
        if (wr == 1) PG8_BAR;
    }
    PG8_WAIT_V(0);
    PG8_BAR;
#undef PG8_SA
#undef PG8_SB
#undef PG8_STAGE
#undef PG8_LDA
#undef PG8_LDB
#undef PG8_MMA
#undef PG8_WAIT_V
#undef PG8_WAIT_L
#undef PG8_BAR
#undef PG8_SCHED
}

DEVINL void transpose_item(const float* W, int ldw, bf16_t* WT, int ldt, LAS float* scr, int lane) {
    float tv[32];
    unsigned voff = (unsigned)(lane >> 5) * (unsigned)ldw + (unsigned)(lane & 31); asm volatile("" : "+v"(voff));
#pragma unroll
    for (int i = 0; i < 32; ++i) tv[i] = (W + (size_t)(2 * i) * ldw)[voff];
#pragma unroll
    for (int i = 0; i < 32; ++i) { const int kk = 2 * i + (lane >> 5); scr[kk * 33 + (lane & 31)] = tv[i]; }
    LDS_WAIT();
    const int c = lane & 7;
#pragma unroll
    for (int j = 0; j < 4; ++j) { const int n = (lane >> 3) + 8 * j; const LAS float* s = scr + (8 * c) * 33 + n;
        u32x4 o; o.x = cvtpk(s[0 * 33], s[1 * 33]); o.y = cvtpk(s[2 * 33], s[3 * 33]); o.z = cvtpk(s[4 * 33], s[5 * 33]); o.w = cvtpk(s[6 * 33], s[7 * 33]);
        *(u32x4*)(WT + (size_t)n * ldt + 8 * c) = o; }
    LDS_WAIT();
}

DEVINL void phase_convert(LAS unsigned char* lds, int l, int nskip, int mask) {
    PP q = get_params();
    const int tid = opaque_tid(), lane = tid & 63, wave = __builtin_amdgcn_readfirstlane(tid >> 6), G = gridDim.x, blk = blockIdx.x;
    unsigned char* ws = q->ws;
    const float* w_in = q->in[6] + (size_t)l * 1024 * 6144;
    LAS float* scr = (LAS float*)(lds + wave * 8448);
    if (nskip >= G) nskip = 0;
    if (blk < nskip) return;
    const int gw = (blk - nskip) * 8 + wave, NGW = (G - nskip) * 8;
    constexpr int N_RG = 1024, N_QK = 1024, N_V = 512, N_G = 1536, N_M = 1536, N_O = 512, N_1 = 1408, N_3 = 1408, N_2 = 1408, N_R = 256;
    constexpr int NIT = N_RG + N_QK + N_V + N_G + N_M + N_O + N_1 + N_3 + N_2 + N_R;
    for (int it = gw; it < NIT; it += NGW) {
        int r = it;
        { const int grp = it < 5632 ? 1 : it < 6144 ? 2 : it < 8960 ? 4 : it < 10368 ? 8 : 1; if (!(mask & grp)) continue; }
        if (r < N_RG) { const int kb = r >> 6, nb = r & 63; transpose_item(w_in + (size_t)kb * 64 * 6144 + nb * 32, 6144, (bf16_t*)(ws + W_RG) + (size_t)nb * 32 * 1024 + kb * 64, 1024, scr, lane); continue; } r -= N_RG;
        if (r < N_QK) { const int kb = r >> 6, nb = r & 63; const int isk = nb >> 5, cc = (nb & 31) * 32, hh = cc >> 7, c = (cc >> 6) & 1, half = (cc >> 5) & 1;
            const int drow = (isk * 4 + (hh >> 1)) * 256 + half * 128 + (hh & 1) * 64 + c * 32;
            transpose_item(w_in + (size_t)kb * 64 * 6144 + 3072 + nb * 32, 6144, (bf16_t*)(ws + W_QK) + (size_t)drow * 1024 + kb * 64, 1024, scr, lane); continue; } r -= N_QK;
        if (r < N_V) { const int kb = r >> 5, nb = r & 31; transpose_item(w_in + (size_t)kb * 64 * 6144 + 5120 + nb * 32, 6144, (bf16_t*)(ws + W_V) + (size_t)nb * 32 * 1024 + kb * 64, 1024, scr, lane); continue; } r -= N_V;
        if (r < N_G) { const int kb = r / 96, nb = r % 96; transpose_item(q->in[16] + (size_t)l * 1024 * 3072 + (size_t)kb * 64 * 3072 + nb * 32, 3072, (bf16_t*)(ws + W_G) + (size_t)nb * 32 * 1024 + kb * 64, 1024, scr, lane); continue; } r -= N_G;
        if (r < N_M) { const int i = r / 512, rr = r % 512, kb = rr >> 5, nb = rr & 31;
            transpose_item(q->in[15] + (size_t)l * 3072 * 1024 + ((size_t)i * 1024 + kb * 64) * 1024 + nb * 32, 1024, (bf16_t*)(ws + W_M) + ((size_t)i * 1024 + nb * 32) * 1024 + kb * 64, 1024, scr, lane); continue; } r -= N_M;
        if (r < N_O) { const int kb = r >> 5, nb = r & 31; transpose_item(q->in[18] + (size_t)l * 1024 * 1024 + (size_t)kb * 64 * 1024 + nb * 32, 1024, (bf16_t*)(ws + W_O) + (size_t)nb * 32 * 1024 + kb * 64, 1024, scr, lane); continue; } r -= N_O;
        if (r < N_1 + N_3) { const int w3 = r >= N_1; if (w3) r -= N_1; const int kb = r / 88, nb = r % 88; const float* src = (w3 ? q->in[20] : q->in[19]) + (size_t)l * 1024 * DFF + (size_t)kb * 64 * DFF + nb * 32;
            const int drow = (nb >> 2) * 256 + w3 * 128 + (nb & 3) * 32;
            transpose_item(src, DFF, (bf16_t*)(ws + W_13) + (size_t)drow * 1024 + kb * 64, 1024, scr, lane); continue; } r -= N_1 + N_3;
        if (r < N_2) { const int kb = r >> 5, nb = r & 31; transpose_item(q->in[21] + (size_t)l * DFF * 1024 + (size_t)kb * 64 * 1024 + nb * 32, 1024, (bf16_t*)(ws + W_2) + (size_t)nb * 32 * DFF + kb * 64, DFF, scr, lane); continue; } r -= N_2;
        {
            const int mat = r >> 3, sub = r & 7, kb = sub >> 2, nb = sub & 3; const int dir = mat >> 4, ri = (mat >> 3) & 1, g = mat & 7;
            const float* src = (ri ? q->in[11] : q->in[9]) + ((size_t)((l * 2 + dir) * 8 + g)) * 16384 + (size_t)kb * 64 * 128 + nb * 32;
            transpose_item(src, 128, (bf16_t*)(ws + W_RNN) + ((size_t)((dir * 2 + ri) * 8 + g)) * 16384 + (size_t)nb * 32 * 128 + kb * 64, 128, scr, lane);
        }
    }
    __syncthreads();
    LAS float* wt = (LAS float*)lds; LAS f32x2* ct = (LAS f32x2*)(wt + 128 * 33);
    for (int it = (mask & 16) ? blk - nskip : 256; it < 256; it += G - nskip) {
        const int g = it >> 5, k0 = (it & 31) * 32;
        __syncthreads();
#pragma unroll
        for (int i = 0; i < 8; ++i) { const int e = tid + 512 * i, kk = e >> 7, c = e & 127; wt[c * 33 + kk] = w_in[(size_t)(k0 + kk) * 6144 + 2048 + g * 128 + c]; }
        if (tid < 128) ct[tid] = (f32x2){cospif((float)tid * (1.f / 64.f)), sinpif((float)tid * (1.f / 64.f))};
        __syncthreads();
        const int kl = tid & 31, mg = tid >> 5;
        float ac[8], as[8];
#pragma unroll
        for (int i = 0; i < 8; ++i) { ac[i] = 0.f; as[i] = 0.f; }
#pragma unroll 4
        for (int c = 0; c < 128; ++c) { const float w = wt[c * 33 + kl];
#pragma unroll
            for (int mi = 0; mi < 8; ++mi) { const f32x2 cs = ct[((mg * 8 + mi) * c) & 127]; ac[mi] += w * cs.x; as[mi] += w * cs.y; } }
        bf16_t* wz = (bf16_t*)(ws + W_Z);
#pragma unroll
        for (int mi = 0; mi < 8; ++mi) { const int m = mg * 8 + mi; const unsigned pc = cvtpk(ac[mi] * 0.08838834764831845f, as[mi] * 0.08838834764831845f);
            wz[(size_t)(g * 128 + m) * 1024 + k0 + kl] = (bf16_t)(pc & 0xffffu); wz[(size_t)(1024 + g * 128 + m) * 1024 + k0 + kl] = (bf16_t)(pc >> 16); }
    }
    __syncthreads();
}

DEVINL void phase_init(LAS unsigned char* lds) {
    PP q = get_params();
    const int tid = opaque_tid(), G = gridDim.x, blk = blockIdx.x;
    const size_t gtid = (size_t)blk * 512 + tid, gsz = (size_t)G * 512;
    unsigned char* ws = q->ws;
    { float* cT = (float*)(ws + WS_COS); float* sT = (float*)(ws + WS_SIN);
      for (size_t i = gtid; i < 65536; i += gsz) { const int pos = (int)i >> 5, jj = (int)i & 31, f = jj & 15; const float inv = powf(10000.f, -(float)f * (1.f / 16.f));
          const float crd = (jj < 16) ? (float)(pos >> 6) : (float)(pos & 63); const float ang = crd * inv; cT[i] = cosf(ang); sT[i] = sinf(ang); } }
    { bf16_t* T = (bf16_t*)(ws + WS_T);
      for (size_t i = gtid; i < (size_t)2 * 1024 * 1024 / 2; i += gsz) { const int part = (int)(i >> 19), k = (int)(i >> 9) & 1023, col = ((int)i & 511) * 2; float v[2];
#pragma unroll
          for (int e = 0; e < 2; ++e) { const int n = col + e, m = (k * n) & 2047; const float x = (float)m * (1.f / 1024.f); v[e] = (part ? sinpif(x) : cospif(x)) * 0.022097086912079608f; }
          ((unsigned*)T)[i] = cvtpk(v[0], v[1]); } }
    { bf16_t* T = (bf16_t*)(ws + WS_TC);
      for (size_t i = gtid; i < (size_t)256 * 512 / 2; i += gsz) { const int k = (int)(i >> 8), col = ((int)i & 255) * 2; float v[2];
#pragma unroll
          for (int e = 0; e < 2; ++e) { const int cc = col + e, n = cc & 255, m = (k * n) & 255; const float x = (float)m * (1.f / 128.f); v[e] = (cc < 256 ? cospif(x) : -sinpif(x)) * 0.0625f; }
          ((unsigned*)T)[i] = cvtpk(v[0], v[1]); } }
    LAS float* sc = (LAS float*)lds; float* part = (float*)(ws + WS_S0);
    for (int item = blk; item < 384; item += G) {
        const int l = item / 192, rem = item % 192, kc = rem / 24, nb = rem % 24;
        __syncthreads();
        for (int e = tid; e < 9 * 128; e += 512) { const int r = e >> 7, kk = e & 127; const float c = (r < 8) ? q->in[1][r * 1024 + kc * 128 + kk] : q->in[3][kc * 128 + kk]; sc[e] = c / (1.f + __expf(-c)); }
        __syncthreads();
        const int n = nb * 256 + (tid & 255), kh = tid >> 8; const float* w = q->in[4] + ((size_t)l * 1024 + kc * 128 + kh * 64) * NMOD + n;
        float acc[9];
#pragma unroll
        for (int r = 0; r < 9; ++r) acc[r] = 0.f;
#pragma unroll 4
        for (int kk = 0; kk < 64; ++kk) { const float wv = w[(size_t)kk * NMOD];
#pragma unroll
            for (int r = 0; r < 9; ++r) acc[r] += sc[r * 128 + kh * 64 + kk] * wv; }
#pragma unroll
        for (int r = 0; r < 9; ++r) part[((size_t)((kc * 2 + kh) * 2 + l) * 9 + r) * NMOD + n] = acc[r];
    }
}

DEVINL void phase_modreduce() {
    PP q = get_params();
    const size_t gtid = (size_t)blockIdx.x * 512 + opaque_tid(), gsz = (size_t)gridDim.x * 512;
    const float* part = (const float*)(q->ws + WS_S0); float* mod = (float*)(q->ws + WS_MOD);
    for (size_t i = gtid; i < 2 * 9 * NMOD; i += gsz) { const int l = (int)(i / (9 * NMOD)), n = (int)(i % NMOD); float s = q->in[5][l * NMOD + n];
#pragma unroll
        for (int j = 0; j < 16; ++j) s += part[(size_t)j * 2 * 9 * NMOD + i];
        mod[i] = s; }
}

DEVINL void phase_modulate(int l, int shoff, int scoff, int ntok, bool from_input) {
    PP q = get_params(); const float* modl = (const float*)(q->ws + WS_MOD) + (size_t)l * 9 * NMOD; bf16_t* H = (bf16_t*)(q->ws + WS_S0);
    const int tid = opaque_tid(), lane = tid & 63, wave = tid >> 6; const int gw = blockIdx.x * 8 + wave, NGW = gridDim.x * 8;
    const float* Xlat = from_input ? q->in[0] : q->out; const float* Xctx = from_input ? q->in[2] : (const float*)(q->ws + WS_XCTX);
    for (int tb = gw; tb < ntok; tb += 3 * NGW) {
        f32x4 v[3][4]; float ss[3];
#pragma unroll
        for (int u = 0; u < 3; ++u) { const int t = tb + u * NGW; ss[u] = 0.f;
            if (t < ntok) { const float* xr = t < TL ? Xlat + (size_t)t * 1024 : Xctx + (size_t)(t - TL) * 1024;
#pragma unroll
                for (int j = 0; j < 4; ++j) v[u][j] = ((const f32x4*)xr)[lane + 64 * j]; } }
#pragma unroll
        for (int u = 0; u < 3; ++u) { const int t = tb + u * NGW;
            if (t < ntok) {
#pragma unroll
                for (int j = 0; j < 4; ++j) ss[u] += v[u][j].x * v[u][j].x + v[u][j].y * v[u][j].y + v[u][j].z * v[u][j].z + v[u][j].w * v[u][j].w;
                const float rinv = rsqrtf(wave_sum(ss[u], lane) * (1.f / 1024.f) + EPS); const int r = t < TL ? (t >> 11) : 8;
                u32x2* o = (u32x2*)(H + (size_t)t * 1024);
#pragma unroll
                for (int j = 0; j < 4; ++j) { const int col = (lane + 64 * j) * 4; const f32x4 sc = *(const f32x4*)(modl + r * NMOD + scoff + col), sh = *(const f32x4*)(modl + r * NMOD + shoff + col);
                    const f32x4 y = v[u][j] * rinv * (sc + 1.f) + sh; u32x2 w; w.x = cvtpk(y.x, y.y); w.y = cvtpk(y.z, y.w); o[lane + 64 * j] = w; } } }
    }
}

DEVINL void phase_final() {
    PP q = get_params();
    const int tid = opaque_tid(), lane = tid & 63, wave = tid >> 6; const int gw = blockIdx.x * 8 + wave, NGW = gridDim.x * 8;
    f32x4 g[4];
#pragma unroll
    for (int j = 0; j < 4; ++j) g[j] = ((const f32x4*)q->in[22])[lane + 64 * j];
    for (int tb = gw; tb < TL; tb += 4 * NGW) {
        f32x4 v[4][4]; float ss[4];
#pragma unroll
        for (int u = 0; u < 4; ++u) { const int t = tb + u * NGW; ss[u] = 0.f;
            if (t < TL) {
#pragma unroll
                for (int j = 0; j < 4; ++j) v[u][j] = ((const f32x4*)(q->out + (size_t)t * 1024))[lane + 64 * j]; } }
#pragma unroll
        for (int u = 0; u < 4; ++u) { const int t = tb + u * NGW;
            if (t < TL) {
#pragma unroll
                for (int j = 0; j < 4; ++j) ss[u] += v[u][j].x * v[u][j].x + v[u][j].y * v[u][j].y + v[u][j].z * v[u][j].z + v[u][j].w * v[u][j].w;
                const float rinv = rsqrtf(wave_sum(ss[u], lane) * (1.f / 1024.f) + EPS);
#pragma unroll
                for (int j = 0; j < 4; ++j) ((f32x4*)(q->out + (size_t)t * 1024))[lane + 64 * j] = v[u][j] * rinv * g[j]; } }
    }
}

constexpr size_t WS_ZTCTX = WS_T + 4 * MiB, WS_ZH = WS_T + 12 * MiB, WS_ALT = WS_ZH + 64 * 1024;
DEVINL void phase_sym() {
    PP q = get_params(); const bf16_t* H = (const bf16_t*)(q->ws + WS_S0); bf16_t* HP = (bf16_t*)(q->ws + WS_S2); bf16_t* HM = (bf16_t*)(q->ws + WS_S2 + 16 * MiB);
    const bf16_t* WZ = (const bf16_t*)(q->ws + W_Z); float* zh = (float*)(q->ws + WS_ZH);
    const int tid = opaque_tid(), lane = tid & 63, wave = tid >> 6; const int gw = blockIdx.x * 8 + wave, NGW = gridDim.x * 8;
    for (int rb = gw; rb < 8192; rb += 2 * NGW) {
        u32x4 xa[2][2], xb[2][2];
#pragma unroll
        for (int u = 0; u < 2; ++u) { const int r = rb + u * NGW; if (r < 8192) { const int b = r >> 10, n = r & 1023;
            const u32x4* h1 = (const u32x4*)(H + ((size_t)b * 2048 + n) * 1024); const u32x4* h2 = (const u32x4*)(H + ((size_t)b * 2048 + ((2048 - n) & 2047)) * 1024);
            xa[u][0] = h1[lane]; xa[u][1] = h1[lane + 64]; xb[u][0] = h2[lane]; xb[u][1] = h2[lane + 64]; } }
#pragma unroll
        for (int u = 0; u < 2; ++u) { const int r = rb + u * NGW; if (r < 8192) { const int n = r & 1023;
#pragma unroll
            for (int jj = 0; jj < 2; ++jj) { float x[8], y[8], pp[8], mm[8]; bf8_unpack(xa[u][jj], x); bf8_unpack(xb[u][jj], y);
#pragma unroll
                for (int e = 0; e < 8; ++e) { pp[e] = n ? x[e] + y[e] : x[e]; mm[e] = n ? x[e] - y[e] : 0.f; }
                ((u32x4*)(HP + (size_t)r * 1024))[lane + 64 * jj] = bf8_pack(pp); ((u32x4*)(HM + (size_t)r * 1024))[lane + 64 * jj] = bf8_pack(mm); } } }
    }
    for (int rb = gw; rb < 8192; rb += 2 * NGW) {
        u32x4 wv[2][2], hv[2][2];
#pragma unroll
        for (int u = 0; u < 2; ++u) { const int r = rb + u * NGW; if (r < 8192) { const int b = r >> 10, j = r & 1023; const u32x4* w = (const u32x4*)(WZ + (size_t)j * 1024); const u32x4* h = (const u32x4*)(H + ((size_t)b * 2048 + 1024) * 1024);
            wv[u][0] = w[lane]; wv[u][1] = w[lane + 64]; hv[u][0] = h[lane]; hv[u][1] = h[lane + 64]; } }
#pragma unroll
        for (int u = 0; u < 2; ++u) { const int r = rb + u * NGW; if (r < 8192) { float a = 0.f;
#pragma unroll
            for (int jj = 0; jj < 2; ++jj) { float x[8], y[8]; bf8_unpack(wv[u][jj], x); bf8_unpack(hv[u][jj], y);
#pragma unroll
                for (int e = 0; e < 8; ++e) a += x[e] * y[e]; }
            a = wave_sum(a, lane); if (lane == 0) zh[r] = a; } }
    }
}
DEVINL void phase_alt() {
    PP q = get_params(); const bf16_t* ZTc = (const bf16_t*)(q->ws + WS_S1); float* alt = (float*)(q->ws + WS_ALT);
    const int tid = opaque_tid(), lane = tid & 63, wave = tid >> 6; const int gw = blockIdx.x * 8 + wave, NGW = gridDim.x * 8;
    for (int r = gw; r < 8192; r += NGW) { const u32x4* z = (const u32x4*)(ZTc + (size_t)r * 1024); float a = 0.f;
#pragma unroll
        for (int jj = 0; jj < 2; ++jj) { float x[8]; bf8_unpack(z[lane + 64 * jj], x); a += (x[0] - x[1]) + (x[2] - x[3]) + (x[4] - x[5]) + (x[6] - x[7]); }
        a = wave_sum(a, lane); if (lane == 0) alt[r] = a; }
}
DEVINL void phase_combine() {
    PP q = get_params(); const bf16_t* E = (const bf16_t*)(q->ws + WS_S3); const bf16_t* Od = (const bf16_t*)(q->ws + WS_S3 + 16 * MiB); bf16_t* Yb = (bf16_t*)(q->ws + WS_S2);
    const float* zh = (const float*)(q->ws + WS_ZH); const float* alt = (const float*)(q->ws + WS_ALT);
    const int tid = opaque_tid(), lane = tid & 63, wave = tid >> 6; const int gw = blockIdx.x * 8 + wave, NGW = gridDim.x * 8;
    constexpr float SC = 0.022097086912079608f;
    for (int r = gw; r < 8 * 1025; r += NGW) { const int b = r / 1025, kk = r % 1025;
#pragma unroll
        for (int jj = 0; jj < 2; ++jj) { const int j0 = (lane + 64 * jj) * 8; float z[8];
            { const f32x4 z0 = *(const f32x4*)(zh + b * 1024 + j0), z1 = *(const f32x4*)(zh + b * 1024 + j0 + 4); z[0] = z0.x; z[1] = z0.y; z[2] = z0.z; z[3] = z0.w; z[4] = z1.x; z[5] = z1.y; z[6] = z1.z; z[7] = z1.w; }
            if (kk == 1024) { float y[8]; const f32x4 a0 = *(const f32x4*)(alt + b * 1024 + j0), a1 = *(const f32x4*)(alt + b * 1024 + j0 + 4); const float av[8] = {a0.x, a0.y, a0.z, a0.w, a1.x, a1.y, a1.z, a1.w};
#pragma unroll
                for (int e = 0; e < 8; ++e) y[e] = SC * (z[e] + av[e]);
                *(u32x4*)(Yb + ((size_t)b * 2048 + 1024) * 1024 + j0) = bf8_pack(y); }
            else { float ev[8], ov[8], y1[8], y2[8]; bf8_unpack(*(const u32x4*)(E + ((size_t)b * 1024 + kk) * 1024 + j0), ev); bf8_unpack(*(const u32x4*)(Od + ((size_t)b * 1024 + kk) * 1024 + j0), ov);
                const float sg = (kk & 1) ? -SC : SC;
#pragma unroll
                for (int e = 0; e < 8; ++e) { const float base = ev[e] + sg * z[e]; y1[e] = base - ov[e]; y2[e] = base + ov[e]; }
                *(u32x4*)(Yb + ((size_t)b * 2048 + kk) * 1024 + j0) = bf8_pack(y1);
                if (kk) *(u32x4*)(Yb + ((size_t)b * 2048 + 2048 - kk) * 1024 + j0) = bf8_pack(y2); } }
    }
}

constexpr int NCHUNK = 576;
DEVINL void rnn_decode(int ck, int& t0, int& s0, int& s1) {
    if (ck < 512) { const int b = ck >> 6, cc = ck & 63; s0 = b * 2048; s1 = s0 + 2048; t0 = s0 + cc * 32; }
    else { const int b = (ck - 512) >> 3, cc = (ck - 512) & 7; s0 = TL + b * 256; s1 = s0 + 256; t0 = s0 + cc * 32; }
}
DEVINL void phase_rnn(LAS unsigned char* lds, int l, int pass, bool skip_ctx) {
    PP q = get_params();
    const bf16_t* XR = (const bf16_t*)(q->ws + WS_S1); const bf16_t* GR = (const bf16_t*)(q->ws + WS_S2); bf16_t* Ya = (bf16_t*)(q->ws + WS_S3); f32x2* totals = (f32x2*)(q->ws + WS_S3); const float* carry = (const float*)(q->ws + WS_S4);
    const int tid = opaque_tid(), lane = tid & 63, wave = __builtin_amdgcn_readfirstlane(tid >> 6), cl = lane & 15, fq = lane >> 4;
    const int G = gridDim.x, blk = blockIdx.x;
    LAS unsigned char* Us = lds;
    LAS f32x2* coef = (LAS f32x2*)(lds + 16384);
    const bf16_t* wrn = (const bf16_t*)(q->ws + W_RNN);
    const int per = (8 * NCHUNK + G - 1) / G;
    const int it0 = blk * per, it1 = (it0 + per) < 8 * NCHUNK ? (it0 + per) : 8 * NCHUNK;
    const int ctok = tid >> 4, ch8 = (tid & 15) * 8;
    const int mch = wave * 16 + cl;
    int gcur = -1; bf16x8 bfr[4][4]; f32x4 cw[4][2], cbv[2]; float brv[2], biv[2], lslv[2];
    u32x4 xr[4];
#define RNN_NEXT(it_) do { ++(it_); } while ((it_) < it1 && skip_ctx && ((it_) % NCHUNK) >= 512)
#define RNN_LOADX(it_) do { const int g_ = (it_) / NCHUNK, ck_ = (it_) % NCHUNK; int t0_, s0_, s1_; rnn_decode(ck_, t0_, s0_, s1_); \
        _Pragma("unroll") for (int k = 0; k < 4; ++k) { const int t_ = t0_ + ctok + k - 2; xr[k] = (u32x4){0u, 0u, 0u, 0u}; if (t_ >= s0_ && t_ < s1_) xr[k] = *(const u32x4*)(XR + (size_t)t_ * 1024 + g_ * 128 + ch8); } } while (0)
    int it = it0 - 1; RNN_NEXT(it);
    if (it < it1) RNN_LOADX(it);
    while (it < it1) {
        const int g = it / NCHUNK, ck = it % NCHUNK;
        int t0, s0, s1; rnn_decode(ck, t0, s0, s1);
        if (g != gcur) { gcur = g;
#pragma unroll
            for (int ty = 0; ty < 4; ++ty)
#pragma unroll
                for (int ks = 0; ks < 4; ++ks) bfr[ty][ks] = *(const bf16x8*)(wrn + ((size_t)(ty * 8 + g)) * 16384 + (size_t)mch * 128 + ks * 32 + fq * 8);
            const int gc = g * 128 + ch8; const float* cb = q->in[8] + l * 1024 + gc; cbv[0] = *(const f32x4*)cb; cbv[1] = *(const f32x4*)(cb + 4);
#pragma unroll
            for (int k = 0; k < 4; ++k) { const float* cwp = q->in[7] + (size_t)(l * 4 + k) * 1024 + gc; cw[k][0] = *(const f32x4*)cwp; cw[k][1] = *(const f32x4*)(cwp + 4); }
#pragma unroll
            for (int dir = 0; dir < 2; ++dir) { const int pi = (l * 2 + dir) * 1024 + g * 128 + mch; brv[dir] = q->in[10][pi]; biv[dir] = q->in[12][pi]; lslv[dir] = -8.f * log1pf(__expf(-q->in[13][pi])); } }
        { float u[8] = {cbv[0].x, cbv[0].y, cbv[0].z, cbv[0].w, cbv[1].x, cbv[1].y, cbv[1].z, cbv[1].w};
#pragma unroll
          for (int k = 0; k < 4; ++k) { const u32x4 x = xr[k]; const f32x4 w0 = cw[k][0], w1 = cw[k][1];
              u[0] += w0.x * bflo(x.x); u[1] += w0.y * bfhi(x.x); u[2] += w0.z * bflo(x.y); u[3] += w0.w * bfhi(x.y); u[4] += w1.x * bflo(x.z); u[5] += w1.y * bfhi(x.z); u[6] += w1.z * bflo(x.w); u[7] += w1.w * bfhi(x.w); }
          u32x4 w; w.x = cvtpk(u[0], u[1]); w.y = cvtpk(u[2], u[3]); w.z = cvtpk(u[4], u[5]); w.w = cvtpk(u[6], u[7]); *(LAS u32x4*)(Us + ctok * 272 + ch8 * 2) = w; }
        int itn = it; RNN_NEXT(itn);
        if (itn < it1) RNN_LOADX(itn);
        u32x4 grv = {0u, 0u, 0u, 0u};
        const size_t yoff = (size_t)(t0 + ctok) * 1024 + g * 128 + ch8;
        if (pass == 2) grv = *(const u32x4*)(GR + yoff);
        float hcar = 0.f;
        if (pass == 2 && tid < 256) hcar = carry[((size_t)(tid >> 7) * NCHUNK + ck) * 1024 + g * 128 + (tid & 127)];
        LDS_BARRIER();
        f32x4 acc[4][2];
#pragma unroll
        for (int ty = 0; ty < 4; ++ty) { acc[ty][0] = (f32x4){0.f, 0.f, 0.f, 0.f}; acc[ty][1] = (f32x4){0.f, 0.f, 0.f, 0.f}; }
#pragma unroll
        for (int ks = 0; ks < 4; ++ks) {
            const bf16x8 a0 = *(const LAS bf16x8*)(Us + cl * 272 + (ks * 32 + fq * 8) * 2), a1 = *(const LAS bf16x8*)(Us + (16 + cl) * 272 + (ks * 32 + fq * 8) * 2);
#pragma unroll
            for (int ty = 0; ty < 4; ++ty) { acc[ty][0] = __builtin_amdgcn_mfma_f32_16x16x32_bf16(a0, bfr[ty][ks], acc[ty][0], 0, 0, 0); acc[ty][1] = __builtin_amdgcn_mfma_f32_16x16x32_bf16(a1, bfr[ty][ks], acc[ty][1], 0, 0, 0); } }
        { const f32x2 br2 = {brv[0], brv[1]}, bi2 = {biv[0], biv[1]}, lsl2 = {lslv[0] * 1.4426950408889634f, lslv[1] * 1.4426950408889634f};
#pragma unroll
          for (int mt = 0; mt < 2; ++mt)
#pragma unroll
            for (int r = 0; r < 4; ++r) { const int tok = mt * 16 + fq * 4 + r; const float u = bf2f(*(const LAS bf16_t*)(Us + tok * 272 + mch * 2));
                const f32x2 tr = ((f32x2){acc[0][mt][r], acc[2][mt][r]} + br2) * -1.4426950408889634f, ti = ((f32x2){acc[1][mt][r], acc[3][mt][r]} + bi2) * -1.4426950408889634f;
                const f32x2 dr = (f32x2){__builtin_amdgcn_exp2f(tr.x), __builtin_amdgcn_exp2f(tr.y)} + 1.f, di = (f32x2){__builtin_amdgcn_exp2f(ti.x), __builtin_amdgcn_exp2f(ti.y)} + 1.f;
                const f32x2 rr = {__builtin_amdgcn_rcpf(dr.x), __builtin_amdgcn_rcpf(dr.y)}, ii = {__builtin_amdgcn_rcpf(di.x), __builtin_amdgcn_rcpf(di.y)};
                const f32x2 la2 = lsl2 * rr, a2 = la2 * 2.f;
                const f32x2 om = __builtin_elementwise_max((f32x2){1.f, 1.f} - (f32x2){__builtin_amdgcn_exp2f(a2.x), __builtin_amdgcn_exp2f(a2.y)}, (f32x2){0.f, 0.f});
                const f32x2 bb = (f32x2){__builtin_amdgcn_sqrtf(om.x), __builtin_amdgcn_sqrtf(om.y)} * ii * u;
                coef[(0 * 32 + tok) * 128 + mch] = (f32x2){la2.x, bb.x}; coef[(1 * 32 + tok) * 128 + mch] = (f32x2){la2.y, bb.y}; } }
        LDS_BARRIER();
        if (tid < 256) { const int dir = wave >> 1, ch = tid & 127; LAS f32x2* cp = coef + dir * 32 * 128 + ch; float h = hcar, P2 = 0.f;
            f32x2 cf[16];
            if (dir == 0) {
#pragma unroll
                for (int hf = 0; hf < 2; ++hf) {
#pragma unroll
                    for (int s = 0; s < 16; ++s) cf[s] = cp[(hf * 16 + s) * 128];
#pragma unroll
                    for (int s = 0; s < 16; ++s) { h = __builtin_amdgcn_exp2f(cf[s].x) * h + cf[s].y; P2 += cf[s].x; if (pass == 2) cp[(hf * 16 + s) * 128].y = h; } }
            } else {
#pragma unroll
                for (int hf = 0; hf < 2; ++hf) {
#pragma unroll
                    for (int s = 0; s < 16; ++s) cf[s] = cp[(31 - hf * 16 - s) * 128];
#pragma unroll
                    for (int s = 0; s < 16; ++s) { h = __builtin_amdgcn_exp2f(cf[s].x) * h + cf[s].y; P2 += cf[s].x; if (pass == 2) cp[(31 - hf * 16 - s) * 128].y = h; } }
            }
            if (pass == 1) totals[((size_t)dir * NCHUNK + ck) * 1024 + g * 128 + ch] = (f32x2){P2, h}; }
        if (pass == 2) {
            LDS_BARRIER();
            float y[8]; const float gv[8] = {bflo(grv.x), bfhi(grv.x), bflo(grv.y), bfhi(grv.y), bflo(grv.z), bfhi(grv.z), bflo(grv.w), bfhi(grv.w)};
#pragma unroll
            for (int e = 0; e < 8; ++e) { const float hs = coef[(0 * 32 + ctok) * 128 + ch8 + e].y + coef[(1 * 32 + ctok) * 128 + ch8 + e].y; y[e] = hs * gelu_tanh(gv[e]); }
            u32x4 w; w.x = cvtpk(y[0], y[1]); w.y = cvtpk(y[2], y[3]); w.z = cvtpk(y[4], y[5]); w.w = cvtpk(y[6], y[7]); *(u32x4*)(Ya + yoff) = w;
        }
        LDS_BARRIER();
        it = itn;
    }
#undef RNN_NEXT
#undef RNN_LOADX
}

DEVINL void phase_rnn_carry() {
    PP q = get_params(); const f32x2* totals = (const f32x2*)(q->ws + WS_S3); float* carry = (float*)(q->ws + WS_S4);
    const int tid = opaque_tid();
    if (tid >= 64) return;
    for (int seq = blockIdx.x * 64 + tid; seq < NB * 2 * 1024; seq += gridDim.x * 64) {
        const int b = seq >> 11, dir = (seq >> 10) & 1, gc = seq & 1023;
        float st = 0.f;
#pragma unroll 1
        for (int s0 = 0; s0 < 72; s0 += 24) { int idx[24]; f32x2 t[24];
#pragma unroll
            for (int j = 0; j < 24; ++j) { const int s = s0 + j; int ck; if (s < 8) { const int cc = dir ? 7 - s : s; ck = 512 + b * 8 + cc; } else { const int cc = dir ? 63 - (s - 8) : (s - 8); ck = b * 64 + cc; }
                idx[j] = (dir * NCHUNK + ck) * 1024 + gc; t[j] = totals[idx[j]]; }
#pragma unroll
            for (int j = 0; j < 24; ++j) { carry[idx[j]] = st; st = __builtin_amdgcn_exp2f(t[j].x) * st + t[j].y; } }
    }
}

DEVINL void phase_attn(LAS unsigned char* lds, int l, bool do_ctx) {
    PP q = get_params(); bf16_t* Q = (bf16_t*)(q->ws + WS_S1); const bf16_t* K = (const bf16_t*)(q->ws + WS_S2); const bf16_t* VT = (const bf16_t*)(q->ws + WS_S3);
    const int tid = opaque_tid(), lane = tid & 63, wave = __builtin_amdgcn_readfirstlane(tid >> 6), r32 = lane & 31, hi = lane >> 5;
    const int G = gridDim.x, blk = blockIdx.x;
    const float* lv = q->in[14] + l * 256;
    const float s1 = wave_sum(lv[lane] * lv[64 + lane], lane), s2 = wave_sum(lv[128 + lane] * lv[192 + lane], lane);
    const float lam_init = 0.8f - 0.6f * expf(-0.3f * (float)l); const float lam = expf(s1) - expf(s2) + lam_init;
    const int nit = 1024 + (do_ctx ? 128 : 0);
    const int c = wave >> 2, qs = wave & 3;
    const int kperm = (r32 & ~12) | ((r32 & 4) << 1) | ((r32 & 8) >> 1);
    constexpr int STG = 35840, VOFF = 17408;
    const int vb = (G & 7) ? blk : (blk & 7) * (G >> 3) + (blk >> 3);
    for (int item = vb; item < nit; item += G) {
        int b, h, q0, kt0;
        if (item < 1024) { b = item >> 7; h = (item >> 4) & 7; q0 = b * 2048 + (item & 15) * 128; kt0 = 0; }
        else { const int j = item - 1024; b = j >> 4; h = (j >> 1) & 7; q0 = TL + b * 256 + (j & 1) * 128; kt0 = 32; }
        const int tq = q0 + qs * 32 + r32;
        bf16x8 qf[4];
#pragma unroll
        for (int ks = 0; ks < 4; ++ks) qf[ks] = *(const bf16x8*)(Q + (size_t)tq * 1024 + h * 128 + c * 64 + ks * 16 + hi * 8);
        f32x16 O[4];
#pragma unroll
        for (int n = 0; n < 4; ++n)
#pragma unroll
            for (int i = 0; i < 16; ++i) O[n][i] = 0.f;
        float mrun = 0.f, lsum = 0.f;
        const int kkey = tid >> 3, kpart = tid & 7, vvd = tid >> 2, vpart = tid & 3;
        u32x4 kr0, kr1, vr0, vr1;
#define ATT_LOAD(kt) do { const int tk_ = ((kt) < 32 ? b * 2048 + (kt) * 64 : TL + b * 256 + ((kt) - 32) * 64) + kkey; const bf16_t* ks_ = K + (size_t)tk_ * 1024 + h * 128 + kpart * 16; \
            kr0 = *(const u32x4*)ks_; kr1 = *(const u32x4*)(ks_ + 8); const bf16_t* vs_ = VT + ((size_t)(b * 1024 + h * 128 + vvd)) * 2304 + (kt) * 64 + vpart * 16; vr0 = *(const u32x4*)vs_; vr1 = *(const u32x4*)(vs_ + 8); } while (0)
        constexpr int KST = 17408, VBASE = 2 * 17408, VST = 18432;
#define ATT_STORE(ks_, vs_) do { LAS unsigned char* kb_ = lds + (ks_) * KST + kkey * 272 + kpart * 32; *(LAS u32x4*)kb_ = kr0; *(LAS u32x4*)(kb_ + 16) = kr1; \
            LAS unsigned char* vb_ = lds + VBASE + (vs_) * VST + vvd * 144 + vpart * 32; *(LAS u32x4*)vb_ = vr0; *(LAS u32x4*)(vb_ + 16) = vr1; } while (0)
#define ATT_VLD(dst, Vb_, n_) do { _Pragma("unroll") for (int j = 0; j < 4; ++j) dst[j] = *(const LAS bf16x8*)((Vb_) + ((n_) * 32 + r32) * 144 + (j * 16 + hi * 8) * 2); } while (0)
#define ATT_PVM(src, P_, n_) do { _Pragma("unroll") for (int j = 0; j < 4; ++j) O[n_] = __builtin_amdgcn_mfma_f32_32x32x16_bf16(src[j], P_[j >> 1][j & 1], O[n_], 0, 0, 0); } while (0)
#define ATT_PV(Vb_, P_) do { ATT_VLD(fb, Vb_, 1); __builtin_amdgcn_sched_barrier(0); ATT_PVM(fa, P_, 0); ATT_VLD(fa, Vb_, 2); __builtin_amdgcn_sched_barrier(0); \
            ATT_PVM(fb, P_, 1); ATT_VLD(fb, Vb_, 3); __builtin_amdgcn_sched_barrier(0); ATT_PVM(fa, P_, 2); ATT_PVM(fb, P_, 3); } while (0)
        ATT_LOAD(kt0); ATT_STORE(0, 0);
        LDS_BARRIER();
        bf16x8 pp[2][2];
#pragma unroll
        for (int a_ = 0; a_ < 2; ++a_)
#pragma unroll
            for (int b_ = 0; b_ < 2; ++b_) pp[a_][b_] = (bf16x8){0, 0, 0, 0, 0, 0, 0, 0};
        int vcur = 0;
        for (int kt = kt0; kt < 36; ++kt) {
            const int cur = (kt - kt0) & 1; const int vprev = vcur == 0 ? 2 : vcur - 1, vnext = vcur == 2 ? 0 : vcur + 1;
            if (kt + 1 < 36) ATT_LOAD(kt + 1);
            const LAS unsigned char* Kb = lds + cur * KST; const LAS unsigned char* Vb = lds + VBASE + vcur * VST;
            bf16x8 fa[4], fb[4];
            if (c == 1 && kt > kt0) {
                const LAS unsigned char* Vp = lds + VBASE + vprev * VST;
                ATT_VLD(fa, Vp, 0); __builtin_amdgcn_sched_barrier(0); ATT_PV(Vp, pp);
            }
            f32x16 S0, S1;
#pragma unroll
            for (int i = 0; i < 16; ++i) { S0[i] = -mrun; S1[i] = -mrun; }
            bf16x8 kf[8];
#pragma unroll
            for (int ks = 0; ks < 4; ++ks) { kf[2 * ks] = *(const LAS bf16x8*)(Kb + kperm * 272 + (c * 64 + ks * 16 + hi * 8) * 2); kf[2 * ks + 1] = *(const LAS bf16x8*)(Kb + (32 + kperm) * 272 + (c * 64 + ks * 16 + hi * 8) * 2); }
            __builtin_amdgcn_sched_barrier(0);
#pragma unroll
            for (int ks = 0; ks < 4; ++ks) { S0 = __builtin_amdgcn_mfma_f32_32x32x16_bf16(kf[2 * ks], qf[ks], S0, 0, 0, 0); S1 = __builtin_amdgcn_mfma_f32_32x32x16_bf16(kf[2 * ks + 1], qf[ks], S1, 0, 0, 0); }
            if (c == 0) ATT_VLD(fa, Vb, 0);
            __builtin_amdgcn_sched_barrier(0);
            float mxa = max3f_(S0[0], S1[0], S0[1]), mxb = max3f_(S1[1], S0[2], S1[2]);
#pragma unroll
            for (int i = 3; i < 15; i += 2) { mxa = max3f_(mxa, S0[i], S1[i]); mxb = max3f_(mxb, S0[i + 1], S1[i + 1]); }
            float mx = max3f_(mxa, mxb, fmaxf(S0[15], S1[15]));
            mx = fmaxf(mx, shflx(mx, 32, lane));
            const float dlt = (fabsf(mx) > 8.f) ? mx : 0.f;
            if (__builtin_amdgcn_ballot_w64(dlt != 0.f) != 0ull) {
                const float alpha = __builtin_amdgcn_exp2f(-dlt); mrun += dlt; lsum *= alpha;
#pragma unroll
                for (int i = 0; i < 16; ++i) { S0[i] -= dlt; S1[i] -= dlt; }
#pragma unroll
                for (int n = 0; n < 4; ++n)
#pragma unroll
                    for (int i = 0; i < 16; ++i) O[n][i] *= alpha;
            }
            f32x2 ps2 = {0.f, 0.f};
#pragma unroll
            for (int i = 0; i < 16; i += 2) { S0[i] = __builtin_amdgcn_exp2f(S0[i]); S0[i + 1] = __builtin_amdgcn_exp2f(S0[i + 1]); S1[i] = __builtin_amdgcn_exp2f(S1[i]); S1[i + 1] = __builtin_amdgcn_exp2f(S1[i + 1]);
                ps2 += (f32x2){S0[i], S0[i + 1]} + (f32x2){S1[i], S1[i + 1]}; }
            lsum += ps2.x + ps2.y;
            bf16x8 pf[2][2];
#pragma unroll
            for (int s = 0; s < 2; ++s) { u32x4 w0, w1;
                w0.x = cvtpk(S0[8 * s + 0], S0[8 * s + 1]); w0.y = cvtpk(S0[8 * s + 2], S0[8 * s + 3]); w0.z = cvtpk(S0[8 * s + 4], S0[8 * s + 5]); w0.w = cvtpk(S0[8 * s + 6], S0[8 * s + 7]);
                w1.x = cvtpk(S1[8 * s + 0], S1[8 * s + 1]); w1.y = cvtpk(S1[8 * s + 2], S1[8 * s + 3]); w1.z = cvtpk(S1[8 * s + 4], S1[8 * s + 5]); w1.w = cvtpk(S1[8 * s + 6], S1[8 * s + 7]);
                pf[0][s] = __builtin_bit_cast(bf16x8, w0); pf[1][s] = __builtin_bit_cast(bf16x8, w1); }
            __builtin_amdgcn_sched_barrier(0);
            if (c == 0) { ATT_PV(Vb, pf); }
            else {
#pragma unroll
                for (int a_ = 0; a_ < 2; ++a_)
#pragma unroll
                    for (int b_ = 0; b_ < 2; ++b_) pp[a_][b_] = pf[a_][b_]; }
            if (kt + 1 < 36) ATT_STORE(cur ^ 1, vnext);
            LDS_BARRIER();
            vcur = vnext;
        }
        if (c == 1) { const LAS unsigned char* Vl = lds + VBASE + (vcur == 0 ? 2 : vcur - 1) * VST; bf16x8 fa[4], fb[4];
            ATT_VLD(fa, Vl, 0); __builtin_amdgcn_sched_barrier(0); ATT_PV(Vl, pp); }
        LDS_BARRIER();
#undef ATT_VLD
#undef ATT_PVM
#undef ATT_PV
#undef ATT_LOAD
#undef ATT_STORE
        lsum += shflx(lsum, 32, lane);
        const float inv = 1.f / lsum;
        LAS float* xb = (LAS float*)lds + qs * (32 * 132) + r32 * 132;
        if (c == 1) { const float f = inv * lam;
#pragma unroll
            for (int n = 0; n < 4; ++n)
#pragma unroll
                for (int gq = 0; gq < 4; ++gq) { const int vd = n * 32 + 8 * gq + 4 * hi; *(LAS f32x4*)(xb + vd) = (f32x4){O[n][4 * gq] * f, O[n][4 * gq + 1] * f, O[n][4 * gq + 2] * f, O[n][4 * gq + 3] * f}; } }
        LDS_BARRIER();
        if (c == 0) { float ss = 0.f;
#pragma unroll
            for (int n = 0; n < 4; ++n)
#pragma unroll
                for (int gq = 0; gq < 4; ++gq) { const int vd = n * 32 + 8 * gq + 4 * hi; const f32x4 o1 = *(const LAS f32x4*)(xb + vd);
#pragma unroll
                    for (int j = 0; j < 4; ++j) { const float o = O[n][4 * gq + j] * inv - o1[j]; O[n][4 * gq + j] = o; ss += o * o; } }
            ss += shflx(ss, 32, lane);
            const float rn = rsqrtf(ss * (1.f / 128.f) + EPS) * (1.f - lam_init);
            bf16_t* dst = Q + (size_t)tq * 1024 + h * 128;
#pragma unroll
            for (int n = 0; n < 4; ++n)
#pragma unroll
                for (int gq = 0; gq < 4; ++gq) { const int vd = n * 32 + 8 * gq + 4 * hi; u32x2 w; w.x = cvtpk(O[n][4 * gq] * rn, O[n][4 * gq + 1] * rn); w.y = cvtpk(O[n][4 * gq + 2] * rn, O[n][4 * gq + 3] * rn); *(u32x2*)(dst + vd) = w; } }
        LDS_BARRIER();
    }
}

#define XB_TMO      128
#define XB_XCNT(j)  (256  + 64 * (j))
#define XB_XSUB(j)  (1280 + 64 * (j))
#define XB_XGEN(j)  (2304 + 64 * (j))
#define XB_TOP      3328
#define XB_TOPGEN   3392
#define XCD_BAR_WORDS 3456
#define XB_SPIN_CAP (1u << 18)

__device__ __forceinline__ unsigned xb_ld(unsigned* p)              { return __hip_atomic_load(p, __ATOMIC_RELAXED, __HIP_MEMORY_SCOPE_AGENT); }
__device__ __forceinline__ unsigned xb_add(unsigned* p, unsigned v) { return __hip_atomic_fetch_add(p, v, __ATOMIC_RELAXED, __HIP_MEMORY_SCOPE_AGENT); }
__device__ __forceinline__ unsigned xb_xcc_id() { return (unsigned)__builtin_amdgcn_s_getreg((3 << 11) | 20) & 0xFu; }
#define XB_SPIN(cond, bar) do { unsigned _sp = 0; while (cond) { __builtin_amdgcn_s_sleep(1); \
    if ((++_sp & 255u) == 0u) { if (xb_ld(&(bar)[XB_TMO])) break; if (_sp > XB_SPIN_CAP) { atomicAdd(&(bar)[XB_TMO], 1u); break; } } } } while (0)

struct XcdBarrier {
    unsigned* bar; unsigned x;
    volatile LAS unsigned* st;
};

__device__ __forceinline__ XcdBarrier xcd_barrier_post(unsigned* bar, volatile LAS unsigned* st) {
    XcdBarrier b; b.bar = bar; b.x = xb_xcc_id(); b.st = st;
    if (opaque_tid() == 0) (void)xb_add(&bar[XB_XCNT(b.x)], 1u);
    return b;
}
__device__ __forceinline__ void xcd_barrier_complete(unsigned* bar, unsigned x, unsigned& nloc, unsigned& nx) {
    const unsigned G = gridDim.x * gridDim.y * gridDim.z;
    unsigned sum, cnt, mine, sp = 0u;
    for (;;) {
        sum = 0u; cnt = 0u; mine = 0u;
#pragma unroll
        for (unsigned j = 0; j < 16; ++j) { const unsigned c = xb_ld(&bar[XB_XCNT(j)]); sum += c; cnt += (c > 0u) ? 1u : 0u; mine = (j == x) ? c : mine; }
        if (sum == G) break;
        __builtin_amdgcn_s_sleep(1);
        if ((++sp & 255u) == 0u) { if (xb_ld(&bar[XB_TMO])) break; if (sp > XB_SPIN_CAP) { atomicAdd(&bar[XB_TMO], 1u); break; } }
    }
    nloc = mine > 0u ? mine : 1u; nx = cnt > 0u ? cnt : 1u;
}

__device__ __forceinline__ void xcd_barrier(const XcdBarrier& b) {
    asm volatile("s_waitcnt vmcnt(0)" ::: "memory");
    __syncthreads();
    if (opaque_tid() == 0) {
        unsigned* bar = (unsigned*)(get_params()->ws + WS_BAR);
        unsigned bx = xb_xcc_id(); asm volatile("" : "+s"(bx));
        __builtin_amdgcn_s_waitcnt(0);
        unsigned nloc = b.st[0], nx = b.st[1];
        if (nloc == 0u) { xcd_barrier_complete(bar, bx, nloc, nx); b.st[0] = nloc; b.st[1] = nx; }
        const unsigned old = xb_add(&bar[XB_XSUB(bx)], 1u);
        const unsigned gen = old / nloc;
        if (old + 1u == (gen + 1u) * nloc) {
            __builtin_amdgcn_fence(__ATOMIC_RELEASE, "agent");
            asm volatile("s_waitcnt vmcnt(0)" ::: "memory");
            const unsigned og = xb_add(&bar[XB_TOP], 1u);
            const unsigned tg = og / nx;
            if (og + 1u == (tg + 1u) * nx) xb_add(&bar[XB_TOPGEN], 1u);
            else XB_SPIN(xb_ld(&bar[XB_TOPGEN]) == tg, bar);
            __builtin_amdgcn_fence(__ATOMIC_ACQUIRE, "agent");
            xb_add(&bar[XB_XGEN(bx)], 1u);
            asm volatile("s_waitcnt vmcnt(0)" ::: "memory");
        } else {
            XB_SPIN(xb_ld(&bar[XB_XGEN(bx)]) == gen, bar);
            __builtin_amdgcn_fence(__ATOMIC_ACQUIRE, "agent");
            asm volatile("s_waitcnt vmcnt(0)" ::: "memory");
        }
    }
    __syncthreads();
}


__global__ void __launch_bounds__(512) mega_fwd(Params p_unused) {
    extern __shared__ __attribute__((aligned(16))) unsigned char lds_raw[];
    LAS unsigned char* lds = (LAS unsigned char*)lds_raw;
    cg::grid_group grid = cg::this_grid();
    volatile LAS unsigned* bst = (volatile LAS unsigned*)(lds + 131072);
    { const int t_ = opaque_tid(); if (t_ < 64) bst[t_] = 0u; }
    __syncthreads();
    XcdBarrier gbar;
    { PP q_ = get_params(); gbar = xcd_barrier_post((unsigned*)(q_->ws + WS_BAR), bst); }
#if PROBE
    int n_stamp = 0;
#define SYNC() do { xcd_barrier(gbar); if (opaque_blk() == 0 && opaque_tid() == 0) { PP q_ = get_params(); ((unsigned long long*)(q_->ws + 1280 * 1024))[n_stamp] = __builtin_amdgcn_s_memrealtime(); } ++n_stamp; } while (0)
#else
#define SYNC() xcd_barrier(gbar)
#endif
#define GSETUP PP q = get_params(); unsigned char* ws = q->ws; const int G = gridDim.x, blk = opaque_blk(); (void)ws; (void)G; (void)blk
#define SL(i) (ws + WS_S0 + (size_t)(i) * SLOT)

#if PROBE
    SYNC();
#endif
    phase_init(lds);
    grid.sync();
    phase_modreduce();
    SYNC();

#pragma unroll 1
    for (int l = 0; l < 2; ++l) {
        const bool last = (l == 1);
        const int nMt = last ? 64 : 72;
        phase_convert(lds, l, 0, l == 0 ? 0x1F : 0x8);
        if (l == 0 || gridDim.x != 256) { phase_modulate(l, 0, 1024, TT, l == 0); SYNC(); }
        {
            GSETUP; SchedG S{1, (const char*)SL(0), (const char*)(ws + W_RG), (char*)SL(1), (char*)SL(2), 1024, 1024, 72, 8, G, blk};
            gemm_phase(lds, GemmK{1024, 1024, 1024}, S, EpiStore{});
        }
        SYNC();
        phase_rnn(lds, l, 1, false);
        SYNC();
        phase_rnn_carry();
        SYNC();
        phase_rnn(lds, l, 2, last);
        SYNC();
        phase_sym();
        {
            GSETUP; SchedG S{9, (const char*)SL(0), (const char*)(ws + W_G + 0 * MiB), (char*)SL(3), (char*)(ws + W_M + 0 * MiB), 1024, 1024, nMt, 4, G, blk, (G == 256 && !last) ? 1 : 0};
            gemm_phase(lds, GemmK{1024, 1024, 1024}, S, EpiGateMerge{(bf16_t*)SL(1), q->in[17] + l * 3072 + 0 * 1024, (bf16_t*)SL(4), 1, (unsigned*)(ws + WS_CNT + 20480) + 0 * 32 * 16});
        }
        if (!last) {
            GSETUP; const int ns = (G >= 128) ? 64 : 0; if (blk >= ns) { SchedG S{7, (const char*)(ws + W_Z), (const char*)SL(0), nullptr, (char*)(ws + WS_ZTCTX), 1024, 1024, 0, 0, G - ns, blk - ns};
                gemm_phase(lds, GemmK{1024, 1024, 1024}, S, EpiStore{}); }
        }
        SYNC();
        {
            GSETUP; SchedG S{6, (const char*)(ws + W_Z), (const char*)SL(2), (char*)SL(1), (char*)(ws + WS_ZTCTX), 1024, 1024, 0, 0, G, blk};
            gemm_phase(lds, GemmK{1024, 1024, 1024}, S, EpiStoreAlt{(float*)(ws + WS_ALT16)});
        }
        SYNC();
        if (gridDim.x != 256) phase_alt();
        {
            GSETUP; const int fuse = (G == 256) ? 1 : 0; SchedG S{8, (const char*)(ws + WS_T), (const char*)SL(1), (char*)SL(3), nullptr, 1024, 1024, 0, 0, G, blk};
            gemm_phase(lds, GemmK{1024, 1024, 1024}, S, EpiEO{(bf16_t*)SL(3), (bf16_t*)SL(2), (const float*)(ws + WS_ZH), (const float*)(ws + WS_ALT16), (unsigned*)(ws + WS_CNT + 28672) + (size_t)l * 128 * 16, fuse});
        }
        if (!last) { GSETUP; SchedG Sc{5, (const char*)(ws + WS_TC), (const char*)(ws + WS_ZTCTX), (char*)SL(2), nullptr, 512, 512, 0, 0, G, (blk + 128) % G};
            gemm_phase(lds, GemmK{512, 512, 512}, Sc, EpiStore{}); }
        SYNC();
        if (gridDim.x != 256) { phase_combine(); SYNC(); }
        {
            GSETUP; SchedG S{9, (const char*)SL(0), (const char*)(ws + W_G + 2 * MiB), (char*)SL(2), (char*)(ws + W_M + 2 * MiB), 1024, 1024, nMt, 4, G, blk, (G == 256 && !last) ? 1 : 0};
            gemm_phase(lds, GemmK{1024, 1024, 1024}, S, EpiGateMerge{(bf16_t*)SL(1), q->in[17] + l * 3072 + 1 * 1024, (bf16_t*)SL(4), 0, (unsigned*)(ws + WS_CNT + 20480) + 1 * 32 * 16});
        }
        SYNC();
        {
            GSETUP; SchedG S{0, (const char*)SL(0), (const char*)(ws + W_QK), nullptr, nullptr, 1024, 1024, 72, 8, G, blk};
            gemm_phase(lds, GemmK{1024, 1024, 1024}, S, EpiQK{(bf16_t*)SL(1), (bf16_t*)SL(2), (const float*)(ws + WS_COS), (const float*)(ws + WS_SIN)});
        }
        {
            GSETUP; SchedG Sv{3, (const char*)(ws + W_V), (const char*)SL(0), (char*)SL(3), nullptr, 1024, 1024, 4, 72, G, (G - 1) - blk};
            gemm_phase(lds, GemmK{1024, 1024, 1024}, Sv, EpiStore{});
        }
        SYNC();
        phase_attn(lds, l, !last);
        SYNC();
        {
            GSETUP; SchedG S{9, (const char*)SL(0), (const char*)(ws + W_G + 4 * MiB), (char*)SL(1), (char*)(ws + W_M + 4 * MiB), 1024, 1024, nMt, 4, G, blk, (G == 256 && !last) ? 1 : 0};
            gemm_phase(lds, GemmK{1024, 1024, 1024}, S, EpiGateMerge{(bf16_t*)SL(2), q->in[17] + l * 3072 + 2 * 1024, (bf16_t*)SL(4), 0, (unsigned*)(ws + WS_CNT + 20480) + 2 * 32 * 16});
        }
        SYNC();
        {
            GSETUP; const int fuse = (G == 256) ? 1 : 0; const float* modl_ = (const float*)(ws + WS_MOD) + (size_t)l * 9 * NMOD;
            SchedG S{fuse ? 10 : 0, (const char*)SL(4), (const char*)(ws + W_O), nullptr, nullptr, 1024, 1024, nMt, 4, G, blk};
            gemm_phase(lds, GemmK{1024, 1024, 1024}, S, EpiResidNorm{q->out, (float*)(ws + WS_XCTX), modl_ + 2048, l == 0 ? q->in[0] : (const float*)q->out, l == 0 ? q->in[2] : (const float*)(ws + WS_XCTX),
                fuse, (bf16_t*)SL(0), modl_, 3072, 4096, (float*)(ws + WS_XSTAT), (unsigned*)(ws + WS_CNT) + (size_t)(l * 2 + 0) * 72 * 16, nullptr});
        }
        if (!last) phase_convert(lds, 1, 32, 0x1);
        SYNC();
        if (gridDim.x != 256) { phase_modulate(l, 3072, 4096, last ? TL : TT, false); SYNC(); }
        {
            GSETUP; SchedG S{0, (const char*)SL(0), (const char*)(ws + W_13), nullptr, nullptr, 1024, 1024, nMt, 22, G, blk};
            gemm_phase(lds, GemmK{1024, 1024, 1024}, S, EpiSwiGLU{(bf16_t*)SL(1)});
        }
        if (!last) phase_convert(lds, 1, 48, 0x2);
        SYNC();
        {
            GSETUP; const int fuse = (G == 256) ? 1 : 0; const float* modl_ = (const float*)(ws + WS_MOD) + (size_t)l * 9 * NMOD; const float* modn_ = (const float*)(ws + WS_MOD) + (size_t)(last ? l : l + 1) * 9 * NMOD;
            SchedG S{fuse ? 10 : 0, (const char*)SL(1), (const char*)(ws + W_2), nullptr, nullptr, DFF, DFF, nMt, 4, G, blk};
            gemm_phase(lds, GemmK{DFF, DFF, DFF}, S, EpiResidNorm{q->out, (float*)(ws + WS_XCTX), modl_ + 5120, (const float*)q->out, (const float*)(ws + WS_XCTX),
                fuse, (bf16_t*)SL(0), modn_, 0, 1024, (float*)(ws + WS_XSTAT), (unsigned*)(ws + WS_CNT) + (size_t)(l * 2 + 1) * 72 * 16, last ? q->in[22] : nullptr});
        }
        if (!last) phase_convert(lds, 1, 32, 0x14);
        if (!last || gridDim.x != 256) SYNC();
    }
    if (gridDim.x != 256) phase_final();
#if PROBE
    grid.sync();
    if (opaque_blk() == 0 && opaque_tid() == 0) { PP q_ = get_params(); const unsigned long long* ts = (const unsigned long long*)(q_->ws + 1280 * 1024);
        float x1 = 0.f, x2 = 0.f;
        PROBE_EXPR
        ((float*)(q_->ws + 1280 * 1024))[1024] = x2; q_->out[0] += x1; }
    __syncthreads();
    if (opaque_blk() == 0) { PP q_ = get_params(); const float x2 = ((const float*)(q_->ws + 1280 * 1024))[1024] * 0.1f; for (int i = opaque_tid(); i < 65536; i += 512) q_->out[8000 * 1024 + i] += x2; }
#endif
}

extern "C" void kernel_launch(void* const* d_in, const int* in_sizes, int n_in, void* d_out, int out_size, void* d_ws, size_t ws_size, hipStream_t stream) {
    static int grid = 0;
    if (grid == 0) {
        int dev = 0, cus = 0, per_cu = 0;
        (void)hipGetDevice(&dev);
        (void)hipDeviceGetAttribute(&cus, hipDeviceAttributeMultiprocessorCount, dev);
        (void)hipFuncSetAttribute((const void*)mega_fwd, hipFuncAttributeMaxDynamicSharedMemorySize, LDS_BYTES);
        (void)hipOccupancyMaxActiveBlocksPerMultiprocessor(&per_cu, (const void*)mega_fwd, 512, LDS_BYTES);
        if (per_cu < 1) { fprintf(stderr, "kernel_launch: occupancy query says %d blocks per CU\n", per_cu); per_cu = 1; }
        if (per_cu > 1) per_cu = 1;
        grid = cus * per_cu;
        if (n_in != 23 || ws_size < 253 * MiB) fprintf(stderr, "kernel_launch: unexpected n_in %d / ws_size %zu\n", n_in, ws_size);
    }
    Params p{};
    for (int i = 0; i < 23; ++i) p.in[i] = (const float*)d_in[i];
    p.out = (float*)d_out; p.ws = (unsigned char*)d_ws;
    (void)hipMemsetAsync((unsigned char*)d_ws + WS_BAR, 0, 65536, stream);
    void* args[] = {&p};
    hipError_t e = hipLaunchCooperativeKernel((const void*)mega_fwd, dim3(grid), dim3(512), args, LDS_BYTES, stream);
    if (e != hipSuccess) fprintf(stderr, "cooperative launch failed: %s (grid %d)\n", hipGetErrorString(e), grid);
}
```

```cpp
#include <hip/hip_runtime.h>
#include <hip/hip_cooperative_groups.h>
#include <cstdio>
#include <cstdint>
namespace cg = cooperative_groups;
#define PROBE 0
#define DT(a, b) ((float)(ts[b] - ts[a]) * 1e-4f)
#define PROBE_EXPR x1 = DT(2 + 20, 2 + 21); x2 = DT(2 + 21, 2 + 22);

#define LAS __attribute__((address_space(3)))
#define DEVINL __device__ __forceinline__
typedef unsigned short bf16_t;
typedef short bf16x8 __attribute__((ext_vector_type(8)));
typedef float f32x2 __attribute__((ext_vector_type(2)));
typedef float f32x4 __attribute__((ext_vector_type(4)));
typedef float f32x16 __attribute__((ext_vector_type(16)));
typedef unsigned u32x2 __attribute__((ext_vector_type(2)));
typedef unsigned u32x4 __attribute__((ext_vector_type(4)));
typedef __bf16 bf16x2_t __attribute__((ext_vector_type(2)));

constexpr int DM = 1024, NB = 8, SEQ = 2048, CTX = 256, TL = NB * SEQ, TC = NB * CTX, TT = TL + TC;
constexpr int DFF = 2816, NMOD = 6144;
constexpr float EPS = 1e-6f;
constexpr float C2 = 0.125f * 1.4426950408889634f;

constexpr size_t MiB = 1u << 20;
constexpr size_t WS_MOD = 0;
constexpr size_t WS_COS = 512 * 1024, WS_SIN = 768 * 1024;
constexpr size_t WS_BAR = 1536 * 1024;
constexpr size_t WS_XCTX = 2 * MiB;
constexpr size_t WS_T = 10 * MiB;
constexpr size_t WS_TC = 26 * MiB;
constexpr size_t WS_W = 27 * MiB;
constexpr size_t W_RG = WS_W, W_QK = WS_W + 4 * MiB, W_V = WS_W + 8 * MiB, W_Z = WS_W + 10 * MiB, W_G = WS_W + 14 * MiB,
                 W_M = WS_W + 20 * MiB, W_O = WS_W + 26 * MiB, W_13 = WS_W + 28 * MiB, W_2 = WS_W + 39 * MiB, W_RNN = WS_W + 44 * MiB + 512 * 1024;
constexpr size_t SLOT = 36 * MiB;
constexpr size_t WS_S0 = 73 * MiB, WS_S1 = WS_S0 + SLOT, WS_S2 = WS_S1 + SLOT, WS_S3 = WS_S2 + SLOT, WS_S4 = WS_S3 + SLOT;
constexpr int LDS_BYTES = 131072 + 8192;
constexpr size_t WS_CNT = WS_BAR + 16384;
constexpr size_t WS_ALT16 = WS_T + 12 * MiB + 128 * 1024;
constexpr size_t WS_XSTAT = WS_T + 13 * MiB;

struct Params { const float* in[23]; float* out; unsigned char* ws; };

DEVINL unsigned cvtpk(float lo, float hi) { f32x2 v = {lo, hi}; bf16x2_t b = __builtin_convertvector(v, bf16x2_t); return __builtin_bit_cast(unsigned, b); }
DEVINL float bf2f(unsigned short b) { return __builtin_bit_cast(float, (unsigned)b << 16); }
DEVINL float bflo(unsigned w) { return __builtin_bit_cast(float, w << 16); }
DEVINL float bfhi(unsigned w) { return __builtin_bit_cast(float, w & 0xffff0000u); }
DEVINL void bf8_unpack(const u32x4 x, float* f) { f[0] = bflo(x.x); f[1] = bfhi(x.x); f[2] = bflo(x.y); f[3] = bfhi(x.y); f[4] = bflo(x.z); f[5] = bfhi(x.z); f[6] = bflo(x.w); f[7] = bfhi(x.w); }
DEVINL u32x4 bf8_pack(const float* f) { u32x4 w; w.x = cvtpk(f[0], f[1]); w.y = cvtpk(f[2], f[3]); w.z = cvtpk(f[4], f[5]); w.w = cvtpk(f[6], f[7]); return w; }
DEVINL float shflx(float v, int mask, int lane) { return __builtin_bit_cast(float, __builtin_amdgcn_ds_bpermute((lane ^ mask) << 2, __builtin_bit_cast(int, v))); }
DEVINL float wave_sum(float v, int lane) {
#pragma unroll
    for (int o = 1; o < 64; o <<= 1) v += shflx(v, o, lane);
    return v;
}
DEVINL float max3f_(float a, float b, float c) { float r; asm("v_max3_f32 %0, %1, %2, %3" : "=v"(r) : "v"(a), "v"(b), "v"(c)); return r; }
DEVINL float sigmoidf_(float x) { return __builtin_amdgcn_rcpf(1.f + __expf(-x)); }
DEVINL float gelu_tanh(float x) { const float u = 0.7978845608028654f * (x + 0.044715f * x * x * x); const float e = __expf(2.f * u); const float t = 1.f - 2.f * __builtin_amdgcn_rcpf(e + 1.f); return 0.5f * x * (1.f + t); }
#define LDS_WAIT() asm volatile("s_waitcnt lgkmcnt(0)" ::: "memory")
DEVINL void st16_wt(void* p, u32x4 v) { asm volatile("global_store_dwordx4 %0, %1, off sc1\n\ts_nop 1" :: "v"(p), "v"(v) : "memory"); }
#define LDS_BARRIER() asm volatile("s_waitcnt lgkmcnt(0)\n\ts_barrier" ::: "memory")
DEVINL int opaque_tid() { int t = threadIdx.x; asm volatile("" : "+v"(t)); return t; }
DEVINL int opaque_blk() { int t = blockIdx.x; asm volatile("" : "+s"(t)); return t; }
typedef const __attribute__((address_space(4))) Params* PP;
DEVINL PP get_params() { PP q = (PP)__builtin_amdgcn_kernarg_segment_ptr(); asm volatile("" : "+s"(q)); return q; }

constexpr int BM = 256, BK = 64, HALF = 128, HTB = HALF * BK * 2;
DEVINL int lds_byte(int r, int c) { const int st = (r >> 4) * 2 + (c >> 5), rr = r & 15, cc = c & 31, ob = rr * 64 + cc * 2; return st * 1024 + (ob ^ (((ob >> 9) & 1) << 5)); }
DEVINL void stage_rc(int b, int& R, int& C) { const int st = b / 1024, sb = b % 1024, swz = sb ^ (((sb >> 9) & 1) << 5); R = (st >> 1) * 16 + swz / 64; C = (st & 1) * 32 + (swz % 64) / 2; }
DEVINL int perm32(int rho) { const int n = rho >> 4, i = rho & 15; return 8 * (i >> 2) + 4 * n + (i & 3); }

struct Unit { const char* a; const char* b; char* o; int ldo, pm, pn; };
struct GemmK { int lda, ldb, K; };

DEVINL bool tile_order(int i, int G, int c, int nM, int nN, int& pm, int& pn) {
    const long L = (long)i * G + c; const int nwg = nM * nN; if (L >= nwg) return false;
    int wgid = (int)L; { const int q = nwg / 8, r = nwg % 8, xcd = wgid % 8, off = wgid / 8; wgid = (xcd < r ? xcd * (q + 1) : r * (q + 1) + (xcd - r) * q) + off; }
    const int nig = 8 * nN, gid = wgid / nig, fm = gid * 8, gsz = (nM - fm) < 8 ? (nM - fm) : 8;
    pm = fm + ((wgid % nig) % gsz); pn = (wgid % nig) / gsz; return true;
}

struct SchedG {
    int kind; const char* A; const char* B; char* O; char* O2; int lda, ldb, nM, nN, G, c, pm0;
    DEVINL bool next(int i, Unit& u) const {
        int pm, pn;
        if (kind >= 4 && kind < 9) {
            const long L = (long)i * G + c;
            if (kind == 7) {
                if (L >= 64) return false; const int Lc = (int)L; pm = Lc >> 3; const int b = Lc & 7, part = pm >> 2, j0 = (pm & 3) * 256; pn = b;
                u.a = A + (size_t)pm * 256 * 1024 * 2; u.b = B + ((size_t)TL + b * 256) * 1024 * 2; u.o = O2 + ((((size_t)b * 1024 + j0) * 2 + part) * 256) * 2; u.ldo = 512;
            } else if (kind == 6) {
                if (L < 256) { const int part = (int)L >> 7; pm = ((int)L >> 5) & 3; pn = (int)L & 31; const int b = pn >> 2, n0 = (pn & 3) * 256;
                    u.a = A + ((size_t)part * 1024 + pm * 256) * 1024 * 2; u.b = B + (size_t)part * 16 * MiB + (size_t)pn * 256 * 1024 * 2;
                    u.o = O + (size_t)part * 16 * MiB + (((size_t)b * 1024 + pm * 256) * 1024 + n0) * 2; u.ldo = 1024; pn += 32 * part; }
                else if (L < 256 + nN) { const int Lc = (int)L - 256; pm = Lc >> 3; const int b = Lc & 7, part = pm >> 2, j0 = (pm & 3) * 256; pn = b;
                    u.a = A + (size_t)pm * 256 * 1024 * 2; u.b = B - 2 * SLOT + ((size_t)TL + b * 256) * 1024 * 2;
                    u.o = O2 + ((((size_t)b * 1024 + j0) * 2 + part) * 256) * 2; u.ldo = 512; }
                else return false;
            } else if (kind == 8) {
                if (L >= 256) return false; const int part = (int)L >> 7, b = ((int)L >> 4) & 7; pm = ((int)L >> 2) & 3; pn = (int)L & 3;
                u.a = A + (size_t)part * 2 * MiB + (size_t)pm * 256 * 1024 * 2; u.b = B + (size_t)part * 16 * MiB + ((size_t)b * 1024 + pn * 256) * 1024 * 2;
                u.o = O + (size_t)part * 16 * MiB + (((size_t)b * 1024 + pm * 256) * 1024 + pn * 256) * 2; u.ldo = 1024; pn |= (b << 2) | (part << 5); }
            else { if (L >= 32) return false; const int b = (int)L >> 2; pm = 0; pn = (int)L & 3;
                u.a = A; u.b = B + ((size_t)b * 1024 + pn * 256) * 512 * 2; u.o = O + (((size_t)TL + b * 256) * 1024 + pn * 256) * 2; u.ldo = 1024; }
            u.pm = pm; u.pn = pn; return true;
        }
        if (kind == 10) {
            if (i == 0) { pm = (c & 7) * 8 + (c >> 5); pn = (c >> 3) & 3; }
            else if (i == 1 && nM == 72 && c < 32) { pm = 64 + (c & 7); pn = c >> 3; }
            else return false;
            u.pm = pm; u.pn = pn; u.a = A + (size_t)pm * 256 * lda * 2; u.b = B + (size_t)pn * 256 * ldb * 2; u.o = O; u.ldo = 1024; return true;
        }
        if (kind == 9) {
            int sub;
            if (pm0) {
                if (i < 2) { if (!tile_order(0, G, c, 64, nN, pm, pn)) return false; sub = i; }
                else if (i == 2 && c < 64) { const int p = c & 31; pm = 64 + (p >> 2); pn = p & 3; sub = (c < 32) ? 2 : 3; }
                else return false;
            } else { if (!tile_order(i >> 1, G, c, nM, nN, pm, pn)) return false; sub = i & 1; }
            u.pm = pm; u.pn = pn; u.ldo = sub; u.o = nullptr;
            u.a = ((sub & 1) ? (const char*)O : A) + (size_t)pm * 256 * lda * 2; u.b = ((sub & 1) ? (const char*)O2 : B) + (size_t)pn * 256 * ldb * 2; return true;
        }
        if (!tile_order(i, G, c, nM, nN, pm, pn)) return false;
        pm += pm0; u.pm = pm; u.pn = pn; u.a = A + (size_t)pm * 256 * lda * 2; u.b = B + (size_t)pn * 256 * ldb * 2; u.o = O; u.ldo = 1024;
        if (kind == 1) { u.o = (pn < 4 ? O : O2) + ((size_t)pm * 256 * 1024 + (pn & 3) * 256) * 2; }
        else if (kind == 2) {
            const int part = pm >> 2, j0 = (pm & 3) * 256;
            if (pn < 64) { const int b = pn >> 3, n0 = (pn & 7) * 256; u.o = O + ((((size_t)b * 1024 + j0) * 2 + part) * 2048 + n0) * 2; u.ldo = 4096; }
            else { const int b = pn - 64; u.o = O2 + ((((size_t)b * 1024 + j0) * 2 + part) * 256) * 2; u.ldo = 512; }
        } else if (kind == 3) {
            int b, key0; if (pn < 64) { b = pn >> 3; key0 = (pn & 7) * 256; } else { b = pn - 64; key0 = 2048; }
            u.o = O + (((size_t)b * 1024 + pm * 256) * 2304 + key0) * 2; u.ldo = 2304;
        }
        return true;
    }
};

typedef f32x4 AccT[2][2][4][2];
struct EpiStore {
    static constexpr bool FUSED = false;
    DEVINL void operator()(const AccT& acc, const Unit& u, int wr, int wc, int fr, int fq) const {
#pragma unroll
        for (int ai = 0; ai < 2; ++ai)
#pragma unroll
            for (int m = 0; m < 4; ++m) { bf16_t* rowp = (bf16_t*)u.o + (size_t)(ai * 128 + wr * 64 + m * 16 + fr) * u.ldo + wc * 32 + 8 * fq;
#pragma unroll
                for (int bj = 0; bj < 2; ++bj) { const f32x4 v0 = acc[ai][bj][m][0], v1 = acc[ai][bj][m][1]; u32x4 w;
                    w.x = cvtpk(v0[0], v0[1]); w.y = cvtpk(v0[2], v0[3]); w.z = cvtpk(v1[0], v1[1]); w.w = cvtpk(v1[2], v1[3]); *(u32x4*)(rowp + bj * 128) = w; } }
    }
};
struct EpiQK {
    static constexpr bool FUSED = false;
    bf16_t* Q; bf16_t* K; const float* cosT; const float* sinT;
    DEVINL void operator()(const AccT& acc, const Unit& u, int wr, int wc, int fr, int fq) const {
        const bool isq = u.pn < 4; bf16_t* base = isq ? Q : K; const float sc = isq ? C2 : 1.f;
        const int hp = (u.pn & 3) * 2 + (wc >> 1), c = wc & 1, jj0 = 8 * fq;
#pragma unroll
        for (int ai = 0; ai < 2; ++ai)
#pragma unroll
            for (int m = 0; m < 4; ++m) { const int t = u.pm * 256 + ai * 128 + wr * 64 + m * 16 + fr; const bool lat = t < TL; const int pos = t & 2047;
                bf16_t* dst = base + (size_t)t * 1024 + hp * 128 + c * 64 + jj0; f32x4 o1[2], o2[2];
#pragma unroll
                for (int n = 0; n < 2; ++n) { f32x4 cs = {1.f, 1.f, 1.f, 1.f}, sn = {0.f, 0.f, 0.f, 0.f};
                    if (lat) { cs = *(const f32x4*)(cosT + pos * 32 + jj0 + 4 * n); sn = *(const f32x4*)(sinT + pos * 32 + jj0 + 4 * n); }
                    const f32x4 t1 = acc[ai][0][m][n], t2 = acc[ai][1][m][n]; o1[n] = (t1 * cs - t2 * sn) * sc; o2[n] = (t1 * sn + t2 * cs) * sc; }
                u32x4 w; w.x = cvtpk(o1[0][0], o1[0][1]); w.y = cvtpk(o1[0][2], o1[0][3]); w.z = cvtpk(o1[1][0], o1[1][1]); w.w = cvtpk(o1[1][2], o1[1][3]); *(u32x4*)dst = w;
                w.x = cvtpk(o2[0][0], o2[0][1]); w.y = cvtpk(o2[0][2], o2[0][3]); w.z = cvtpk(o2[1][0], o2[1][1]); w.w = cvtpk(o2[1][2], o2[1][3]); *(u32x4*)(dst + 32) = w; }
    }
};
struct EpiGate {
    static constexpr bool FUSED = false;
    bf16_t* Gd; const float* bias; int wt;
    DEVINL void operator()(const AccT& acc, const Unit& u, int wr, int wc, int fr, int fq) const {
        const int col0 = u.pn * 256 + wc * 32 + 8 * fq;
#pragma unroll
        for (int bj = 0; bj < 2; ++bj) { const f32x4 b0 = *(const f32x4*)(bias + col0 + bj * 128), b1 = *(const f32x4*)(bias + col0 + bj * 128 + 4);
#pragma unroll
            for (int ai = 0; ai < 2; ++ai)
#pragma unroll
                for (int m = 0; m < 4; ++m) { const int t = u.pm * 256 + ai * 128 + wr * 64 + m * 16 + fr; const f32x4 v0 = acc[ai][bj][m][0] + b0, v1 = acc[ai][bj][m][1] + b1; u32x4 w;
                    w.x = cvtpk(sigmoidf_(v0[0]), sigmoidf_(v0[1])); w.y = cvtpk(sigmoidf_(v0[2]), sigmoidf_(v0[3])); w.z = cvtpk(sigmoidf_(v1[0]), sigmoidf_(v1[1])); w.w = cvtpk(sigmoidf_(v1[2]), sigmoidf_(v1[3]));
                    if (wt) st16_wt(Gd + (size_t)t * 1024 + col0 + bj * 128, w); else *(u32x4*)(Gd + (size_t)t * 1024 + col0 + bj * 128) = w; } }
    }
};
struct EpiMerge {
    static constexpr bool FUSED = false;
    const bf16_t* Gs; bf16_t* Md; int first;
    DEVINL void operator()(const AccT& acc, const Unit& u, int wr, int wc, int fr, int fq) const {
        const int col0 = u.pn * 256 + wc * 32 + 8 * fq;
#pragma unroll
        for (int ai = 0; ai < 2; ++ai)
#pragma unroll
            for (int m = 0; m < 4; ++m) { const int t = u.pm * 256 + ai * 128 + wr * 64 + m * 16 + fr;
#pragma unroll
                for (int bj = 0; bj < 2; ++bj) { const size_t off = (size_t)t * 1024 + col0 + bj * 128; const u32x4 g = *(const u32x4*)(Gs + off); const f32x4 v0 = acc[ai][bj][m][0], v1 = acc[ai][bj][m][1];
                    float r0 = bflo(g.x) * v0[0], r1 = bfhi(g.x) * v0[1], r2 = bflo(g.y) * v0[2], r3 = bfhi(g.y) * v0[3], r4 = bflo(g.z) * v1[0], r5 = bfhi(g.z) * v1[1], r6 = bflo(g.w) * v1[2], r7 = bfhi(g.w) * v1[3];
                    if (!first) { const u32x4 o = *(const u32x4*)(Md + off); r0 += bflo(o.x); r1 += bfhi(o.x); r2 += bflo(o.y); r3 += bfhi(o.y); r4 += bflo(o.z); r5 += bfhi(o.z); r6 += bflo(o.w); r7 += bfhi(o.w); }
                    u32x4 w; w.x = cvtpk(r0, r1); w.y = cvtpk(r2, r3); w.z = cvtpk(r4, r5); w.w = cvtpk(r6, r7); *(u32x4*)(Md + off) = w; } }
    }
};
struct EpiGateMerge {
    static constexpr bool FUSED = true;
    bf16_t* Gd; const float* bias; bf16_t* Md; int first; unsigned* cnt;
    DEVINL void operator()(AccT& acc, const Unit& u, int wr, int wc, int fr, int fq, LAS unsigned char* lds, int wid, int lane) const {
        (void)lds;
        const int role = u.ldo; unsigned* cw = cnt + 16 * ((u.pm - 64) * 4 + u.pn);
        if (role == 0) { EpiGate g{Gd, bias, 0}; g(acc, u, wr, wc, fr, fq); }
        else if (role == 2) { EpiGate g{Gd, bias, 1}; g(acc, u, wr, wc, fr, fq);
            asm volatile("s_waitcnt vmcnt(0)" ::: "memory");
            if (lane == 0) __hip_atomic_fetch_add(cw, 1u, __ATOMIC_RELAXED, __HIP_MEMORY_SCOPE_AGENT); }
        else {
            if (role == 3) {
                if (wid == 0) { unsigned spins = 0;
                    while ((unsigned)__builtin_amdgcn_readfirstlane((int)__hip_atomic_load(cw, __ATOMIC_RELAXED, __HIP_MEMORY_SCOPE_AGENT)) < 8u) { __builtin_amdgcn_s_sleep(2); if (++spins > (1u << 22)) break; }
                    __builtin_amdgcn_fence(__ATOMIC_ACQUIRE, "agent"); }
                asm volatile("s_waitcnt vmcnt(0) lgkmcnt(0)\n\ts_barrier" ::: "memory");
            }
            EpiMerge m{Gd, Md, first}; m(acc, u, wr, wc, fr, fq); }
    }
};
struct EpiResid {
    static constexpr bool FUSED = false;
    float* Xlat; float* Xctx; const float* gmod; const float* Rlat; const float* Rctx;
    DEVINL void operator()(const AccT& acc, const Unit& u, int wr, int wc, int fr, int fq) const {
        const int col0 = u.pn * 256 + wc * 32 + 8 * fq; const int mr = u.pm < 64 ? (u.pm >> 3) : 8;
        float* xb = u.pm < 64 ? Xlat + (size_t)u.pm * 256 * 1024 : Xctx + (size_t)(u.pm - 64) * 256 * 1024;
        const float* rb = u.pm < 64 ? Rlat + (size_t)u.pm * 256 * 1024 : Rctx + (size_t)(u.pm - 64) * 256 * 1024;
#pragma unroll
        for (int bj = 0; bj < 2; ++bj) { const f32x4 g0 = *(const f32x4*)(gmod + mr * NMOD + col0 + bj * 128), g1 = *(const f32x4*)(gmod + mr * NMOD + col0 + bj * 128 + 4);
#pragma unroll
            for (int ai = 0; ai < 2; ++ai)
#pragma unroll
                for (int m = 0; m < 4; ++m) { const size_t xo = (size_t)(ai * 128 + wr * 64 + m * 16 + fr) * 1024 + col0 + bj * 128; float* xp = xb + xo;
                    f32x4 x0 = *(const f32x4*)(rb + xo), x1 = *(const f32x4*)(rb + xo + 4); x0 += g0 * acc[ai][bj][m][0]; x1 += g1 * acc[ai][bj][m][1]; *(f32x4*)xp = x0; *(f32x4*)(xp + 4) = x1; } }
    }
};
struct EpiResidNorm {
    static constexpr bool FUSED = true;
    float* Xlat; float* Xctx; const float* gmod; const float* Rlat; const float* Rctx;
    int fuse; bf16_t* H; const float* nmod; int shoff, scoff; float* xstat; unsigned* cnt; const float* fg;
    DEVINL void operator()(AccT& acc, const Unit& u, int wr, int wc, int fr, int fq, LAS unsigned char* lds, int wid, int lane) const {
        const int col0 = u.pn * 256 + wc * 32 + 8 * fq; const int mr = u.pm < 64 ? (u.pm >> 3) : 8;
        float* xb = u.pm < 64 ? Xlat + (size_t)u.pm * 256 * 1024 : Xctx + (size_t)(u.pm - 64) * 256 * 1024;
        const float* rb = u.pm < 64 ? Rlat + (size_t)u.pm * 256 * 1024 : Rctx + (size_t)(u.pm - 64) * 256 * 1024;
#pragma unroll
        for (int bj = 0; bj < 2; ++bj) { const f32x4 g0 = *(const f32x4*)(gmod + mr * NMOD + col0 + bj * 128), g1 = *(const f32x4*)(gmod + mr * NMOD + col0 + bj * 128 + 4);
#pragma unroll
            for (int ai = 0; ai < 2; ++ai)
#pragma unroll
                for (int m = 0; m < 4; ++m) { const size_t xo = (size_t)(ai * 128 + wr * 64 + m * 16 + fr) * 1024 + col0 + bj * 128; float* xp = xb + xo;
                    f32x4 x0 = *(const f32x4*)(rb + xo), x1 = *(const f32x4*)(rb + xo + 4); x0 += g0 * acc[ai][bj][m][0]; x1 += g1 * acc[ai][bj][m][1];
                    acc[ai][bj][m][0] = x0; acc[ai][bj][m][1] = x1; if (!(fuse && fg)) { *(f32x4*)xp = x0; *(f32x4*)(xp + 4) = x1; } } }
        if (!fuse) return;
        LAS float* P = (LAS float*)(lds + 131072 + 1024);
        LAS float* S = (LAS float*)(lds + 131072 + 5120);
#pragma unroll
        for (int ai = 0; ai < 2; ++ai)
#pragma unroll
            for (int m = 0; m < 4; ++m) { float sq = 0.f;
#pragma unroll
                for (int bj = 0; bj < 2; ++bj)
#pragma unroll
                    for (int n = 0; n < 2; ++n) { const f32x4 x = acc[ai][bj][m][n]; sq += (x[0] * x[0] + x[1] * x[1]) + (x[2] * x[2] + x[3] * x[3]); }
                sq += shflx(sq, 16, lane); sq += shflx(sq, 32, lane);
                if (fq == 0) P[(ai * 128 + wr * 64 + m * 16 + fr) * 4 + wc] = sq; }
        LDS_BARRIER();
        const int row = wid * 32 + (lane & 31);
        if (lane < 32) { const float t = (P[row * 4 + 0] + P[row * 4 + 1]) + (P[row * 4 + 2] + P[row * 4 + 3]);
            __hip_atomic_store((unsigned*)xstat + ((size_t)(u.pm * 256 + row) * 4 + u.pn), __builtin_bit_cast(unsigned, t), __ATOMIC_RELAXED, __HIP_MEMORY_SCOPE_AGENT); }
        asm volatile("s_waitcnt vmcnt(0)" ::: "memory");
        if (lane == 0) __hip_atomic_fetch_add(cnt + 16 * u.pm, 1u, __ATOMIC_RELAXED, __HIP_MEMORY_SCOPE_AGENT);
        if (wid == 0) { unsigned spins = 0;
            while ((unsigned)__builtin_amdgcn_readfirstlane((int)__hip_atomic_load(cnt + 16 * u.pm, __ATOMIC_RELAXED, __HIP_MEMORY_SCOPE_AGENT)) < 32u) { __builtin_amdgcn_s_sleep(2); if (++spins > (1u << 22)) break; }
            __builtin_amdgcn_fence(__ATOMIC_ACQUIRE, "agent"); }
        asm volatile("s_waitcnt vmcnt(0) lgkmcnt(0)\n\ts_barrier" ::: "memory");
        if (lane < 32) { const unsigned* sl = (const unsigned*)xstat + (size_t)(u.pm * 256 + row) * 4; float tot = 0.f;
#pragma unroll
            for (int t = 0; t < 4; ++t) tot += __builtin_bit_cast(float, __hip_atomic_load(sl + t, __ATOMIC_RELAXED, __HIP_MEMORY_SCOPE_AGENT));
            S[row] = rsqrtf(tot * (1.f / 1024.f) + EPS); }
        LDS_BARRIER();
        if (fg) {
#pragma unroll
            for (int bj = 0; bj < 2; ++bj) { const f32x4 g0 = *(const f32x4*)(fg + col0 + bj * 128), g1 = *(const f32x4*)(fg + col0 + bj * 128 + 4);
#pragma unroll
                for (int ai = 0; ai < 2; ++ai)
#pragma unroll
                    for (int m = 0; m < 4; ++m) { const int r = ai * 128 + wr * 64 + m * 16 + fr; const float rinv = S[r]; float* xp = xb + (size_t)r * 1024 + col0 + bj * 128;
                        *(f32x4*)xp = acc[ai][bj][m][0] * rinv * g0; *(f32x4*)(xp + 4) = acc[ai][bj][m][1] * rinv * g1; } }
            return;
        }
#pragma unroll
        for (int bj = 0; bj < 2; ++bj) { const float* mp = nmod + mr * NMOD + col0 + bj * 128;
            const f32x4 sc0 = *(const f32x4*)(mp + scoff) + 1.f, sc1 = *(const f32x4*)(mp + scoff + 4) + 1.f, sh0 = *(const f32x4*)(mp + shoff), sh1 = *(const f32x4*)(mp + shoff + 4);
#pragma unroll
            for (int ai = 0; ai < 2; ++ai)
#pragma unroll
                for (int m = 0; m < 4; ++m) { const int r = ai * 128 + wr * 64 + m * 16 + fr; const float rinv = S[r];
                    const f32x4 y0 = acc[ai][bj][m][0] * rinv * sc0 + sh0, y1 = acc[ai][bj][m][1] * rinv * sc1 + sh1; u32x4 w;
                    w.x = cvtpk(y0[0], y0[1]); w.y = cvtpk(y0[2], y0[3]); w.z = cvtpk(y1[0], y1[1]); w.w = cvtpk(y1[2], y1[3]);
                    *(u32x4*)(H + (size_t)(u.pm * 256 + r) * 1024 + col0 + bj * 128) = w; } }
    }
};
struct EpiStoreAlt {
    static constexpr bool FUSED = false;
    float* alt16;
    DEVINL void operator()(const AccT& acc, const Unit& u, int wr, int wc, int fr, int fq) const {
        EpiStore st; st(acc, u, wr, wc, fr, fq);
        if (u.pn < 32) { const int b = u.pn >> 2, q4 = u.pn & 3, lane = fq * 16 + fr;
#pragma unroll
            for (int ai = 0; ai < 2; ++ai)
#pragma unroll
                for (int m = 0; m < 4; ++m) { float sa = 0.f;
#pragma unroll
                    for (int bj = 0; bj < 2; ++bj)
#pragma unroll
                        for (int n = 0; n < 2; ++n) { const f32x4 x = acc[ai][bj][m][n]; sa += (x[0] - x[1]) + (x[2] - x[3]); }
                    sa += shflx(sa, 16, lane); sa += shflx(sa, 32, lane);
                    if (fq == 0) alt16[((size_t)(b * 1024 + u.pm * 256 + ai * 128 + wr * 64 + m * 16 + fr)) * 16 + q4 * 4 + wc] = sa; } }
    }
};
struct EpiEO {
    static constexpr bool FUSED = true;
    bf16_t* EO; bf16_t* Yb; const float* zh; const float* alt16; unsigned* cnt; int fuse;
    DEVINL void operator()(AccT& acc, const Unit& u, int wr, int wc, int fr, int fq, LAS unsigned char* lds, int wid, int lane) const {
        (void)lds;
        const int pn = u.pn & 3, b = (u.pn >> 2) & 7, part = u.pn >> 5; const int col0 = pn * 256 + wc * 32 + 8 * fq;
        const size_t tbase = ((size_t)b * 1024 + u.pm * 256) * 1024 + col0;
        bf16_t* mine = EO + (size_t)part * 8 * MiB + tbase; const bf16_t* other = EO + (size_t)(part ^ 1) * 8 * MiB + tbase;
#pragma unroll
        for (int ai = 0; ai < 2; ++ai)
#pragma unroll
            for (int m = 0; m < 4; ++m) { const int row = ai * 128 + wr * 64 + m * 16 + fr;
#pragma unroll
                for (int bj = 0; bj < 2; ++bj) { const f32x4 v0 = acc[ai][bj][m][0], v1 = acc[ai][bj][m][1]; u32x4 w;
                    w.x = cvtpk(v0[0], v0[1]); w.y = cvtpk(v0[2], v0[3]); w.z = cvtpk(v1[0], v1[1]); w.w = cvtpk(v1[2], v1[3]);
                    if (fuse) st16_wt(mine + (size_t)row * 1024 + bj * 128, w); else *(u32x4*)(mine + (size_t)row * 1024 + bj * 128) = w; } }
        if (!fuse) return;
        unsigned* cw = cnt + 16 * ((b * 4 + u.pm) * 4 + pn);
        asm volatile("s_waitcnt vmcnt(0)" ::: "memory");
        if (lane == 0) __hip_atomic_fetch_add(cw, 1u, __ATOMIC_RELAXED, __HIP_MEMORY_SCOPE_AGENT);
        if (wid == 0) { unsigned spins = 0;
            while ((unsigned)__builtin_amdgcn_readfirstlane((int)__hip_atomic_load(cw, __ATOMIC_RELAXED, __HIP_MEMORY_SCOPE_AGENT)) < 16u) { __builtin_amdgcn_s_sleep(2); if (++spins > (1u << 22)) break; }
            __builtin_amdgcn_fence(__ATOMIC_ACQUIRE, "agent"); }
        asm volatile("s_waitcnt vmcnt(0) lgkmcnt(0)\n\ts_barrier" ::: "memory");
        constexpr float SC = 0.022097086912079608f;
#pragma unroll
        for (int bj = 0; bj < 2; ++bj) { const float* zp = zh + b * 1024 + col0 + bj * 128; const f32x4 z0 = *(const f32x4*)zp, z1 = *(const f32x4*)(zp + 4);
            const float zv[8] = {z0.x, z0.y, z0.z, z0.w, z1.x, z1.y, z1.z, z1.w};
#pragma unroll
            for (int ai = 0; ai < 2; ++ai)
#pragma unroll
                for (int m = 0; m < 4; ++m) { const int row = ai * 128 + wr * 64 + m * 16 + fr, k = u.pm * 256 + row; const float sg = (k & 1) ? -SC : SC;
                    float ov[8], y[8]; bf8_unpack(*(const u32x4*)(other + (size_t)row * 1024 + bj * 128), ov);
                    const f32x4 a0 = acc[ai][bj][m][0], a1 = acc[ai][bj][m][1]; const float av[8] = {a0[0], a0[1], a0[2], a0[3], a1[0], a1[1], a1[2], a1[3]};
                    int dest;
                    if (part == 0) { dest = k;
#pragma unroll
                        for (int e = 0; e < 8; ++e) y[e] = (av[e] + sg * zv[e]) - ov[e]; }
                    else if (k != 0) { dest = 2048 - k;
#pragma unroll
                        for (int e = 0; e < 8; ++e) y[e] = (ov[e] + sg * zv[e]) + av[e]; }
                    else { dest = 1024;
#pragma unroll
                        for (int e = 0; e < 8; ++e) { const float* ap = alt16 + ((size_t)(b * 1024 + col0 + bj * 128 + e)) * 16; float al = 0.f;
#pragma unroll
                            for (int t = 0; t < 16; ++t) al += ap[t];
                            y[e] = SC * (zv[e] + al); } }
                    *(u32x4*)(Yb + ((size_t)b * 2048 + dest) * 1024 + col0 + bj * 128) = bf8_pack(y); } }
    }
};
struct EpiSwiGLU {
    static constexpr bool FUSED = false;
    bf16_t* Ud;
    DEVINL void operator()(const AccT& acc, const Unit& u, int wr, int wc, int fr, int fq) const {
        const int col0 = u.pn * 128 + wc * 32 + 8 * fq;
#pragma unroll
        for (int ai = 0; ai < 2; ++ai)
#pragma unroll
            for (int m = 0; m < 4; ++m) { const int t = u.pm * 256 + ai * 128 + wr * 64 + m * 16 + fr; float r[8];
#pragma unroll
                for (int n = 0; n < 2; ++n)
#pragma unroll
                    for (int j = 0; j < 4; ++j) { const float a = acc[ai][0][m][n][j], b = acc[ai][1][m][n][j]; r[n * 4 + j] = a * sigmoidf_(a) * b; }
                u32x4 w; w.x = cvtpk(r[0], r[1]); w.y = cvtpk(r[2], r[3]); w.z = cvtpk(r[4], r[5]); w.w = cvtpk(r[6], r[7]); *(u32x4*)(Ud + (size_t)t * DFF + col0) = w; }
    }
};

template <class Epi, class Sched>
DEVINL void gemm_phase(LAS unsigned char* lds, const GemmK g, const Sched& S, const Epi& E) {
    const int tid = opaque_tid(), wid = __builtin_amdgcn_readfirstlane(tid >> 6), lane = tid & 63, wr = wid >> 2, wc = wid & 3, fr = lane & 15, fq = lane >> 4;
    const int nt = g.K / BK;
    unsigned voffA[2], voffB[2];
#pragma unroll
    for (int i = 0; i < 2; ++i) { int R, C; stage_rc(tid * 16 + i * 8192, R, C); const int Rb = (R & ~31) + perm32(R & 31);
        voffA[i] = (unsigned)(R * g.lda + C) * 2u; voffB[i] = (unsigned)(Rb * g.ldb + C) * 2u; }
    const size_t kstep = (size_t)(BK * 2);
    const size_t hstepA = (size_t)HALF * g.lda * 2, hstepB = (size_t)HALF * g.ldb * 2;
    const unsigned ldsw = (unsigned)wid * 1024u;
    const int aoff = lds_byte(wr * 64 + fr, fq * 8), boff = lds_byte(wc * 32 + fr, fq * 8);
#define PG8_SA(b, h) (((b) * 2 + (h)) * HTB)
#define PG8_SB(b, h) ((4 + (b) * 2 + (h)) * HTB)
#define PG8_STAGE(bufoff, gbase, voff) do { _Pragma("unroll") for (int _i = 0; _i < 2; ++_i) \
        __builtin_amdgcn_global_load_lds((const unsigned*)((const char*)(gbase) + (voff)[_i]), (LAS unsigned*)(lds + (bufoff) + ldsw + _i * 8192), 16, 0, 0); } while (0)
#define PG8_LDA(dst, b, h) do { _Pragma("unroll") for (int m = 0; m < 4; ++m) _Pragma("unroll") for (int k = 0; k < 2; ++k) dst[m][k] = *(const LAS bf16x8*)(lds + PG8_SA(b, h) + aoff + m * 2048 + k * 1024); } while (0)
#define PG8_LDB(dst, b, h) do { _Pragma("unroll") for (int n = 0; n < 2; ++n) _Pragma("unroll") for (int k = 0; k < 2; ++k) dst[n][k] = *(const LAS bf16x8*)(lds + PG8_SB(b, h) + boff + n * 2048 + k * 1024); } while (0)
#define PG8_MMA(ai, bj, At, Bt) do { __builtin_amdgcn_s_setprio(1); _Pragma("unroll") for (int m = 0; m < 4; ++m) _Pragma("unroll") for (int n = 0; n < 2; ++n) _Pragma("unroll") for (int k = 0; k < 2; ++k) \
        acc[ai][bj][m][n] = __builtin_amdgcn_mfma_f32_16x16x32_bf16(Bt[n][k], At[m][k], acc[ai][bj][m][n], 0, 0, 0); __builtin_amdgcn_s_setprio(0); } while (0)
#define PG8_WAIT_V(n) asm volatile("s_waitcnt vmcnt(" #n ")" ::: "memory")
#define PG8_WAIT_L(n) asm volatile("s_waitcnt lgkmcnt(" #n ")" ::: "memory")
#define PG8_BAR __builtin_amdgcn_s_barrier()
#define PG8_SCHED __builtin_amdgcn_sched_barrier(0)
    Unit cur, nxt; int ui = 0;
    if (!S.next(0, cur)) return;
    f32x4 acc[2][2][4][2];
#pragma unroll
    for (int a = 0; a < 2; ++a)
#pragma unroll
        for (int b = 0; b < 2; ++b)
#pragma unroll
            for (int m = 0; m < 4; ++m)
#pragma unroll
                for (int n = 0; n < 2; ++n) acc[a][b][m][n] = (f32x4){0.f, 0.f, 0.f, 0.f};
    bf16x8 At[4][2], B0[2][2], B1[2][2];
    const char* cA = cur.a; const char* cB = cur.b;
    PG8_STAGE(PG8_SB(0, 0), cB, voffB); PG8_STAGE(PG8_SB(0, 1), cB + hstepB, voffB); PG8_STAGE(PG8_SA(0, 0), cA, voffA); PG8_STAGE(PG8_SA(0, 1), cA + hstepA, voffA);
    if (wr == 1) PG8_BAR;
    PG8_WAIT_V(2); PG8_BAR;
    PG8_STAGE(PG8_SB(1, 0), cB + kstep, voffB); PG8_STAGE(PG8_SA(1, 0), cA + kstep, voffA); PG8_STAGE(PG8_SB(1, 1), cB + hstepB + kstep, voffB);
    PG8_WAIT_V(6); PG8_BAR;
    for (;;) {
        const bool has_next = S.next(ui + 1, nxt);
        const char* nA = has_next ? nxt.a : cA; const char* nB = has_next ? nxt.b : cB;
        for (int t = 0; t < nt; t += 2) {
            const bool last = (t == nt - 2);
            const char* a1 = cA + (size_t)(t + 1) * kstep;
            const char* a2 = last ? nA : cA + (size_t)(t + 2) * kstep; const char* b2 = last ? nB : cB + (size_t)(t + 2) * kstep;
            const char* a3 = a2 + kstep; const char* b3 = b2 + kstep;
            PG8_LDB(B0, 0, 0); PG8_LDB(B1, 0, 1); PG8_SCHED; PG8_LDA(At, 0, 0); PG8_STAGE(PG8_SA(1, 1), a1 + hstepA, voffA);
            PG8_WAIT_V(8); PG8_WAIT_L(0); PG8_BAR; PG8_MMA(0, 0, At, B0); PG8_MMA(0, 1, At, B1); PG8_BAR; PG8_SCHED;
            PG8_LDA(At, 0, 1); PG8_STAGE(PG8_SB(0, 0), b2, voffB); PG8_STAGE(PG8_SB(0, 1), b2 + hstepB, voffB); PG8_STAGE(PG8_SA(0, 0), a2, voffA);
            PG8_WAIT_V(8); PG8_WAIT_L(0); PG8_BAR; PG8_MMA(1, 0, At, B0); PG8_MMA(1, 1, At, B1); PG8_BAR; PG8_SCHED;
            PG8_LDB(B0, 1, 0); PG8_LDB(B1, 1, 1); PG8_SCHED; PG8_LDA(At, 1, 0); PG8_STAGE(PG8_SA(0, 1), a2 + hstepA, voffA);
            PG8_WAIT_V(8); PG8_WAIT_L(0); PG8_BAR; PG8_MMA(0, 0, At, B0); PG8_MMA(0, 1, At, B1); PG8_BAR; PG8_SCHED;
            PG8_LDA(At, 1, 1); PG8_STAGE(PG8_SB(1, 0), b3, voffB); PG8_STAGE(PG8_SB(1, 1), b3 + hstepB, voffB); PG8_STAGE(PG8_SA(1, 0), a3, voffA);
            PG8_WAIT_V(8); PG8_WAIT_L(0); PG8_BAR; PG8_MMA(1, 0, At, B0); PG8_MMA(1, 1, At, B1); PG8_BAR; PG8_SCHED;
        }
        if (wr == 0) PG8_BAR;
        { int fr2 = fr, fq2 = fq; asm volatile("" : "+v"(fr2), "+v"(fq2));
          if constexpr (Epi::FUSED) E(acc, cur, wr, wc, fr2, fq2, lds, wid, lane); else E(acc, cur, wr, wc, fr2, fq2); }
        if (!has_next) break;
#pragma unroll
        for (int a = 0; a < 2; ++a)
#pragma unroll
            for (int b = 0; b < 2; ++b)
#pragma unroll
                for (int m = 0; m < 4; ++m)
#pragma unroll
                    for (int n = 0; n < 2; ++n) acc[a][b][m][n] = (f32x4){0.f, 0.f, 0.f, 0.f};
        cur = nxt; cA = nA; cB = nB; ++ui;
        if (wr == 1) PG8_BAR;
    }
    PG8_WAIT_V(0);
    PG8_BAR;
#undef PG8_SA
#undef PG8_SB
#undef PG8_STAGE
#undef PG8_LDA
#undef PG8_LDB
#undef PG8_MMA
#undef PG8_WAIT_V
#undef PG8_WAIT_L
#undef PG8_BAR
#undef PG8_SCHED
}

DEVINL void transpose_item(const float* W, int ldw, bf16_t* WT, int ldt, LAS float* scr, int lane) {
    float tv[32];
    unsigned voff = (unsigned)(lane >> 5) * (unsigned)ldw + (unsigned)(lane & 31); asm volatile("" : "+v"(voff));
#pragma unroll
    for (int i = 0; i < 32; ++i) tv[i] = (W + (size_t)(2 * i) * ldw)[voff];
#pragma unroll
    for (int i = 0; i < 32; ++i) { const int kk = 2 * i + (lane >> 5); scr[kk * 33 + (lane & 31)] = tv[i]; }
    LDS_WAIT();
    const int c = lane & 7;
#pragma unroll
    for (int j = 0; j < 4; ++j) { const int n = (lane >> 3) + 8 * j; const LAS float* s = scr + (8 * c) * 33 + n;
        u32x4 o; o.x = cvtpk(s[0 * 33], s[1 * 33]); o.y = cvtpk(s[2 * 33], s[3 * 33]); o.z = cvtpk(s[4 * 33], s[5 * 33]); o.w = cvtpk(s[6 * 33], s[7 * 33]);
        *(u32x4*)(WT + (size_t)n * ldt + 8 * c) = o; }
    LDS_WAIT();
}

DEVINL void phase_convert(LAS unsigned char* lds, int l, int nskip, int mask) {
    PP q = get_params();
    const int tid = opaque_tid(), lane = tid & 63, wave = __builtin_amdgcn_readfirstlane(tid >> 6), G = gridDim.x, blk = blockIdx.x;
    unsigned char* ws = q->ws;
    const float* w_in = q->in[6] + (size_t)l * 1024 * 6144;
    LAS float* scr = (LAS float*)(lds + wave * 8448);
    if (nskip >= G) nskip = 0;
    if (blk < nskip) return;
    const int gw = (blk - nskip) * 8 + wave, NGW = (G - nskip) * 8;
    constexpr int N_RG = 1024, N_QK = 1024, N_V = 512, N_G = 1536, N_M = 1536, N_O = 512, N_1 = 1408, N_3 = 1408, N_2 = 1408, N_R = 256;
    constexpr int NIT = N_RG + N_QK + N_V + N_G + N_M + N_O + N_1 + N_3 + N_2 + N_R;
    for (int it = gw; it < NIT; it += NGW) {
        int r = it;
        { const int grp = it < 5632 ? 1 : it < 6144 ? 2 : it < 8960 ? 4 : it < 10368 ? 8 : 1; if (!(mask & grp)) continue; }
        if (r < N_RG) { const int kb = r >> 6, nb = r & 63; transpose_item(w_in + (size_t)kb * 64 * 6144 + nb * 32, 6144, (bf16_t*)(ws + W_RG) + (size_t)nb * 32 * 1024 + kb * 64, 1024, scr, lane); continue; } r -= N_RG;
        if (r < N_QK) { const int kb = r >> 6, nb = r & 63; const int isk = nb >> 5, cc = (nb & 31) * 32, hh = cc >> 7, c = (cc >> 6) & 1, half = (cc >> 5) & 1;
            const int drow = (isk * 4 + (hh >> 1)) * 256 + half * 128 + (hh & 1) * 64 + c * 32;
            transpose_item(w_in + (size_t)kb * 64 * 6144 + 3072 + nb * 32, 6144, (bf16_t*)(ws + W_QK) + (size_t)drow * 1024 + kb * 64, 1024, scr, lane); continue; } r -= N_QK;
        if (r < N_V) { const int kb = r >> 5, nb = r & 31; transpose_item(w_in + (size_t)kb * 64 * 6144 + 5120 + nb * 32, 6144, (bf16_t*)(ws + W_V) + (size_t)nb * 32 * 1024 + kb * 64, 1024, scr, lane); continue; } r -= N_V;
        if (r < N_G) { const int kb = r / 96, nb = r % 96; transpose_item(q->in[16] + (size_t)l * 1024 * 3072 + (size_t)kb * 64 * 3072 + nb * 32, 3072, (bf16_t*)(ws + W_G) + (size_t)nb * 32 * 1024 + kb * 64, 1024, scr, lane); continue; } r -= N_G;
        if (r < N_M) { const int i = r / 512, rr = r % 512, kb = rr >> 5, nb = rr & 31;
            transpose_item(q->in[15] + (size_t)l * 3072 * 1024 + ((size_t)i * 1024 + kb * 64) * 1024 + nb * 32, 1024, (bf16_t*)(ws + W_M) + ((size_t)i * 1024 + nb * 32) * 1024 + kb * 64, 1024, scr, lane); continue; } r -= N_M;
        if (r < N_O) { const int kb = r >> 5, nb = r & 31; transpose_item(q->in[18] + (size_t)l * 1024 * 1024 + (size_t)kb * 64 * 1024 + nb * 32, 1024, (bf16_t*)(ws + W_O) + (size_t)nb * 32 * 1024 + kb * 64, 1024, scr, lane); continue; } r -= N_O;
        if (r < N_1 + N_3) { const int w3 = r >= N_1; if (w3) r -= N_1; const int kb = r / 88, nb = r % 88; const float* src = (w3 ? q->in[20] : q->in[19]) + (size_t)l * 1024 * DFF + (size_t)kb * 64 * DFF + nb * 32;
            const int drow = (nb >> 2) * 256 + w3 * 128 + (nb & 3) * 32;
            transpose_item(src, DFF, (bf16_t*)(ws + W_13) + (size_t)drow * 1024 + kb * 64, 1024, scr, lane); continue; } r -= N_1 + N_3;
        if (r < N_2) { const int kb = r >> 5, nb = r & 31; transpose_item(q->in[21] + (size_t)l * DFF * 1024 + (size_t)kb * 64 * 1024 + nb * 32, 1024, (bf16_t*)(ws + W_2) + (size_t)nb * 32 * DFF + kb * 64, DFF, scr, lane); continue; } r -= N_2;
        {
            const int mat = r >> 3, sub = r & 7, kb = sub >> 2, nb = sub & 3; const int dir = mat >> 4, ri = (mat >> 3) & 1, g = mat & 7;
            const float* src = (ri ? q->in[11] : q->in[9]) + ((size_t)((l * 2 + dir) * 8 + g)) * 16384 + (size_t)kb * 64 * 128 + nb * 32;
            transpose_item(src, 128, (bf16_t*)(ws + W_RNN) + ((size_t)((dir * 2 + ri) * 8 + g)) * 16384 + (size_t)nb * 32 * 128 + kb * 64, 128, scr, lane);
        }
    }
    __syncthreads();
    LAS float* wt = (LAS float*)lds; LAS f32x2* ct = (LAS f32x2*)(wt + 128 * 33);
    for (int it = (mask & 16) ? blk - nskip : 256; it < 256; it += G - nskip) {
        const int g = it >> 5, k0 = (it & 31) * 32;
        __syncthreads();
#pragma unroll
        for (int i = 0; i < 8; ++i) { const int e = tid + 512 * i, kk = e >> 7, c = e & 127; wt[c * 33 + kk] = w_in[(size_t)(k0 + kk) * 6144 + 2048 + g * 128 + c]; }
        if (tid < 128) ct[tid] = (f32x2){cospif((float)tid * (1.f / 64.f)), sinpif((float)tid * (1.f / 64.f))};
        __syncthreads();
        const int kl = tid & 31, mg = tid >> 5;
        float ac[8], as[8];
#pragma unroll
        for (int i = 0; i < 8; ++i) { ac[i] = 0.f; as[i] = 0.f; }
#pragma unroll 4
        for (int c = 0; c < 128; ++c) { const float w = wt[c * 33 + kl];
#pragma unroll
            for (int mi = 0; mi < 8; ++mi) { const f32x2 cs = ct[((mg * 8 + mi) * c) & 127]; ac[mi] += w * cs.x; as[mi] += w * cs.y; } }
        bf16_t* wz = (bf16_t*)(ws + W_Z);
#pragma unroll
        for (int mi = 0; mi < 8; ++mi) { const int m = mg * 8 + mi; const unsigned pc = cvtpk(ac[mi] * 0.08838834764831845f, as[mi] * 0.08838834764831845f);
            wz[(size_t)(g * 128 + m) * 1024 + k0 + kl] = (bf16_t)(pc & 0xffffu); wz[(size_t)(1024 + g * 128 + m) * 1024 + k0 + kl] = (bf16_t)(pc >> 16); }
    }
    __syncthreads();
}

DEVINL void phase_init(LAS unsigned char* lds) {
    PP q = get_params();
    const int tid = opaque_tid(), G = gridDim.x, blk = blockIdx.x;
    const size_t gtid = (size_t)blk * 512 + tid, gsz = (size_t)G * 512;
    unsigned char* ws = q->ws;
    { float* cT = (float*)(ws + WS_COS); float* sT = (float*)(ws + WS_SIN);
      for (size_t i = gtid; i < 65536; i += gsz) { const int pos = (int)i >> 5, jj = (int)i & 31, f = jj & 15; const float inv = powf(10000.f, -(float)f * (1.f / 16.f));
          const float crd = (jj < 16) ? (float)(pos >> 6) : (float)(pos & 63); const float ang = crd * inv; cT[i] = cosf(ang); sT[i] = sinf(ang); } }
    { bf16_t* T = (bf16_t*)(ws + WS_T);
      for (size_t i = gtid; i < (size_t)2 * 1024 * 1024 / 2; i += gsz) { const int part = (int)(i >> 19), k = (int)(i >> 9) & 1023, col = ((int)i & 511) * 2; float v[2];
#pragma unroll
          for (int e = 0; e < 2; ++e) { const int n = col + e, m = (k * n) & 2047; const float x = (float)m * (1.f / 1024.f); v[e] = (part ? sinpif(x) : cospif(x)) * 0.022097086912079608f; }
          ((unsigned*)T)[i] = cvtpk(v[0], v[1]); } }
    { bf16_t* T = (bf16_t*)(ws + WS_TC);
      for (size_t i = gtid; i < (size_t)256 * 512 / 2; i += gsz) { const int k = (int)(i >> 8), col = ((int)i & 255) * 2; float v[2];
#pragma unroll
          for (int e = 0; e < 2; ++e) { const int cc = col + e, n = cc & 255, m = (k * n) & 255; const float x = (float)m * (1.f / 128.f); v[e] = (cc < 256 ? cospif(x) : -sinpif(x)) * 0.0625f; }
          ((unsigned*)T)[i] = cvtpk(v[0], v[1]); } }
    LAS float* sc = (LAS float*)lds; float* part = (float*)(ws + WS_S0);
    for (int item = blk; item < 384; item += G) {
        const int l = item / 192, rem = item % 192, kc = rem / 24, nb = rem % 24;
        __syncthreads();
        for (int e = tid; e < 9 * 128; e += 512) { const int r = e >> 7, kk = e & 127; const float c = (r < 8) ? q->in[1][r * 1024 + kc * 128 + kk] : q->in[3][kc * 128 + kk]; sc[e] = c / (1.f + __expf(-c)); }
        __syncthreads();
        const int n = nb * 256 + (tid & 255), kh = tid >> 8; const float* w = q->in[4] + ((size_t)l * 1024 + kc * 128 + kh * 64) * NMOD + n;
        float acc[9];
#pragma unroll
        for (int r = 0; r < 9; ++r) acc[r] = 0.f;
#pragma unroll 4
        for (int kk = 0; kk < 64; ++kk) { const float wv = w[(size_t)kk * NMOD];
#pragma unroll
            for (int r = 0; r < 9; ++r) acc[r] += sc[r * 128 + kh * 64 + kk] * wv; }
#pragma unroll
        for (int r = 0; r < 9; ++r) part[((size_t)((kc * 2 + kh) * 2 + l) * 9 + r) * NMOD + n] = acc[r];
    }
}

DEVINL void phase_modreduce() {
    PP q = get_params();
    const size_t gtid = (size_t)blockIdx.x * 512 + opaque_tid(), gsz = (size_t)gridDim.x * 512;
    const float* part = (const float*)(q->ws + WS_S0); float* mod = (float*)(q->ws + WS_MOD);
    for (size_t i = gtid; i < 2 * 9 * NMOD; i += gsz) { const int l = (int)(i / (9 * NMOD)), n = (int)(i % NMOD); float s = q->in[5][l * NMOD + n];
#pragma unroll
        for (int j = 0; j < 16; ++j) s += part[(size_t)j * 2 * 9 * NMOD + i];
        mod[i] = s; }
}

DEVINL void phase_modulate(int l, int shoff, int scoff, int ntok, bool from_input) {
    PP q = get_params(); const float* modl = (const float*)(q->ws + WS_MOD) + (size_t)l * 9 * NMOD; bf16_t* H = (bf16_t*)(q->ws + WS_S0);
    const int tid = opaque_tid(), lane = tid & 63, wave = tid >> 6; const int gw = blockIdx.x * 8 + wave, NGW = gridDim.x * 8;
    const float* Xlat = from_input ? q->in[0] : q->out; const float* Xctx = from_input ? q->in[2] : (const float*)(q->ws + WS_XCTX);
    for (int tb = gw; tb < ntok; tb += 3 * NGW) {
        f32x4 v[3][4]; float ss[3];
#pragma unroll
        for (int u = 0; u < 3; ++u) { const int t = tb + u * NGW; ss[u] = 0.f;
            if (t < ntok) { const float* xr = t < TL ? Xlat + (size_t)t * 1024 : Xctx + (size_t)(t - TL) * 1024;
#pragma unroll
                for (int j = 0; j < 4; ++j) v[u][j] = ((const f32x4*)xr)[lane + 64 * j]; } }
#pragma unroll
        for (int u = 0; u < 3; ++u) { const int t = tb + u * NGW;
            if (t < ntok) {
#pragma unroll
                for (int j = 0; j < 4; ++j) ss[u] += v[u][j].x * v[u][j].x + v[u][j].y * v[u][j].y + v[u][j].z * v[u][j].z + v[u][j].w * v[u][j].w;
                const float rinv = rsqrtf(wave_sum(ss[u], lane) * (1.f / 1024.f) + EPS); const int r = t < TL ? (t >> 11) : 8;
                u32x2* o = (u32x2*)(H + (size_t)t * 1024);
#pragma unroll
                for (int j = 0; j < 4; ++j) { const int col = (lane + 64 * j) * 4; const f32x4 sc = *(const f32x4*)(modl + r * NMOD + scoff + col), sh = *(const f32x4*)(modl + r * NMOD + shoff + col);
                    const f32x4 y = v[u][j] * rinv * (sc + 1.f) + sh; u32x2 w; w.x = cvtpk(y.x, y.y); w.y = cvtpk(y.z, y.w); o[lane + 64 * j] = w; } } }
    }
}

DEVINL void phase_final() {
    PP q = get_params();
    const int tid = opaque_tid(), lane = tid & 63, wave = tid >> 6; const int gw = blockIdx.x * 8 + wave, NGW = gridDim.x * 8;
    f32x4 g[4];
#pragma unroll
    for (int j = 0; j < 4; ++j) g[j] = ((const f32x4*)q->in[22])[lane + 64 * j];
    for (int tb = gw; tb < TL; tb += 4 * NGW) {
        f32x4 v[4][4]; float ss[4];
#pragma unroll
        for (int u = 0; u < 4; ++u) { const int t = tb + u * NGW; ss[u] = 0.f;
            if (t < TL) {
#pragma unroll
                for (int j = 0; j < 4; ++j) v[u][j] = ((const f32x4*)(q->out + (size_t)t * 1024))[lane + 64 * j]; } }
#pragma unroll
        for (int u = 0; u < 4; ++u) { const int t = tb + u * NGW;
            if (t < TL) {
#pragma unroll
                for (int j = 0; j < 4; ++j) ss[u] += v[u][j].x * v[u][j].x + v[u][j].y * v[u][j].y + v[u][j].z * v[u][j].z + v[u][j].w * v[u][j].w;
                const float rinv = rsqrtf(wave_sum(ss[u], lane) * (1.f / 1024.f) + EPS);
#pragma unroll
                for (int j = 0; j < 4; ++j) ((f32x4*)(q->out + (size_t)t * 1024))[lane + 64 * j] = v[u][j] * rinv * g[j]; } }
    }
}

constexpr size_t WS_ZTCTX = WS_T + 4 * MiB, WS_ZH = WS_T + 12 * MiB, WS_ALT = WS_ZH + 64 * 1024;
DEVINL void phase_sym(int b0, int nb) {
    PP q = get_params(); const bf16_t* H = (const bf16_t*)(q->ws + WS_S0); bf16_t* HP = (bf16_t*)(q->ws + WS_S2); bf16_t* HM = (bf16_t*)(q->ws + WS_S2 + 16 * MiB);
    const bf16_t* WZ = (const bf16_t*)(q->ws + W_Z); float* zh = (float*)(q->ws + WS_ZH);
    const int blk_ = opaque_blk();
    if (blk_ < b0 || blk_ >= b0 + nb) return;
    const int tid = opaque_tid(), lane = tid & 63, wave = tid >> 6; const int gw = (blk_ - b0) * 8 + wave, NGW = nb * 8;
    for (int rb = gw; rb < 8192; rb += 2 * NGW) {
        u32x4 xa[2][2], xb[2][2];
#pragma unroll
        for (int u = 0; u < 2; ++u) { const int r = rb + u * NGW; if (r < 8192) { const int b = r >> 10, n = r & 1023;
            const u32x4* h1 = (const u32x4*)(H + ((size_t)b * 2048 + n) * 1024); const u32x4* h2 = (const u32x4*)(H + ((size_t)b * 2048 + ((2048 - n) & 2047)) * 1024);
            xa[u][0] = h1[lane]; xa[u][1] = h1[lane + 64]; xb[u][0] = h2[lane]; xb[u][1] = h2[lane + 64]; } }
#pragma unroll
        for (int u = 0; u < 2; ++u) { const int r = rb + u * NGW; if (r < 8192) { const int n = r & 1023;
#pragma unroll
            for (int jj = 0; jj < 2; ++jj) { float x[8], y[8], pp[8], mm[8]; bf8_unpack(xa[u][jj], x); bf8_unpack(xb[u][jj], y);
#pragma unroll
                for (int e = 0; e < 8; ++e) { pp[e] = n ? x[e] + y[e] : x[e]; mm[e] = n ? x[e] - y[e] : 0.f; }
                ((u32x4*)(HP + (size_t)r * 1024))[lane + 64 * jj] = bf8_pack(pp); ((u32x4*)(HM + (size_t)r * 1024))[lane + 64 * jj] = bf8_pack(mm); } } }
    }
    for (int rb = gw; rb < 8192; rb += 2 * NGW) {
        u32x4 wv[2][2], hv[2][2];
#pragma unroll
        for (int u = 0; u < 2; ++u) { const int r = rb + u * NGW; if (r < 8192) { const int b = r >> 10, j = r & 1023; const u32x4* w = (const u32x4*)(WZ + (size_t)j * 1024); const u32x4* h = (const u32x4*)(H + ((size_t)b * 2048 + 1024) * 1024);
            wv[u][0] = w[lane]; wv[u][1] = w[lane + 64]; hv[u][0] = h[lane]; hv[u][1] = h[lane + 64]; } }
#pragma unroll
        for (int u = 0; u < 2; ++u) { const int r = rb + u * NGW; if (r < 8192) { float a = 0.f;
#pragma unroll
            for (int jj = 0; jj < 2; ++jj) { float x[8], y[8]; bf8_unpack(wv[u][jj], x); bf8_unpack(hv[u][jj], y);
#pragma unroll
                for (int e = 0; e < 8; ++e) a += x[e] * y[e]; }
            a = wave_sum(a, lane); if (lane == 0) zh[r] = a; } }
    }
}
DEVINL void phase_alt() {
    PP q = get_params(); const bf16_t* ZTc = (const bf16_t*)(q->ws + WS_S1); float* alt = (float*)(q->ws + WS_ALT);
    const int tid = opaque_tid(), lane = tid & 63, wave = tid >> 6; const int gw = blockIdx.x * 8 + wave, NGW = gridDim.x * 8;
    for (int r = gw; r < 8192; r += NGW) { const u32x4* z = (const u32x4*)(ZTc + (size_t)r * 1024); float a = 0.f;
#pragma unroll
        for (int jj = 0; jj < 2; ++jj) { float x[8]; bf8_unpack(z[lane + 64 * jj], x); a += (x[0] - x[1]) + (x[2] - x[3]) + (x[4] - x[5]) + (x[6] - x[7]); }
        a = wave_sum(a, lane); if (lane == 0) alt[r] = a; }
}
DEVINL void phase_combine() {
    PP q = get_params(); const bf16_t* E = (const bf16_t*)(q->ws + WS_S3); const bf16_t* Od = (const bf16_t*)(q->ws + WS_S3 + 16 * MiB); bf16_t* Yb = (bf16_t*)(q->ws + WS_S2);
    const float* zh = (const float*)(q->ws + WS_ZH); const float* alt = (const float*)(q->ws + WS_ALT);
    const int tid = opaque_tid(), lane = tid & 63, wave = tid >> 6; const int gw = blockIdx.x * 8 + wave, NGW = gridDim.x * 8;
    constexpr float SC = 0.022097086912079608f;
    for (int r = gw; r < 8 * 1025; r += NGW) { const int b = r / 1025, kk = r % 1025;
#pragma unroll
        for (int jj = 0; jj < 2; ++jj) { const int j0 = (lane + 64 * jj) * 8; float z[8];
            { const f32x4 z0 = *(const f32x4*)(zh + b * 1024 + j0), z1 = *(const f32x4*)(zh + b * 1024 + j0 + 4); z[0] = z0.x; z[1] = z0.y; z[2] = z0.z; z[3] = z0.w; z[4] = z1.x; z[5] = z1.y; z[6] = z1.z; z[7] = z1.w; }
            if (kk == 1024) { float y[8]; const f32x4 a0 = *(const f32x4*)(alt + b * 1024 + j0), a1 = *(const f32x4*)(alt + b * 1024 + j0 + 4); const float av[8] = {a0.x, a0.y, a0.z, a0.w, a1.x, a1.y, a1.z, a1.w};
#pragma unroll
                for (int e = 0; e < 8; ++e) y[e] = SC * (z[e] + av[e]);
                *(u32x4*)(Yb + ((size_t)b * 2048 + 1024) * 1024 + j0) = bf8_pack(y); }
            else { float ev[8], ov[8], y1[8], y2[8]; bf8_unpack(*(const u32x4*)(E + ((size_t)b * 1024 + kk) * 1024 + j0), ev); bf8_unpack(*(const u32x4*)(Od + ((size_t)b * 1024 + kk) * 1024 + j0), ov);
                const float sg = (kk & 1) ? -SC : SC;
#pragma unroll
                for (int e = 0; e < 8; ++e) { const float base = ev[e] + sg * z[e]; y1[e] = base - ov[e]; y2[e] = base + ov[e]; }
                *(u32x4*)(Yb + ((size_t)b * 2048 + kk) * 1024 + j0) = bf8_pack(y1);
                if (kk) *(u32x4*)(Yb + ((size_t)b * 2048 + 2048 - kk) * 1024 + j0) = bf8_pack(y2); } }
    }
}

constexpr int NCHUNK = 576;
DEVINL void rnn_decode(int ck, int& t0, int& s0, int& s1) {
    if (ck < 512) { const int b = ck >> 6, cc = ck & 63; s0 = b * 2048; s1 = s0 + 2048; t0 = s0 + cc * 32; }
    else { const int b = (ck - 512) >> 3, cc = (ck - 512) & 7; s0 = TL + b * 256; s1 = s0 + 256; t0 = s0 + cc * 32; }
}
DEVINL void phase_rnn(LAS unsigned char* lds, int l, int pass, bool skip_ctx) {
    PP q = get_params();
    const bf16_t* XR = (const bf16_t*)(q->ws + WS_S1); const bf16_t* GR = (const bf16_t*)(q->ws + WS_S2); bf16_t* Ya = (bf16_t*)(q->ws + WS_S3); f32x2* totals = (f32x2*)(q->ws + WS_S3); const float* carry = (const float*)(q->ws + WS_S4);
    const int tid = opaque_tid(), lane = tid & 63, wave = __builtin_amdgcn_readfirstlane(tid >> 6), cl = lane & 15, fq = lane >> 4;
    const int G = gridDim.x, blk = blockIdx.x;
    LAS unsigned char* Us = lds;
    LAS f32x2* coef = (LAS f32x2*)(lds + 16384);
    const bf16_t* wrn = (const bf16_t*)(q->ws + W_RNN);
    const int per = (8 * NCHUNK + G - 1) / G;
    const int it0 = blk * per, it1 = (it0 + per) < 8 * NCHUNK ? (it0 + per) : 8 * NCHUNK;
    const int ctok = tid >> 4, ch8 = (tid & 15) * 8;
    const int mch = wave * 16 + cl;
    int gcur = -1; bf16x8 bfr[4][4]; f32x4 cw[4][2], cbv[2]; float brv[2], biv[2], lslv[2];
    u32x4 xr[4];
#define RNN_NEXT(it_) do { ++(it_); } while ((it_) < it1 && skip_ctx && ((it_) % NCHUNK) >= 512)
#define RNN_LOADX(it_) do { const int g_ = (it_) / NCHUNK, ck_ = (it_) % NCHUNK; int t0_, s0_, s1_; rnn_decode(ck_, t0_, s0_, s1_); \
        _Pragma("unroll") for (int k = 0; k < 4; ++k) { const int t_ = t0_ + ctok + k - 2; xr[k] = (u32x4){0u, 0u, 0u, 0u}; if (t_ >= s0_ && t_ < s1_) xr[k] = *(const u32x4*)(XR + (size_t)t_ * 1024 + g_ * 128 + ch8); } } while (0)
    int it = it0 - 1; RNN_NEXT(it);
    if (it < it1) RNN_LOADX(it);
    while (it < it1) {
        const int g = it / NCHUNK, ck = it % NCHUNK;
        int t0, s0, s1; rnn_decode(ck, t0, s0, s1);
        if (g != gcur) { gcur = g;
#pragma unroll
            for (int ty = 0; ty < 4; ++ty)
#pragma unroll
                for (int ks = 0; ks < 4; ++ks) bfr[ty][ks] = *(const bf16x8*)(wrn + ((size_t)(ty * 8 + g)) * 16384 + (size_t)mch * 128 + ks * 32 + fq * 8);
            const int gc = g * 128 + ch8; const float* cb = q->in[8] + l * 1024 + gc; cbv[0] = *(const f32x4*)cb; cbv[1] = *(const f32x4*)(cb + 4);
#pragma unroll
            for (int k = 0; k < 4; ++k) { const float* cwp = q->in[7] + (size_t)(l * 4 + k) * 1024 + gc; cw[k][0] = *(const f32x4*)cwp; cw[k][1] = *(const f32x4*)(cwp + 4); }
#pragma unroll
            for (int dir = 0; dir < 2; ++dir) { const int pi = (l * 2 + dir) * 1024 + g * 128 + mch; brv[dir] = q->in[10][pi]; biv[dir] = q->in[12][pi]; lslv[dir] = -8.f * log1pf(__expf(-q->in[13][pi])); } }
        { float u[8] = {cbv[0].x, cbv[0].y, cbv[0].z, cbv[0].w, cbv[1].x, cbv[1].y, cbv[1].z, cbv[1].w};
#pragma unroll
          for (int k = 0; k < 4; ++k) { const u32x4 x = xr[k]; const f32x4 w0 = cw[k][0], w1 = cw[k][1];
              u[0] += w0.x * bflo(x.x); u[1] += w0.y * bfhi(x.x); u[2] += w0.z * bflo(x.y); u[3] += w0.w * bfhi(x.y); u[4] += w1.x * bflo(x.z); u[5] += w1.y * bfhi(x.z); u[6] += w1.z * bflo(x.w); u[7] += w1.w * bfhi(x.w); }
          u32x4 w; w.x = cvtpk(u[0], u[1]); w.y = cvtpk(u[2], u[3]); w.z = cvtpk(u[4], u[5]); w.w = cvtpk(u[6], u[7]); *(LAS u32x4*)(Us + ctok * 272 + ch8 * 2) = w; }
        int itn = it; RNN_NEXT(itn);
        if (itn < it1) RNN_LOADX(itn);
        u32x4 grv = {0u, 0u, 0u, 0u};
        const size_t yoff = (size_t)(t0 + ctok) * 1024 + g * 128 + ch8;
        if (pass == 2) grv = *(const u32x4*)(GR + yoff);
        float hcar = 0.f;
        if (pass == 2 && tid < 256) hcar = carry[((size_t)(tid >> 7) * NCHUNK + ck) * 1024 + g * 128 + (tid & 127)];
        LDS_BARRIER();
        f32x4 acc[4][2];
#pragma unroll
        for (int ty = 0; ty < 4; ++ty) { acc[ty][0] = (f32x4){0.f, 0.f, 0.f, 0.f}; acc[ty][1] = (f32x4){0.f, 0.f, 0.f, 0.f}; }
#pragma unroll
        for (int ks = 0; ks < 4; ++ks) {
            const bf16x8 a0 = *(const LAS bf16x8*)(Us + cl * 272 + (ks * 32 + fq * 8) * 2), a1 = *(const LAS bf16x8*)(Us + (16 + cl) * 272 + (ks * 32 + fq * 8) * 2);
#pragma unroll
            for (int ty = 0; ty < 4; ++ty) { acc[ty][0] = __builtin_amdgcn_mfma_f32_16x16x32_bf16(a0, bfr[ty][ks], acc[ty][0], 0, 0, 0); acc[ty][1] = __builtin_amdgcn_mfma_f32_16x16x32_bf16(a1, bfr[ty][ks], acc[ty][1], 0, 0, 0); } }
        { const f32x2 br2 = {brv[0], brv[1]}, bi2 = {biv[0], biv[1]}, lsl2 = {lslv[0] * 1.4426950408889634f, lslv[1] * 1.4426950408889634f};
#pragma unroll
          for (int mt = 0; mt < 2; ++mt)
#pragma unroll
            for (int r = 0; r < 4; ++r) { const int tok = mt * 16 + fq * 4 + r; const float u = bf2f(*(const LAS bf16_t*)(Us + tok * 272 + mch * 2));
                const f32x2 tr = ((f32x2){acc[0][mt][r], acc[2][mt][r]} + br2) * -1.4426950408889634f, ti = ((f32x2){acc[1][mt][r], acc[3][mt][r]} + bi2) * -1.4426950408889634f;
                const f32x2 dr = (f32x2){__builtin_amdgcn_exp2f(tr.x), __builtin_amdgcn_exp2f(tr.y)} + 1.f, di = (f32x2){__builtin_amdgcn_exp2f(ti.x), __builtin_amdgcn_exp2f(ti.y)} + 1.f;
                const f32x2 rr = {__builtin_amdgcn_rcpf(dr.x), __builtin_amdgcn_rcpf(dr.y)}, ii = {__builtin_amdgcn_rcpf(di.x), __builtin_amdgcn_rcpf(di.y)};
                const f32x2 la2 = lsl2 * rr, a2 = la2 * 2.f;
                const f32x2 om = __builtin_elementwise_max((f32x2){1.f, 1.f} - (f32x2){__builtin_amdgcn_exp2f(a2.x), __builtin_amdgcn_exp2f(a2.y)}, (f32x2){0.f, 0.f});
                const f32x2 bb = (f32x2){__builtin_amdgcn_sqrtf(om.x), __builtin_amdgcn_sqrtf(om.y)} * ii * u;
                coef[(0 * 32 + tok) * 128 + mch] = (f32x2){la2.x, bb.x}; coef[(1 * 32 + tok) * 128 + mch] = (f32x2){la2.y, bb.y}; } }
        LDS_BARRIER();
        if (tid < 256) { const int dir = wave >> 1, ch = tid & 127; LAS f32x2* cp = coef + dir * 32 * 128 + ch; float h = hcar, P2 = 0.f;
            f32x2 cf[16];
            if (dir == 0) {
#pragma unroll
                for (int hf = 0; hf < 2; ++hf) {
#pragma unroll
                    for (int s = 0; s < 16; ++s) cf[s] = cp[(hf * 16 + s) * 128];
#pragma unroll
                    for (int s = 0; s < 16; ++s) { h = __builtin_amdgcn_exp2f(cf[s].x) * h + cf[s].y; P2 += cf[s].x; if (pass == 2) cp[(hf * 16 + s) * 128].y = h; } }
            } else {
#pragma unroll
                for (int hf = 0; hf < 2; ++hf) {
#pragma unroll
                    for (int s = 0; s < 16; ++s) cf[s] = cp[(31 - hf * 16 - s) * 128];
#pragma unroll
                    for (int s = 0; s < 16; ++s) { h = __builtin_amdgcn_exp2f(cf[s].x) * h + cf[s].y; P2 += cf[s].x; if (pass == 2) cp[(31 - hf * 16 - s) * 128].y = h; } }
            }
            if (pass == 1) totals[((size_t)dir * NCHUNK + ck) * 1024 + g * 128 + ch] = (f32x2){P2, h}; }
        if (pass == 2) {
            LDS_BARRIER();
            float y[8]; const float gv[8] = {bflo(grv.x), bfhi(grv.x), bflo(grv.y), bfhi(grv.y), bflo(grv.z), bfhi(grv.z), bflo(grv.w), bfhi(grv.w)};
#pragma unroll
            for (int e = 0; e < 8; ++e) { const float hs = coef[(0 * 32 + ctok) * 128 + ch8 + e].y + coef[(1 * 32 + ctok) * 128 + ch8 + e].y; y[e] = hs * gelu_tanh(gv[e]); }
            u32x4 w; w.x = cvtpk(y[0], y[1]); w.y = cvtpk(y[2], y[3]); w.z = cvtpk(y[4], y[5]); w.w = cvtpk(y[6], y[7]); *(u32x4*)(Ya + yoff) = w;
        }
        LDS_BARRIER();
        it = itn;
    }
#undef RNN_NEXT
#undef RNN_LOADX
}

DEVINL void phase_rnn_carry() {
    PP q = get_params(); const f32x2* totals = (const f32x2*)(q->ws + WS_S3); float* carry = (float*)(q->ws + WS_S4);
    const int gtid = blockIdx.x * 512 + opaque_tid();
    if (gtid >= NB * 2 * 1024) return;
    const int b = gtid >> 11, dir = (gtid >> 10) & 1, gc = gtid & 1023;
    float st = 0.f;
#pragma unroll 1
    for (int s0 = 0; s0 < 72; s0 += 24) { int idx[24]; f32x2 t[24];
#pragma unroll
        for (int j = 0; j < 24; ++j) { const int s = s0 + j; int ck; if (s < 8) { const int cc = dir ? 7 - s : s; ck = 512 + b * 8 + cc; } else { const int cc = dir ? 63 - (s - 8) : (s - 8); ck = b * 64 + cc; }
            idx[j] = (dir * NCHUNK + ck) * 1024 + gc; t[j] = totals[idx[j]]; }
#pragma unroll
        for (int j = 0; j < 24; ++j) { carry[idx[j]] = st; st = __builtin_amdgcn_exp2f(t[j].x) * st + t[j].y; } }
}

DEVINL void phase_attn(LAS unsigned char* lds, int l, bool do_ctx) {
    PP q = get_params(); bf16_t* Q = (bf16_t*)(q->ws + WS_S1); const bf16_t* K = (const bf16_t*)(q->ws + WS_S2); const bf16_t* VT = (const bf16_t*)(q->ws + WS_S3);
    const int tid = opaque_tid(), lane = tid & 63, wave = __builtin_amdgcn_readfirstlane(tid >> 6), r32 = lane & 31, hi = lane >> 5;
    const int G = gridDim.x, blk = blockIdx.x;
    const float* lv = q->in[14] + l * 256;
    const float s1 = wave_sum(lv[lane] * lv[64 + lane], lane), s2 = wave_sum(lv[128 + lane] * lv[192 + lane], lane);
    const float lam_init = 0.8f - 0.6f * expf(-0.3f * (float)l); const float lam = expf(s1) - expf(s2) + lam_init;
    const int nit = 1024 + (do_ctx ? 128 : 0);
    const int c = wave >> 2, qs = wave & 3;
    const int kperm = (r32 & ~12) | ((r32 & 4) << 1) | ((r32 & 8) >> 1);
    constexpr int STG = 35840, VOFF = 17408;
    const int vb = (G & 7) ? blk : (blk & 7) * (G >> 3) + (blk >> 3);
    for (int item = vb; item < nit; item += G) {
        int b, h, q0, kt0;
        if (item < 1024) { b = item >> 7; h = (item >> 4) & 7; q0 = b * 2048 + (item & 15) * 128; kt0 = 0; }
        else { const int j = item - 1024; b = j >> 4; h = (j >> 1) & 7; q0 = TL + b * 256 + (j & 1) * 128; kt0 = 32; }
        const int tq = q0 + qs * 32 + r32;
        bf16x8 qf[4];
#pragma unroll
        for (int ks = 0; ks < 4; ++ks) qf[ks] = *(const bf16x8*)(Q + (size_t)tq * 1024 + h * 128 + c * 64 + ks * 16 + hi * 8);
        f32x16 O[4];
#pragma unroll
        for (int n = 0; n < 4; ++n)
#pragma unroll
            for (int i = 0; i < 16; ++i) O[n][i] = 0.f;
        float mrun = 0.f, lsum = 0.f;
        const int kkey = tid >> 3, kpart = tid & 7, vvd = tid >> 2, vpart = tid & 3;
        u32x4 kr0, kr1, vr0, vr1;
#define ATT_LOAD(kt) do { const int tk_ = ((kt) < 32 ? b * 2048 + (kt) * 64 : TL + b * 256 + ((kt) - 32) * 64) + kkey; const bf16_t* ks_ = K + (size_t)tk_ * 1024 + h * 128 + kpart * 16; \
            kr0 = *(const u32x4*)ks_; kr1 = *(const u32x4*)(ks_ + 8); const bf16_t* vs_ = VT + ((size_t)(b * 1024 + h * 128 + vvd)) * 2304 + (kt) * 64 + vpart * 16; vr0 = *(const u32x4*)vs_; vr1 = *(const u32x4*)(vs_ + 8); } while (0)
        constexpr int KST = 17408, VBASE = 2 * 17408, VST = 18432;
#define ATT_STORE(ks_, vs_) do { LAS unsigned char* kb_ = lds + (ks_) * KST + kkey * 272 + kpart * 32; *(LAS u32x4*)kb_ = kr0; *(LAS u32x4*)(kb_ + 16) = kr1; \
            LAS unsigned char* vb_ = lds + VBASE + (vs_) * VST + vvd * 144 + vpart * 32; *(LAS u32x4*)vb_ = vr0; *(LAS u32x4*)(vb_ + 16) = vr1; } while (0)
#define ATT_VLD(dst, Vb_, n_) do { _Pragma("unroll") for (int j = 0; j < 4; ++j) dst[j] = *(const LAS bf16x8*)((Vb_) + ((n_) * 32 + r32) * 144 + (j * 16 + hi * 8) * 2); } while (0)
#define ATT_PVM(src, P_, n_) do { _Pragma("unroll") for (int j = 0; j < 4; ++j) O[n_] = __builtin_amdgcn_mfma_f32_32x32x16_bf16(src[j], P_[j >> 1][j & 1], O[n_], 0, 0, 0); } while (0)
#define ATT_PV(Vb_, P_) do { ATT_VLD(fb, Vb_, 1); __builtin_amdgcn_sched_barrier(0); ATT_PVM(fa, P_, 0); ATT_VLD(fa, Vb_, 2); __builtin_amdgcn_sched_barrier(0); \
            ATT_PVM(fb, P_, 1); ATT_VLD(fb, Vb_, 3); __builtin_amdgcn_sched_barrier(0); ATT_PVM(fa, P_, 2); ATT_PVM(fb, P_, 3); } while (0)
        ATT_LOAD(kt0); ATT_STORE(0, 0);
        LDS_BARRIER();
        bf16x8 pp[2][2];
#pragma unroll
        for (int a_ = 0; a_ < 2; ++a_)
#pragma unroll
            for (int b_ = 0; b_ < 2; ++b_) pp[a_][b_] = (bf16x8){0, 0, 0, 0, 0, 0, 0, 0};
        int vcur = 0;
        for (int kt = kt0; kt < 36; ++kt) {
            const int cur = (kt - kt0) & 1; const int vprev = vcur == 0 ? 2 : vcur - 1, vnext = vcur == 2 ? 0 : vcur + 1;
            if (kt + 1 < 36) ATT_LOAD(kt + 1);
            const LAS unsigned char* Kb = lds + cur * KST; const LAS unsigned char* Vb = lds + VBASE + vcur * VST;
            bf16x8 fa[4], fb[4];
            if (c == 1 && kt > kt0) {
                const LAS unsigned char* Vp = lds + VBASE + vprev * VST;
                ATT_VLD(fa, Vp, 0); __builtin_amdgcn_sched_barrier(0); ATT_PV(Vp, pp);
            }
            f32x16 S0, S1;
#pragma unroll
            for (int i = 0; i < 16; ++i) { S0[i] = -mrun; S1[i] = -mrun; }
            bf16x8 kf[8];
#pragma unroll
            for (int ks = 0; ks < 4; ++ks) { kf[2 * ks] = *(const LAS bf16x8*)(Kb + kperm * 272 + (c * 64 + ks * 16 + hi * 8) * 2); kf[2 * ks + 1] = *(const LAS bf16x8*)(Kb + (32 + kperm) * 272 + (c * 64 + ks * 16 + hi * 8) * 2); }
            __builtin_amdgcn_sched_barrier(0);
#pragma unroll
            for (int ks = 0; ks < 4; ++ks) { S0 = __builtin_amdgcn_mfma_f32_32x32x16_bf16(kf[2 * ks], qf[ks], S0, 0, 0, 0); S1 = __builtin_amdgcn_mfma_f32_32x32x16_bf16(kf[2 * ks + 1], qf[ks], S1, 0, 0, 0); }
            if (c == 0) ATT_VLD(fa, Vb, 0);
            __builtin_amdgcn_sched_barrier(0);
            float mxa = max3f_(S0[0], S1[0], S0[1]), mxb = max3f_(S1[1], S0[2], S1[2]);
#pragma unroll
            for (int i = 3; i < 15; i += 2) { mxa = max3f_(mxa, S0[i], S1[i]); mxb = max3f_(mxb, S0[i + 1], S1[i + 1]); }
            float mx = max3f_(mxa, mxb, fmaxf(S0[15], S1[15]));
            mx = fmaxf(mx, shflx(mx, 32, lane));
            const float dlt = (fabsf(mx) > 8.f) ? mx : 0.f;
            if (__builtin_amdgcn_ballot_w64(dlt != 0.f) != 0ull) {
                const float alpha = __builtin_amdgcn_exp2f(-dlt); mrun += dlt; lsum *= alpha;
#pragma unroll
                for (int i = 0; i < 16; ++i) { S0[i] -= dlt; S1[i] -= dlt; }
#pragma unroll
                for (int n = 0; n < 4; ++n)
#pragma unroll
                    for (int i = 0; i < 16; ++i) O[n][i] *= alpha;
            }
            f32x2 ps2 = {0.f, 0.f};
#pragma unroll
            for (int i = 0; i < 16; i += 2) { S0[i] = __builtin_amdgcn_exp2f(S0[i]); S0[i + 1] = __builtin_amdgcn_exp2f(S0[i + 1]); S1[i] = __builtin_amdgcn_exp2f(S1[i]); S1[i + 1] = __builtin_amdgcn_exp2f(S1[i + 1]);
                ps2 += (f32x2){S0[i], S0[i + 1]} + (f32x2){S1[i], S1[i + 1]}; }
            lsum += ps2.x + ps2.y;
            bf16x8 pf[2][2];
#pragma unroll
            for (int s = 0; s < 2; ++s) { u32x4 w0, w1;
                w0.x = cvtpk(S0[8 * s + 0], S0[8 * s + 1]); w0.y = cvtpk(S0[8 * s + 2], S0[8 * s + 3]); w0.z = cvtpk(S0[8 * s + 4], S0[8 * s + 5]); w0.w = cvtpk(S0[8 * s + 6], S0[8 * s + 7]);
                w1.x = cvtpk(S1[8 * s + 0], S1[8 * s + 1]); w1.y = cvtpk(S1[8 * s + 2], S1[8 * s + 3]); w1.z = cvtpk(S1[8 * s + 4], S1[8 * s + 5]); w1.w = cvtpk(S1[8 * s + 6], S1[8 * s + 7]);
                pf[0][s] = __builtin_bit_cast(bf16x8, w0); pf[1][s] = __builtin_bit_cast(bf16x8, w1); }
            __builtin_amdgcn_sched_barrier(0);
            if (c == 0) { ATT_PV(Vb, pf); }
            else {
#pragma unroll
                for (int a_ = 0; a_ < 2; ++a_)
#pragma unroll
                    for (int b_ = 0; b_ < 2; ++b_) pp[a_][b_] = pf[a_][b_]; }
            if (kt + 1 < 36) ATT_STORE(cur ^ 1, vnext);
            LDS_BARRIER();
            vcur = vnext;
        }
        if (c == 1) { const LAS unsigned char* Vl = lds + VBASE + (vcur == 0 ? 2 : vcur - 1) * VST; bf16x8 fa[4], fb[4];
            ATT_VLD(fa, Vl, 0); __builtin_amdgcn_sched_barrier(0); ATT_PV(Vl, pp); }
        LDS_BARRIER();
#undef ATT_VLD
#undef ATT_PVM
#undef ATT_PV
#undef ATT_LOAD
#undef ATT_STORE
        lsum += shflx(lsum, 32, lane);
        const float inv = 1.f / lsum;
        LAS float* xb = (LAS float*)lds + qs * (32 * 132) + r32 * 132;
        if (c == 1) { const float f = inv * lam;
#pragma unroll
            for (int n = 0; n < 4; ++n)
#pragma unroll
                for (int gq = 0; gq < 4; ++gq) { const int vd = n * 32 + 8 * gq + 4 * hi; *(LAS f32x4*)(xb + vd) = (f32x4){O[n][4 * gq] * f, O[n][4 * gq + 1] * f, O[n][4 * gq + 2] * f, O[n][4 * gq + 3] * f}; } }
        LDS_BARRIER();
        if (c == 0) { float ss = 0.f;
#pragma unroll
            for (int n = 0; n < 4; ++n)
#pragma unroll
                for (int gq = 0; gq < 4; ++gq) { const int vd = n * 32 + 8 * gq + 4 * hi; const f32x4 o1 = *(const LAS f32x4*)(xb + vd);
#pragma unroll
                    for (int j = 0; j < 4; ++j) { const float o = O[n][4 * gq + j] * inv - o1[j]; O[n][4 * gq + j] = o; ss += o * o; } }
            ss += shflx(ss, 32, lane);
            const float rn = rsqrtf(ss * (1.f / 128.f) + EPS) * (1.f - lam_init);
            bf16_t* dst = Q + (size_t)tq * 1024 + h * 128;
#pragma unroll
            for (int n = 0; n < 4; ++n)
#pragma unroll
                for (int gq = 0; gq < 4; ++gq) { const int vd = n * 32 + 8 * gq + 4 * hi; u32x2 w; w.x = cvtpk(O[n][4 * gq] * rn, O[n][4 * gq + 1] * rn); w.y = cvtpk(O[n][4 * gq + 2] * rn, O[n][4 * gq + 3] * rn); *(u32x2*)(dst + vd) = w; } }
        LDS_BARRIER();
    }
}

#define XB_TMO      128
#define XB_XCNT(j)  (256  + 64 * (j))
#define XB_XSUB(j)  (1280 + 64 * (j))
#define XB_XGEN(j)  (2304 + 64 * (j))
#define XB_TOP      3328
#define XB_TOPGEN   3392
#define XCD_BAR_WORDS 3456
#define XB_SPIN_CAP (1u << 18)

__device__ __forceinline__ unsigned xb_ld(unsigned* p)              { return __hip_atomic_load(p, __ATOMIC_RELAXED, __HIP_MEMORY_SCOPE_AGENT); }
__device__ __forceinline__ unsigned xb_add(unsigned* p, unsigned v) { return __hip_atomic_fetch_add(p, v, __ATOMIC_RELAXED, __HIP_MEMORY_SCOPE_AGENT); }
__device__ __forceinline__ unsigned xb_xcc_id() { return (unsigned)__builtin_amdgcn_s_getreg((3 << 11) | 20) & 0xFu; }
#define XB_SPIN(cond, bar) do { unsigned _sp = 0; while (cond) { __builtin_amdgcn_s_sleep(1); \
    if ((++_sp & 255u) == 0u) { if (xb_ld(&(bar)[XB_TMO])) break; if (_sp > XB_SPIN_CAP) { atomicAdd(&(bar)[XB_TMO], 1u); break; } } } } while (0)

struct XcdBarrier {
    unsigned* bar; unsigned x;
    volatile LAS unsigned* st;
};

__device__ __forceinline__ XcdBarrier xcd_barrier_post(unsigned* bar, volatile LAS unsigned* st) {
    XcdBarrier b; b.bar = bar; b.x = xb_xcc_id(); b.st = st;
    if (opaque_tid() == 0) (void)xb_add(&bar[XB_XCNT(b.x)], 1u);
    return b;
}
__device__ __forceinline__ void xcd_barrier_complete(unsigned* bar, unsigned x, unsigned& nloc, unsigned& nx) {
    const unsigned G = gridDim.x * gridDim.y * gridDim.z;
    unsigned sum, cnt, mine, sp = 0u;
    for (;;) {
        sum = 0u; cnt = 0u; mine = 0u;
#pragma unroll
        for (unsigned j = 0; j < 16; ++j) { const unsigned c = xb_ld(&bar[XB_XCNT(j)]); sum += c; cnt += (c > 0u) ? 1u : 0u; mine = (j == x) ? c : mine; }
        if (sum == G) break;
        __builtin_amdgcn_s_sleep(1);
        if ((++sp & 255u) == 0u) { if (xb_ld(&bar[XB_TMO])) break; if (sp > XB_SPIN_CAP) { atomicAdd(&bar[XB_TMO], 1u); break; } }
    }
    nloc = mine > 0u ? mine : 1u; nx = cnt > 0u ? cnt : 1u;
}

__device__ __forceinline__ void xcd_barrier(const XcdBarrier& b) {
    asm volatile("s_waitcnt vmcnt(0)" ::: "memory");
    __syncthreads();
    if (opaque_tid() == 0) {
        unsigned* bar = (unsigned*)(get_params()->ws + WS_BAR);
        unsigned bx = xb_xcc_id(); asm volatile("" : "+s"(bx));
        __builtin_amdgcn_s_waitcnt(0);
        unsigned nloc = b.st[0], nx = b.st[1];
        if (nloc == 0u) { xcd_barrier_complete(bar, bx, nloc, nx); b.st[0] = nloc; b.st[1] = nx; }
        const unsigned old = xb_add(&bar[XB_XSUB(bx)], 1u);
        const unsigned gen = old / nloc;
        if (old + 1u == (gen + 1u) * nloc) {
            __builtin_amdgcn_fence(__ATOMIC_RELEASE, "agent");
            asm volatile("s_waitcnt vmcnt(0)" ::: "memory");
            const unsigned og = xb_add(&bar[XB_TOP], 1u);
            const unsigned tg = og / nx;
            if (og + 1u == (tg + 1u) * nx) xb_add(&bar[XB_TOPGEN], 1u);
            else XB_SPIN(xb_ld(&bar[XB_TOPGEN]) == tg, bar);
            __builtin_amdgcn_fence(__ATOMIC_ACQUIRE, "agent");
            xb_add(&bar[XB_XGEN(bx)], 1u);
            asm volatile("s_waitcnt vmcnt(0)" ::: "memory");
        } else {
            XB_SPIN(xb_ld(&bar[XB_XGEN(bx)]) == gen, bar);
            __builtin_amdgcn_fence(__ATOMIC_ACQUIRE, "agent");
            asm volatile("s_waitcnt vmcnt(0)" ::: "memory");
        }
    }
    __syncthreads();
}


__global__ void __launch_bounds__(512) mega_fwd(Params p_unused) {
    extern __shared__ __attribute__((aligned(16))) unsigned char lds_raw[];
    LAS unsigned char* lds = (LAS unsigned char*)lds_raw;
    cg::grid_group grid = cg::this_grid();
    volatile LAS unsigned* bst = (volatile LAS unsigned*)(lds + 131072);
    { const int t_ = opaque_tid(); if (t_ < 64) bst[t_] = 0u; }
    __syncthreads();
    XcdBarrier gbar;
    { PP q_ = get_params(); gbar = xcd_barrier_post((unsigned*)(q_->ws + WS_BAR), bst); }
#if PROBE
    int n_stamp = 0;
#define SYNC() do { xcd_barrier(gbar); if (opaque_blk() == 0 && opaque_tid() == 0) { PP q_ = get_params(); ((unsigned long long*)(q_->ws + 1280 * 1024))[n_stamp] = __builtin_amdgcn_s_memrealtime(); } ++n_stamp; } while (0)
#else
#define SYNC() xcd_barrier(gbar)
#endif
#define GSETUP PP q = get_params(); unsigned char* ws = q->ws; const int G = gridDim.x, blk = opaque_blk(); (void)ws; (void)G; (void)blk
#define SL(i) (ws + WS_S0 + (size_t)(i) * SLOT)

#if PROBE
    SYNC();
#endif
    phase_init(lds);
    grid.sync();
    phase_modreduce();
    SYNC();

#pragma unroll 1
    for (int l = 0; l < 2; ++l) {
        const bool last = (l == 1);
        const int nMt = last ? 64 : 72;
        phase_convert(lds, l, 0, l == 0 ? 0x1F : 0x8);
        if (l == 0 || gridDim.x != 256) { phase_modulate(l, 0, 1024, TT, l == 0); SYNC(); }
        {
            GSETUP; SchedG S{1, (const char*)SL(0), (const char*)(ws + W_RG), (char*)SL(1), (char*)SL(2), 1024, 1024, 72, 8, G, blk};
            gemm_phase(lds, GemmK{1024, 1024, 1024}, S, EpiStore{});
        }
        SYNC();
        phase_rnn(lds, l, 1, false);
        SYNC();
        phase_rnn_carry();
        SYNC();
        phase_rnn(lds, l, 2, last);
        SYNC();
        const bool sym_tail = (!last && gridDim.x == 256);
        if (!sym_tail) phase_sym(0, gridDim.x);
        {
            GSETUP; SchedG S{9, (const char*)SL(0), (const char*)(ws + W_G + 0 * MiB), (char*)SL(3), (char*)(ws + W_M + 0 * MiB), 1024, 1024, nMt, 4, G, blk, (G == 256 && !last) ? 1 : 0};
            gemm_phase(lds, GemmK{1024, 1024, 1024}, S, EpiGateMerge{(bf16_t*)SL(1), q->in[17] + l * 3072 + 0 * 1024, (bf16_t*)SL(4), 1, (unsigned*)(ws + WS_CNT + 20480) + 0 * 32 * 16});
        }
        if (!last) {
            GSETUP; const int ns = (G >= 128) ? 64 : 0; if (blk >= ns) { SchedG S{7, (const char*)(ws + W_Z), (const char*)SL(0), nullptr, (char*)(ws + WS_ZTCTX), 1024, 1024, 0, 0, G - ns, blk - ns};
                gemm_phase(lds, GemmK{1024, 1024, 1024}, S, EpiStore{}); }
        }
        if (sym_tail) phase_sym(128, 128);
        SYNC();
        {
            GSETUP; SchedG S{6, (const char*)(ws + W_Z), (const char*)SL(2), (char*)SL(1), (char*)(ws + WS_ZTCTX), 1024, 1024, 0, 0, G, blk};
            gemm_phase(lds, GemmK{1024, 1024, 1024}, S, EpiStoreAlt{(float*)(ws + WS_ALT16)});
        }
        SYNC();
        if (gridDim.x != 256) phase_alt();
        {
            GSETUP; const int fuse = (G == 256) ? 1 : 0; SchedG S{8, (const char*)(ws + WS_T), (const char*)SL(1), (char*)SL(3), nullptr, 1024, 1024, 0, 0, G, blk};
            gemm_phase(lds, GemmK{1024, 1024, 1024}, S, EpiEO{(bf16_t*)SL(3), (bf16_t*)SL(2), (const float*)(ws + WS_ZH), (const float*)(ws + WS_ALT16), (unsigned*)(ws + WS_CNT + 28672) + (size_t)l * 128 * 16, fuse});
        }
        if (!last) { GSETUP; SchedG Sc{5, (const char*)(ws + WS_TC), (const char*)(ws + WS_ZTCTX), (char*)SL(2), nullptr, 512, 512, 0, 0, G, (blk + 128) % G};
            gemm_phase(lds, GemmK{512, 512, 512}, Sc, EpiStore{}); }
        SYNC();
        if (gridDim.x != 256) { phase_combine(); SYNC(); }
        {
            GSETUP; SchedG S{9, (const char*)SL(0), (const char*)(ws + W_G + 2 * MiB), (char*)SL(2), (char*)(ws + W_M + 2 * MiB), 1024, 1024, nMt, 4, G, blk, (G == 256 && !last) ? 1 : 0};
            gemm_phase(lds, GemmK{1024, 1024, 1024}, S, EpiGateMerge{(bf16_t*)SL(1), q->in[17] + l * 3072 + 1 * 1024, (bf16_t*)SL(4), 0, (unsigned*)(ws + WS_CNT + 20480) + 1 * 32 * 16});
        }
        SYNC();
        {
            GSETUP; SchedG S{0, (const char*)SL(0), (const char*)(ws + W_QK), nullptr, nullptr, 1024, 1024, 72, 8, G, blk};
            gemm_phase(lds, GemmK{1024, 1024, 1024}, S, EpiQK{(bf16_t*)SL(1), (bf16_t*)SL(2), (const float*)(ws + WS_COS), (const float*)(ws + WS_SIN)});
        }
        {
            GSETUP; SchedG Sv{3, (const char*)(ws + W_V), (const char*)SL(0), (char*)SL(3), nullptr, 1024, 1024, 4, 72, G, (G - 1) - blk};
            gemm_phase(lds, GemmK{1024, 1024, 1024}, Sv, EpiStore{});
        }
        SYNC();
        phase_attn(lds, l, !last);
        SYNC();
        {
            GSETUP; SchedG S{9, (const char*)SL(0), (const char*)(ws + W_G + 4 * MiB), (char*)SL(1), (char*)(ws + W_M + 4 * MiB), 1024, 1024, nMt, 4, G, blk, (G == 256 && !last) ? 1 : 0};
            gemm_phase(lds, GemmK{1024, 1024, 1024}, S, EpiGateMerge{(bf16_t*)SL(2), q->in[17] + l * 3072 + 2 * 1024, (bf16_t*)SL(4), 0, (unsigned*)(ws + WS_CNT + 20480) + 2 * 32 * 16});
        }
        SYNC();
        {
            GSETUP; const int fuse = (G == 256) ? 1 : 0; const float* modl_ = (const float*)(ws + WS_MOD) + (size_t)l * 9 * NMOD;
            SchedG S{fuse ? 10 : 0, (const char*)SL(4), (const char*)(ws + W_O), nullptr, nullptr, 1024, 1024, nMt, 4, G, blk};
            gemm_phase(lds, GemmK{1024, 1024, 1024}, S, EpiResidNorm{q->out, (float*)(ws + WS_XCTX), modl_ + 2048, l == 0 ? q->in[0] : (const float*)q->out, l == 0 ? q->in[2] : (const float*)(ws + WS_XCTX),
                fuse, (bf16_t*)SL(0), modl_, 3072, 4096, (float*)(ws + WS_XSTAT), (unsigned*)(ws + WS_CNT) + (size_t)(l * 2 + 0) * 72 * 16, nullptr});
        }
        if (!last) phase_convert(lds, 1, 32, 0x1);
        SYNC();
        if (gridDim.x != 256) { phase_modulate(l, 3072, 4096, last ? TL : TT, false); SYNC(); }
        {
            GSETUP; SchedG S{0, (const char*)SL(0), (const char*)(ws + W_13), nullptr, nullptr, 1024, 1024, nMt, 22, G, blk};
            gemm_phase(lds, GemmK{1024, 1024, 1024}, S, EpiSwiGLU{(bf16_t*)SL(1)});
        }
        if (!last) phase_convert(lds, 1, 48, 0x2);
        SYNC();
        {
            GSETUP; const int fuse = (G == 256) ? 1 : 0; const float* modl_ = (const float*)(ws + WS_MOD) + (size_t)l * 9 * NMOD; const float* modn_ = (const float*)(ws + WS_MOD) + (size_t)(last ? l : l + 1) * 9 * NMOD;
            SchedG S{fuse ? 10 : 0, (const char*)SL(1), (const char*)(ws + W_2), nullptr, nullptr, DFF, DFF, nMt, 4, G, blk};
            gemm_phase(lds, GemmK{DFF, DFF, DFF}, S, EpiResidNorm{q->out, (float*)(ws + WS_XCTX), modl_ + 5120, (const float*)q->out, (const float*)(ws + WS_XCTX),
                fuse, (bf16_t*)SL(0), modn_, 0, 1024, (float*)(ws + WS_XSTAT), (unsigned*)(ws + WS_CNT) + (size_t)(l * 2 + 1) * 72 * 16, last ? q->in[22] : nullptr});
        }
        if (!last) phase_convert(lds, 1, 32, 0x14);
        if (!last || gridDim.x != 256) SYNC();
    }
    if (gridDim.x != 256) phase_final();
#if PROBE
    grid.sync();
    if (opaque_blk() == 0 && opaque_tid() == 0) { PP q_ = get_params(); const unsigned long long* ts = (const unsigned long long*)(q_->ws + 1280 * 1024);
        float x1 = 0.f, x2 = 0.f;
        PROBE_EXPR
        ((float*)(q_->ws + 1280 * 1024))[1024] = x2; q_->out[0] += x1; }
    __syncthreads();
    if (opaque_blk() == 0) { PP q_ = get_params(); const float x2 = ((const float*)(q_->ws + 1280 * 1024))[1024] * 0.1f; for (int i = opaque_tid(); i < 65536; i += 512) q_->out[8000 * 1024 + i] += x2; }
#endif
}

extern "C" void kernel_launch(void* const* d_in, const int* in_sizes, int n_in, void* d_out, int out_size, void* d_ws, size_t ws_size, hipStream_t stream) {
    static int grid = 0;
    if (grid == 0) {
        int dev = 0, cus = 0, per_cu = 0;
        (void)hipGetDevice(&dev);
        (void)hipDeviceGetAttribute(&cus, hipDeviceAttributeMultiprocessorCount, dev);
        (void)hipFuncSetAttribute((const void*)mega_fwd, hipFuncAttributeMaxDynamicSharedMemorySize, LDS_BYTES);
        (void)hipOccupancyMaxActiveBlocksPerMultiprocessor(&per_cu, (const void*)mega_fwd, 512, LDS_BYTES);
        if (per_cu < 1) { fprintf(stderr, "kernel_launch: occupancy query says %d blocks per CU\n", per_cu); per_cu = 1; }
        if (per_cu > 1) per_cu = 1;
        grid = cus * per_cu;
        if (n_in != 23 || ws_size < 253 * MiB) fprintf(stderr, "kernel_launch: unexpected n_in %d / ws_size %zu\n", n_in, ws_size);
    }
    Params p{};
    for (int i = 0; i < 23; ++i) p.in[i] = (const float*)d_in[i];
    p.out = (float*)d_out; p.ws = (unsigned char*)d_ws;
    (void)hipMemsetAsync((unsigned char*)d_ws + WS_BAR, 0, 65536, stream);
    void* args[] = {&p};
    hipError_t e = hipLaunchCooperativeKernel((const void*)mega_fwd, dim3(grid), dim3(512), args, LDS_BYTES, stream);
    if (e != hipSuccess) fprintf(stderr, "cooperative launch failed: %s (grid %d)\n", hipGetErrorString(e), grid);
}
```

```cpp
#include <hip/hip_runtime.h>
#include <hip/hip_cooperative_groups.h>
#include <cstdio>
#include <cstdint>
namespace cg = cooperative_groups;
#define PROBE 0
#define DT(a, b) ((float)(ts[b] - ts[a]) * 1e-4f)
#define PROBE_EXPR x1 = DT(2 + 20, 2 + 21); x2 = DT(2 + 21, 2 + 22);

#define LAS __attribute__((address_space(3)))
#define DEVINL __device__ __forceinline__
typedef unsigned short bf16_t;
typedef short bf16x8 __attribute__((ext_vector_type(8)));
typedef float f32x2 __attribute__((ext_vector_type(2)));
typedef float f32x4 __attribute__((ext_vector_type(4)));
typedef float f32x16 __attribute__((ext_vector_type(16)));
typedef unsigned u32x2 __attribute__((ext_vector_type(2)));
typedef unsigned u32x4 __attribute__((ext_vector_type(4)));
typedef __bf16 bf16x2_t __attribute__((ext_vector_type(2)));

constexpr int DM = 1024, NB = 8, SEQ = 2048, CTX = 256, TL = NB * SEQ, TC = NB * CTX, TT = TL + TC;
constexpr int DFF = 2816, NMOD = 6144;
constexpr float EPS = 1e-6f;
constexpr float C2 = 0.125f * 1.4426950408889634f;

constexpr size_t MiB = 1u << 20;
constexpr size_t WS_MOD = 0;
constexpr size_t WS_COS = 512 * 1024, WS_SIN = 768 * 1024;
constexpr size_t WS_BAR = 1536 * 1024;
constexpr size_t WS_XCTX = 2 * MiB;
constexpr size_t WS_T = 10 * MiB;
constexpr size_t WS_TC = 26 * MiB;
constexpr size_t WS_W = 27 * MiB;
constexpr size_t W_RG = WS_W, W_QK = WS_W + 4 * MiB, W_V = WS_W + 8 * MiB, W_Z = WS_W + 10 * MiB, W_G = WS_W + 14 * MiB,
                 W_M = WS_W + 20 * MiB, W_O = WS_W + 26 * MiB, W_13 = WS_W + 28 * MiB, W_2 = WS_W + 39 * MiB, W_RNN = WS_W + 44 * MiB + 512 * 1024;
constexpr size_t SLOT = 36 * MiB;
constexpr size_t WS_S0 = 73 * MiB, WS_S1 = WS_S0 + SLOT, WS_S2 = WS_S1 + SLOT, WS_S3 = WS_S2 + SLOT, WS_S4 = WS_S3 + SLOT;
constexpr int LDS_BYTES = 131072 + 8192;
constexpr size_t WS_CNT = WS_BAR + 16384;
constexpr size_t WS_ALT16 = WS_T + 12 * MiB + 128 * 1024;
constexpr size_t WS_XSTAT = WS_T + 13 * MiB;

struct Params { const float* in[23]; float* out; unsigned char* ws; };

DEVINL unsigned cvtpk(float lo, float hi) { f32x2 v = {lo, hi}; bf16x2_t b = __builtin_convertvector(v, bf16x2_t); return __builtin_bit_cast(unsigned, b); }
DEVINL float bf2f(unsigned short b) { return __builtin_bit_cast(float, (unsigned)b << 16); }
DEVINL float bflo(unsigned w) { return __builtin_bit_cast(float, w << 16); }
DEVINL float bfhi(unsigned w) { return __builtin_bit_cast(float, w & 0xffff0000u); }
DEVINL void bf8_unpack(const u32x4 x, float* f) { f[0] = bflo(x.x); f[1] = bfhi(x.x); f[2] = bflo(x.y); f[3] = bfhi(x.y); f[4] = bflo(x.z); f[5] = bfhi(x.z); f[6] = bflo(x.w); f[7] = bfhi(x.w); }
DEVINL u32x4 bf8_pack(const float* f) { u32x4 w; w.x = cvtpk(f[0], f[1]); w.y = cvtpk(f[2], f[3]); w.z = cvtpk(f[4], f[5]); w.w = cvtpk(f[6], f[7]); return w; }
DEVINL float shflx(float v, int mask, int lane) { return __builtin_bit_cast(float, __builtin_amdgcn_ds_bpermute((lane ^ mask) << 2, __builtin_bit_cast(int, v))); }
DEVINL float wave_sum(float v, int lane) {
#pragma unroll
    for (int o = 1; o < 64; o <<= 1) v += shflx(v, o, lane);
    return v;
}
DEVINL float max3f_(float a, float b, float c) { float r; asm("v_max3_f32 %0, %1, %2, %3" : "=v"(r) : "v"(a), "v"(b), "v"(c)); return r; }
DEVINL float sigmoidf_(float x) { return __builtin_amdgcn_rcpf(1.f + __expf(-x)); }
DEVINL float gelu_tanh(float x) { const float u = 0.7978845608028654f * (x + 0.044715f * x * x * x); const float e = __expf(2.f * u); const float t = 1.f - 2.f * __builtin_amdgcn_rcpf(e + 1.f); return 0.5f * x * (1.f + t); }
#define LDS_WAIT() asm volatile("s_waitcnt lgkmcnt(0)" ::: "memory")
DEVINL void st16_wt(void* p, u32x4 v) { asm volatile("global_store_dwordx4 %0, %1, off sc1\n\ts_nop 1" :: "v"(p), "v"(v) : "memory"); }
#define LDS_BARRIER() asm volatile("s_waitcnt lgkmcnt(0)\n\ts_barrier" ::: "memory")
DEVINL int opaque_tid() { int t = threadIdx.x; asm volatile("" : "+v"(t)); return t; }
DEVINL int opaque_blk() { int t = blockIdx.x; asm volatile("" : "+s"(t)); return t; }
typedef const __attribute__((address_space(4))) Params* PP;
DEVINL PP get_params() { PP q = (PP)__builtin_amdgcn_kernarg_segment_ptr(); asm volatile("" : "+s"(q)); return q; }

constexpr int BM = 256, BK = 64, HALF = 128, HTB = HALF * BK * 2;
DEVINL int lds_byte(int r, int c) { const int st = (r >> 4) * 2 + (c >> 5), rr = r & 15, cc = c & 31, ob = rr * 64 + cc * 2; return st * 1024 + (ob ^ (((ob >> 9) & 1) << 5)); }
DEVINL void stage_rc(int b, int& R, int& C) { const int st = b / 1024, sb = b % 1024, swz = sb ^ (((sb >> 9) & 1) << 5); R = (st >> 1) * 16 + swz / 64; C = (st & 1) * 32 + (swz % 64) / 2; }
DEVINL int perm32(int rho) { const int n = rho >> 4, i = rho & 15; return 8 * (i >> 2) + 4 * n + (i & 3); }

struct Unit { const char* a; const char* b; char* o; int ldo, pm, pn; };
struct GemmK { int lda, ldb, K; };

DEVINL bool tile_order(int i, int G, int c, int nM, int nN, int& pm, int& pn) {
    const long L = (long)i * G + c; const int nwg = nM * nN; if (L >= nwg) return false;
    int wgid = (int)L; { const int q = nwg / 8, r = nwg % 8, xcd = wgid % 8, off = wgid / 8; wgid = (xcd < r ? xcd * (q + 1) : r * (q + 1) + (xcd - r) * q) + off; }
    const int nig = 8 * nN, gid = wgid / nig, fm = gid * 8, gsz = (nM - fm) < 8 ? (nM - fm) : 8;
    pm = fm + ((wgid % nig) % gsz); pn = (wgid % nig) / gsz; return true;
}

struct SchedG {
    int kind; const char* A; const char* B; char* O; char* O2; int lda, ldb, nM, nN, G, c, pm0;
    DEVINL bool next(int i, Unit& u) const {
        int pm, pn;
        if (kind >= 4 && kind < 9) {
            const long L = (long)i * G + c;
            if (kind == 7) {
                if (L >= 64) return false; const int Lc = (int)L; pm = Lc >> 3; const int b = Lc & 7, part = pm >> 2, j0 = (pm & 3) * 256; pn = b;
                u.a = A + (size_t)pm * 256 * 1024 * 2; u.b = B + ((size_t)TL + b * 256) * 1024 * 2; u.o = O2 + ((((size_t)b * 1024 + j0) * 2 + part) * 256) * 2; u.ldo = 512;
            } else if (kind == 6) {
                if (L < 256) { const int part = (int)L >> 7; pm = ((int)L >> 5) & 3; pn = (int)L & 31; const int b = pn >> 2, n0 = (pn & 3) * 256;
                    u.a = A + ((size_t)part * 1024 + pm * 256) * 1024 * 2; u.b = B + (size_t)part * 16 * MiB + (size_t)pn * 256 * 1024 * 2;
                    u.o = O + (size_t)part * 16 * MiB + (((size_t)b * 1024 + pm * 256) * 1024 + n0) * 2; u.ldo = 1024; pn += 32 * part; }
                else if (L < 256 + nN) { const int Lc = (int)L - 256; pm = Lc >> 3; const int b = Lc & 7, part = pm >> 2, j0 = (pm & 3) * 256; pn = b;
                    u.a = A + (size_t)pm * 256 * 1024 * 2; u.b = B - 2 * SLOT + ((size_t)TL + b * 256) * 1024 * 2;
                    u.o = O2 + ((((size_t)b * 1024 + j0) * 2 + part) * 256) * 2; u.ldo = 512; }
                else return false;
            } else if (kind == 8) {
                if (L >= 256) return false; const int part = (int)L >> 7, b = ((int)L >> 4) & 7; pm = ((int)L >> 2) & 3; pn = (int)L & 3;
                u.a = A + (size_t)part * 2 * MiB + (size_t)pm * 256 * 1024 * 2; u.b = B + (size_t)part * 16 * MiB + ((size_t)b * 1024 + pn * 256) * 1024 * 2;
                u.o = O + (size_t)part * 16 * MiB + (((size_t)b * 1024 + pm * 256) * 1024 + pn * 256) * 2; u.ldo = 1024; pn |= (b << 2) | (part << 5); }
            else { if (L >= 32) return false; const int b = (int)L >> 2; pm = 0; pn = (int)L & 3;
                u.a = A; u.b = B + ((size_t)b * 1024 + pn * 256) * 512 * 2; u.o = O + (((size_t)TL + b * 256) * 1024 + pn * 256) * 2; u.ldo = 1024; }
            u.pm = pm; u.pn = pn; return true;
        }
        if (kind == 13 || kind == 14) {
            if (!tile_order(i, G, c, 64, 8, pm, pn)) { const long L = (long)i * G + c - 512; if (L < 0 || L >= 32) return false; pm = 64 + (int)(L >> 2); pn = (int)(L & 3) + (kind == 14 ? 4 : 0); }
            u.pm = pm; u.pn = pn; u.a = A + (size_t)pm * 256 * lda * 2; u.b = B + (size_t)pn * 256 * ldb * 2; u.o = O; u.ldo = 1024;
            if (kind == 13) u.o = (pn < 4 ? O : O2) + ((size_t)pm * 256 * 1024 + (pn & 3) * 256) * 2;
            return true;
        }
        if (kind == 10) {
            if (i == 0) { pm = (c & 7) * 8 + (c >> 5); pn = (c >> 3) & 3; }
            else if (i == 1 && nM == 72 && c < 32) { pm = 64 + (c & 7); pn = c >> 3; }
            else return false;
            u.pm = pm; u.pn = pn; u.a = A + (size_t)pm * 256 * lda * 2; u.b = B + (size_t)pn * 256 * ldb * 2; u.o = O; u.ldo = 1024; return true;
        }
        if (kind == 9) {
            int sub;
            if (pm0) {
                if (i < 2) { if (!tile_order(0, G, c, 64, nN, pm, pn)) return false; sub = i; }
                else if (i == 2 && c < 64) { const int p = c & 31; pm = 64 + (p >> 2); pn = p & 3; sub = (c < 32) ? 2 : 3; }
                else return false;
            } else { if (!tile_order(i >> 1, G, c, nM, nN, pm, pn)) return false; sub = i & 1; }
            u.pm = pm; u.pn = pn; u.ldo = sub; u.o = nullptr;
            u.a = ((sub & 1) ? (const char*)O : A) + (size_t)pm * 256 * lda * 2; u.b = ((sub & 1) ? (const char*)O2 : B) + (size_t)pn * 256 * ldb * 2; return true;
        }
        if (!tile_order(i, G, c, nM, nN, pm, pn)) return false;
        pm += pm0; u.pm = pm; u.pn = pn; u.a = A + (size_t)pm * 256 * lda * 2; u.b = B + (size_t)pn * 256 * ldb * 2; u.o = O; u.ldo = 1024;
        if (kind == 1) { u.o = (pn < 4 ? O : O2) + ((size_t)pm * 256 * 1024 + (pn & 3) * 256) * 2; }
        else if (kind == 2) {
            const int part = pm >> 2, j0 = (pm & 3) * 256;
            if (pn < 64) { const int b = pn >> 3, n0 = (pn & 7) * 256; u.o = O + ((((size_t)b * 1024 + j0) * 2 + part) * 2048 + n0) * 2; u.ldo = 4096; }
            else { const int b = pn - 64; u.o = O2 + ((((size_t)b * 1024 + j0) * 2 + part) * 256) * 2; u.ldo = 512; }
        } else if (kind == 3) {
            int b, key0; if (pn < 64) { b = pn >> 3; key0 = (pn & 7) * 256; } else { b = pn - 64; key0 = 2048; }
            u.o = O + (((size_t)b * 1024 + pm * 256) * 2304 + key0) * 2; u.ldo = 2304;
        }
        return true;
    }
};

typedef f32x4 AccT[2][2][4][2];
struct EpiStore {
    static constexpr bool FUSED = false;
    DEVINL void operator()(const AccT& acc, const Unit& u, int wr, int wc, int fr, int fq) const {
#pragma unroll
        for (int ai = 0; ai < 2; ++ai)
#pragma unroll
            for (int m = 0; m < 4; ++m) { bf16_t* rowp = (bf16_t*)u.o + (size_t)(ai * 128 + wr * 64 + m * 16 + fr) * u.ldo + wc * 32 + 8 * fq;
#pragma unroll
                for (int bj = 0; bj < 2; ++bj) { const f32x4 v0 = acc[ai][bj][m][0], v1 = acc[ai][bj][m][1]; u32x4 w;
                    w.x = cvtpk(v0[0], v0[1]); w.y = cvtpk(v0[2], v0[3]); w.z = cvtpk(v1[0], v1[1]); w.w = cvtpk(v1[2], v1[3]); *(u32x4*)(rowp + bj * 128) = w; } }
    }
};
struct EpiQK {
    static constexpr bool FUSED = false;
    bf16_t* Q; bf16_t* K; const float* cosT; const float* sinT;
    DEVINL void operator()(const AccT& acc, const Unit& u, int wr, int wc, int fr, int fq) const {
        const bool isq = u.pn < 4; bf16_t* base = isq ? Q : K; const float sc = isq ? C2 : 1.f;
        const int hp = (u.pn & 3) * 2 + (wc >> 1), c = wc & 1, jj0 = 8 * fq;
#pragma unroll
        for (int ai = 0; ai < 2; ++ai)
#pragma unroll
            for (int m = 0; m < 4; ++m) { const int t = u.pm * 256 + ai * 128 + wr * 64 + m * 16 + fr; const bool lat = t < TL; const int pos = t & 2047;
                bf16_t* dst = base + (size_t)t * 1024 + hp * 128 + c * 64 + jj0; f32x4 o1[2], o2[2];
#pragma unroll
                for (int n = 0; n < 2; ++n) { f32x4 cs = {1.f, 1.f, 1.f, 1.f}, sn = {0.f, 0.f, 0.f, 0.f};
                    if (lat) { cs = *(const f32x4*)(cosT + pos * 32 + jj0 + 4 * n); sn = *(const f32x4*)(sinT + pos * 32 + jj0 + 4 * n); }
                    const f32x4 t1 = acc[ai][0][m][n], t2 = acc[ai][1][m][n]; o1[n] = (t1 * cs - t2 * sn) * sc; o2[n] = (t1 * sn + t2 * cs) * sc; }
                u32x4 w; w.x = cvtpk(o1[0][0], o1[0][1]); w.y = cvtpk(o1[0][2], o1[0][3]); w.z = cvtpk(o1[1][0], o1[1][1]); w.w = cvtpk(o1[1][2], o1[1][3]); *(u32x4*)dst = w;
                w.x = cvtpk(o2[0][0], o2[0][1]); w.y = cvtpk(o2[0][2], o2[0][3]); w.z = cvtpk(o2[1][0], o2[1][1]); w.w = cvtpk(o2[1][2], o2[1][3]); *(u32x4*)(dst + 32) = w; }
    }
};
struct EpiGate {
    static constexpr bool FUSED = false;
    bf16_t* Gd; const float* bias; int wt;
    DEVINL void operator()(const AccT& acc, const Unit& u, int wr, int wc, int fr, int fq) const {
        const int col0 = u.pn * 256 + wc * 32 + 8 * fq;
#pragma unroll
        for (int bj = 0; bj < 2; ++bj) { const f32x4 b0 = *(const f32x4*)(bias + col0 + bj * 128), b1 = *(const f32x4*)(bias + col0 + bj * 128 + 4);
#pragma unroll
            for (int ai = 0; ai < 2; ++ai)
#pragma unroll
                for (int m = 0; m < 4; ++m) { const int t = u.pm * 256 + ai * 128 + wr * 64 + m * 16 + fr; const f32x4 v0 = acc[ai][bj][m][0] + b0, v1 = acc[ai][bj][m][1] + b1; u32x4 w;
                    w.x = cvtpk(sigmoidf_(v0[0]), sigmoidf_(v0[1])); w.y = cvtpk(sigmoidf_(v0[2]), sigmoidf_(v0[3])); w.z = cvtpk(sigmoidf_(v1[0]), sigmoidf_(v1[1])); w.w = cvtpk(sigmoidf_(v1[2]), sigmoidf_(v1[3]));
                    if (wt) st16_wt(Gd + (size_t)t * 1024 + col0 + bj * 128, w); else *(u32x4*)(Gd + (size_t)t * 1024 + col0 + bj * 128) = w; } }
    }
};
struct EpiMerge {
    static constexpr bool FUSED = false;
    const bf16_t* Gs; bf16_t* Md; int first;
    DEVINL void operator()(const AccT& acc, const Unit& u, int wr, int wc, int fr, int fq) const {
        const int col0 = u.pn * 256 + wc * 32 + 8 * fq;
#pragma unroll
        for (int ai = 0; ai < 2; ++ai)
#pragma unroll
            for (int m = 0; m < 4; ++m) { const int t = u.pm * 256 + ai * 128 + wr * 64 + m * 16 + fr;
#pragma unroll
                for (int bj = 0; bj < 2; ++bj) { const size_t off = (size_t)t * 1024 + col0 + bj * 128; const u32x4 g = *(const u32x4*)(Gs + off); const f32x4 v0 = acc[ai][bj][m][0], v1 = acc[ai][bj][m][1];
                    float r0 = bflo(g.x) * v0[0], r1 = bfhi(g.x) * v0[1], r2 = bflo(g.y) * v0[2], r3 = bfhi(g.y) * v0[3], r4 = bflo(g.z) * v1[0], r5 = bfhi(g.z) * v1[1], r6 = bflo(g.w) * v1[2], r7 = bfhi(g.w) * v1[3];
                    if (!first) { const u32x4 o = *(const u32x4*)(Md + off); r0 += bflo(o.x); r1 += bfhi(o.x); r2 += bflo(o.y); r3 += bfhi(o.y); r4 += bflo(o.z); r5 += bfhi(o.z); r6 += bflo(o.w); r7 += bfhi(o.w); }
                    u32x4 w; w.x = cvtpk(r0, r1); w.y = cvtpk(r2, r3); w.z = cvtpk(r4, r5); w.w = cvtpk(r6, r7); *(u32x4*)(Md + off) = w; } }
    }
};
struct EpiGateMerge {
    static constexpr bool FUSED = true;
    bf16_t* Gd; const float* bias; bf16_t* Md; int first; unsigned* cnt;
    DEVINL void operator()(AccT& acc, const Unit& u, int wr, int wc, int fr, int fq, LAS unsigned char* lds, int wid, int lane) const {
        (void)lds;
        const int role = u.ldo; unsigned* cw = cnt + 16 * ((u.pm - 64) * 4 + u.pn);
        if (role == 0) { EpiGate g{Gd, bias, 0}; g(acc, u, wr, wc, fr, fq); }
        else if (role == 2) { EpiGate g{Gd, bias, 1}; g(acc, u, wr, wc, fr, fq);
            asm volatile("s_waitcnt vmcnt(0)" ::: "memory");
            if (lane == 0) __hip_atomic_fetch_add(cw, 1u, __ATOMIC_RELAXED, __HIP_MEMORY_SCOPE_AGENT); }
        else {
            if (role == 3) {
                if (wid == 0) { unsigned spins = 0;
                    while ((unsigned)__builtin_amdgcn_readfirstlane((int)__hip_atomic_load(cw, __ATOMIC_RELAXED, __HIP_MEMORY_SCOPE_AGENT)) < 8u) { __builtin_amdgcn_s_sleep(2); if (++spins > (1u << 22)) break; }
                    __builtin_amdgcn_fence(__ATOMIC_ACQUIRE, "agent"); }
                asm volatile("s_waitcnt vmcnt(0) lgkmcnt(0)\n\ts_barrier" ::: "memory");
            }
            EpiMerge m{Gd, Md, first}; m(acc, u, wr, wc, fr, fq); }
    }
};
struct EpiResid {
    static constexpr bool FUSED = false;
    float* Xlat; float* Xctx; const float* gmod; const float* Rlat; const float* Rctx;
    DEVINL void operator()(const AccT& acc, const Unit& u, int wr, int wc, int fr, int fq) const {
        const int col0 = u.pn * 256 + wc * 32 + 8 * fq; const int mr = u.pm < 64 ? (u.pm >> 3) : 8;
        float* xb = u.pm < 64 ? Xlat + (size_t)u.pm * 256 * 1024 : Xctx + (size_t)(u.pm - 64) * 256 * 1024;
        const float* rb = u.pm < 64 ? Rlat + (size_t)u.pm * 256 * 1024 : Rctx + (size_t)(u.pm - 64) * 256 * 1024;
#pragma unroll
        for (int bj = 0; bj < 2; ++bj) { const f32x4 g0 = *(const f32x4*)(gmod + mr * NMOD + col0 + bj * 128), g1 = *(const f32x4*)(gmod + mr * NMOD + col0 + bj * 128 + 4);
#pragma unroll
            for (int ai = 0; ai < 2; ++ai)
#pragma unroll
                for (int m = 0; m < 4; ++m) { const size_t xo = (size_t)(ai * 128 + wr * 64 + m * 16 + fr) * 1024 + col0 + bj * 128; float* xp = xb + xo;
                    f32x4 x0 = *(const f32x4*)(rb + xo), x1 = *(const f32x4*)(rb + xo + 4); x0 += g0 * acc[ai][bj][m][0]; x1 += g1 * acc[ai][bj][m][1]; *(f32x4*)xp = x0; *(f32x4*)(xp + 4) = x1; } }
    }
};
struct EpiResidNorm {
    static constexpr bool FUSED = true;
    float* Xlat; float* Xctx; const float* gmod; const float* Rlat; const float* Rctx;
    int fuse; bf16_t* H; const float* nmod; int shoff, scoff; float* xstat; unsigned* cnt; const float* fg;
    DEVINL void operator()(AccT& acc, const Unit& u, int wr, int wc, int fr, int fq, LAS unsigned char* lds, int wid, int lane) const {
        const int col0 = u.pn * 256 + wc * 32 + 8 * fq; const int mr = u.pm < 64 ? (u.pm >> 3) : 8;
        float* xb = u.pm < 64 ? Xlat + (size_t)u.pm * 256 * 1024 : Xctx + (size_t)(u.pm - 64) * 256 * 1024;
        const float* rb = u.pm < 64 ? Rlat + (size_t)u.pm * 256 * 1024 : Rctx + (size_t)(u.pm - 64) * 256 * 1024;
#pragma unroll
        for (int bj = 0; bj < 2; ++bj) { const f32x4 g0 = *(const f32x4*)(gmod + mr * NMOD + col0 + bj * 128), g1 = *(const f32x4*)(gmod + mr * NMOD + col0 + bj * 128 + 4);
#pragma unroll
            for (int ai = 0; ai < 2; ++ai)
#pragma unroll
                for (int m = 0; m < 4; ++m) { const size_t xo = (size_t)(ai * 128 + wr * 64 + m * 16 + fr) * 1024 + col0 + bj * 128; float* xp = xb + xo;
                    f32x4 x0 = *(const f32x4*)(rb + xo), x1 = *(const f32x4*)(rb + xo + 4); x0 += g0 * acc[ai][bj][m][0]; x1 += g1 * acc[ai][bj][m][1];
                    acc[ai][bj][m][0] = x0; acc[ai][bj][m][1] = x1; if (!(fuse && fg)) { *(f32x4*)xp = x0; *(f32x4*)(xp + 4) = x1; } } }
        if (!fuse) return;
        LAS float* P = (LAS float*)(lds + 131072 + 1024);
        LAS float* S = (LAS float*)(lds + 131072 + 5120);
#pragma unroll
        for (int ai = 0; ai < 2; ++ai)
#pragma unroll
            for (int m = 0; m < 4; ++m) { float sq = 0.f;
#pragma unroll
                for (int bj = 0; bj < 2; ++bj)
#pragma unroll
                    for (int n = 0; n < 2; ++n) { const f32x4 x = acc[ai][bj][m][n]; sq += (x[0] * x[0] + x[1] * x[1]) + (x[2] * x[2] + x[3] * x[3]); }
                sq += shflx(sq, 16, lane); sq += shflx(sq, 32, lane);
                if (fq == 0) P[(ai * 128 + wr * 64 + m * 16 + fr) * 4 + wc] = sq; }
        LDS_BARRIER();
        const int row = wid * 32 + (lane & 31);
        if (lane < 32) { const float t = (P[row * 4 + 0] + P[row * 4 + 1]) + (P[row * 4 + 2] + P[row * 4 + 3]);
            __hip_atomic_store((unsigned*)xstat + ((size_t)(u.pm * 256 + row) * 4 + u.pn), __builtin_bit_cast(unsigned, t), __ATOMIC_RELAXED, __HIP_MEMORY_SCOPE_AGENT); }
        asm volatile("s_waitcnt vmcnt(0)" ::: "memory");
        if (lane == 0) __hip_atomic_fetch_add(cnt + 16 * u.pm, 1u, __ATOMIC_RELAXED, __HIP_MEMORY_SCOPE_AGENT);
        if (wid == 0) { unsigned spins = 0;
            while ((unsigned)__builtin_amdgcn_readfirstlane((int)__hip_atomic_load(cnt + 16 * u.pm, __ATOMIC_RELAXED, __HIP_MEMORY_SCOPE_AGENT)) < 32u) { __builtin_amdgcn_s_sleep(2); if (++spins > (1u << 22)) break; }
            __builtin_amdgcn_fence(__ATOMIC_ACQUIRE, "agent"); }
        asm volatile("s_waitcnt vmcnt(0) lgkmcnt(0)\n\ts_barrier" ::: "memory");
        if (lane < 32) { const unsigned* sl = (const unsigned*)xstat + (size_t)(u.pm * 256 + row) * 4; float tot = 0.f;
#pragma unroll
            for (int t = 0; t < 4; ++t) tot += __builtin_bit_cast(float, __hip_atomic_load(sl + t, __ATOMIC_RELAXED, __HIP_MEMORY_SCOPE_AGENT));
            S[row] = rsqrtf(tot * (1.f / 1024.f) + EPS); }
        LDS_BARRIER();
        if (fg) {
#pragma unroll
            for (int bj = 0; bj < 2; ++bj) { const f32x4 g0 = *(const f32x4*)(fg + col0 + bj * 128), g1 = *(const f32x4*)(fg + col0 + bj * 128 + 4);
#pragma unroll
                for (int ai = 0; ai < 2; ++ai)
#pragma unroll
                    for (int m = 0; m < 4; ++m) { const int r = ai * 128 + wr * 64 + m * 16 + fr; const float rinv = S[r]; float* xp = xb + (size_t)r * 1024 + col0 + bj * 128;
                        *(f32x4*)xp = acc[ai][bj][m][0] * rinv * g0; *(f32x4*)(xp + 4) = acc[ai][bj][m][1] * rinv * g1; } }
            return;
        }
#pragma unroll
        for (int bj = 0; bj < 2; ++bj) { const float* mp = nmod + mr * NMOD + col0 + bj * 128;
            const f32x4 sc0 = *(const f32x4*)(mp + scoff) + 1.f, sc1 = *(const f32x4*)(mp + scoff + 4) + 1.f, sh0 = *(const f32x4*)(mp + shoff), sh1 = *(const f32x4*)(mp + shoff + 4);
#pragma unroll
            for (int ai = 0; ai < 2; ++ai)
#pragma unroll
                for (int m = 0; m < 4; ++m) { const int r = ai * 128 + wr * 64 + m * 16 + fr; const float rinv = S[r];
                    const f32x4 y0 = acc[ai][bj][m][0] * rinv * sc0 + sh0, y1 = acc[ai][bj][m][1] * rinv * sc1 + sh1; u32x4 w;
                    w.x = cvtpk(y0[0], y0[1]); w.y = cvtpk(y0[2], y0[3]); w.z = cvtpk(y1[0], y1[1]); w.w = cvtpk(y1[2], y1[3]);
                    *(u32x4*)(H + (size_t)(u.pm * 256 + r) * 1024 + col0 + bj * 128) = w; } }
    }
};
struct EpiStoreAlt {
    static constexpr bool FUSED = false;
    float* alt16;
    DEVINL void operator()(const AccT& acc, const Unit& u, int wr, int wc, int fr, int fq) const {
        EpiStore st; st(acc, u, wr, wc, fr, fq);
        if (u.pn < 32) { const int b = u.pn >> 2, q4 = u.pn & 3, lane = fq * 16 + fr;
#pragma unroll
            for (int ai = 0; ai < 2; ++ai)
#pragma unroll
                for (int m = 0; m < 4; ++m) { float sa = 0.f;
#pragma unroll
                    for (int bj = 0; bj < 2; ++bj)
#pragma unroll
                        for (int n = 0; n < 2; ++n) { const f32x4 x = acc[ai][bj][m][n]; sa += (x[0] - x[1]) + (x[2] - x[3]); }
                    sa += shflx(sa, 16, lane); sa += shflx(sa, 32, lane);
                    if (fq == 0) alt16[((size_t)(b * 1024 + u.pm * 256 + ai * 128 + wr * 64 + m * 16 + fr)) * 16 + q4 * 4 + wc] = sa; } }
    }
};
struct EpiEO {
    static constexpr bool FUSED = true;
    bf16_t* EO; bf16_t* Yb; const float* zh; const float* alt16; unsigned* cnt; int fuse;
    DEVINL void operator()(AccT& acc, const Unit& u, int wr, int wc, int fr, int fq, LAS unsigned char* lds, int wid, int lane) const {
        (void)lds;
        const int pn = u.pn & 3, b = (u.pn >> 2) & 7, part = u.pn >> 5; const int col0 = pn * 256 + wc * 32 + 8 * fq;
        const size_t tbase = ((size_t)b * 1024 + u.pm * 256) * 1024 + col0;
        bf16_t* mine = EO + (size_t)part * 8 * MiB + tbase; const bf16_t* other = EO + (size_t)(part ^ 1) * 8 * MiB + tbase;
#pragma unroll
        for (int ai = 0; ai < 2; ++ai)
#pragma unroll
            for (int m = 0; m < 4; ++m) { const int row = ai * 128 + wr * 64 + m * 16 + fr;
#pragma unroll
                for (int bj = 0; bj < 2; ++bj) { const f32x4 v0 = acc[ai][bj][m][0], v1 = acc[ai][bj][m][1]; u32x4 w;
                    w.x = cvtpk(v0[0], v0[1]); w.y = cvtpk(v0[2], v0[3]); w.z = cvtpk(v1[0], v1[1]); w.w = cvtpk(v1[2], v1[3]);
                    if (fuse) st16_wt(mine + (size_t)row * 1024 + bj * 128, w); else *(u32x4*)(mine + (size_t)row * 1024 + bj * 128) = w; } }
        if (!fuse) return;
        unsigned* cw = cnt + 16 * ((b * 4 + u.pm) * 4 + pn);
        asm volatile("s_waitcnt vmcnt(0)" ::: "memory");
        if (lane == 0) __hip_atomic_fetch_add(cw, 1u, __ATOMIC_RELAXED, __HIP_MEMORY_SCOPE_AGENT);
        if (wid == 0) { unsigned spins = 0;
            while ((unsigned)__builtin_amdgcn_readfirstlane((int)__hip_atomic_load(cw, __ATOMIC_RELAXED, __HIP_MEMORY_SCOPE_AGENT)) < 16u) { __builtin_amdgcn_s_sleep(2); if (++spins > (1u << 22)) break; }
            __builtin_amdgcn_fence(__ATOMIC_ACQUIRE, "agent"); }
        asm volatile("s_waitcnt vmcnt(0) lgkmcnt(0)\n\ts_barrier" ::: "memory");
        constexpr float SC = 0.022097086912079608f;
#pragma unroll
        for (int bj = 0; bj < 2; ++bj) { const float* zp = zh + b * 1024 + col0 + bj * 128; const f32x4 z0 = *(const f32x4*)zp, z1 = *(const f32x4*)(zp + 4);
            const float zv[8] = {z0.x, z0.y, z0.z, z0.w, z1.x, z1.y, z1.z, z1.w};
#pragma unroll
            for (int ai = 0; ai < 2; ++ai)
#pragma unroll
                for (int m = 0; m < 4; ++m) { const int row = ai * 128 + wr * 64 + m * 16 + fr, k = u.pm * 256 + row; const float sg = (k & 1) ? -SC : SC;
                    float ov[8], y[8]; bf8_unpack(*(const u32x4*)(other + (size_t)row * 1024 + bj * 128), ov);
                    const f32x4 a0 = acc[ai][bj][m][0], a1 = acc[ai][bj][m][1]; const float av[8] = {a0[0], a0[1], a0[2], a0[3], a1[0], a1[1], a1[2], a1[3]};
                    int dest;
                    if (part == 0) { dest = k;
#pragma unroll
                        for (int e = 0; e < 8; ++e) y[e] = (av[e] + sg * zv[e]) - ov[e]; }
                    else if (k != 0) { dest = 2048 - k;
#pragma unroll
                        for (int e = 0; e < 8; ++e) y[e] = (ov[e] + sg * zv[e]) + av[e]; }
                    else { dest = 1024;
#pragma unroll
                        for (int e = 0; e < 8; ++e) { const float* ap = alt16 + ((size_t)(b * 1024 + col0 + bj * 128 + e)) * 16; float al = 0.f;
#pragma unroll
                            for (int t = 0; t < 16; ++t) al += ap[t];
                            y[e] = SC * (zv[e] + al); } }
                    *(u32x4*)(Yb + ((size_t)b * 2048 + dest) * 1024 + col0 + bj * 128) = bf8_pack(y); } }
    }
};
struct EpiSwiGLU {
    static constexpr bool FUSED = false;
    bf16_t* Ud;
    DEVINL void operator()(const AccT& acc, const Unit& u, int wr, int wc, int fr, int fq) const {
        const int col0 = u.pn * 128 + wc * 32 + 8 * fq;
#pragma unroll
        for (int ai = 0; ai < 2; ++ai)
#pragma unroll
            for (int m = 0; m < 4; ++m) { const int t = u.pm * 256 + ai * 128 + wr * 64 + m * 16 + fr; float r[8];
#pragma unroll
                for (int n = 0; n < 2; ++n)
#pragma unroll
                    for (int j = 0; j < 4; ++j) { const float a = acc[ai][0][m][n][j], b = acc[ai][1][m][n][j]; r[n * 4 + j] = a * sigmoidf_(a) * b; }
                u32x4 w; w.x = cvtpk(r[0], r[1]); w.y = cvtpk(r[2], r[3]); w.z = cvtpk(r[4], r[5]); w.w = cvtpk(r[6], r[7]); *(u32x4*)(Ud + (size_t)t * DFF + col0) = w; }
    }
};

template <class Epi, class Sched>
DEVINL void gemm_phase(LAS unsigned char* lds, const GemmK g, const Sched& S, const Epi& E) {
    const int tid = opaque_tid(), wid = __builtin_amdgcn_readfirstlane(tid >> 6), lane = tid & 63, wr = wid >> 2, wc = wid & 3, fr = lane & 15, fq = lane >> 4;
    const int nt = g.K / BK;
    unsigned voffA[2], voffB[2];
#pragma unroll
    for (int i = 0; i < 2; ++i) { int R, C; stage_rc(tid * 16 + i * 8192, R, C); const int Rb = (R & ~31) + perm32(R & 31);
        voffA[i] = (unsigned)(R * g.lda + C) * 2u; voffB[i] = (unsigned)(Rb * g.ldb + C) * 2u; }
    const size_t kstep = (size_t)(BK * 2);
    const size_t hstepA = (size_t)HALF * g.lda * 2, hstepB = (size_t)HALF * g.ldb * 2;
    const unsigned ldsw = (unsigned)wid * 1024u;
    const int aoff = lds_byte(wr * 64 + fr, fq * 8), boff = lds_byte(wc * 32 + fr, fq * 8);
#define PG8_SA(b, h) (((b) * 2 + (h)) * HTB)
#define PG8_SB(b, h) ((4 + (b) * 2 + (h)) * HTB)
#define PG8_STAGE(bufoff, gbase, voff) do { _Pragma("unroll") for (int _i = 0; _i < 2; ++_i) \
        __builtin_amdgcn_global_load_lds((const unsigned*)((const char*)(gbase) + (voff)[_i]), (LAS unsigned*)(lds + (bufoff) + ldsw + _i * 8192), 16, 0, 0); } while (0)
#define PG8_LDA(dst, b, h) do { _Pragma("unroll") for (int m = 0; m < 4; ++m) _Pragma("unroll") for (int k = 0; k < 2; ++k) dst[m][k] = *(const LAS bf16x8*)(lds + PG8_SA(b, h) + aoff + m * 2048 + k * 1024); } while (0)
#define PG8_LDB(dst, b, h) do { _Pragma("unroll") for (int n = 0; n < 2; ++n) _Pragma("unroll") for (int k = 0; k < 2; ++k) dst[n][k] = *(const LAS bf16x8*)(lds + PG8_SB(b, h) + boff + n * 2048 + k * 1024); } while (0)
#define PG8_MMA(ai, bj, At, Bt) do { __builtin_amdgcn_s_setprio(1); _Pragma("unroll") for (int m = 0; m < 4; ++m) _Pragma("unroll") for (int n = 0; n < 2; ++n) _Pragma("unroll") for (int k = 0; k < 2; ++k) \
        acc[ai][bj][m][n] = __builtin_amdgcn_mfma_f32_16x16x32_bf16(Bt[n][k], At[m][k], acc[ai][bj][m][n], 0, 0, 0); __builtin_amdgcn_s_setprio(0); } while (0)
#define PG8_WAIT_V(n) asm volatile("s_waitcnt vmcnt(" #n ")" ::: "memory")
#define PG8_WAIT_L(n) asm volatile("s_waitcnt lgkmcnt(" #n ")" ::: "memory")
#define PG8_BAR __builtin_amdgcn_s_barrier()
#define PG8_SCHED __builtin_amdgcn_sched_barrier(0)
    Unit cur, nxt; int ui = 0;
    if (!S.next(0, cur)) return;
    f32x4 acc[2][2][4][2];
#pragma unroll
    for (int a = 0; a < 2; ++a)
#pragma unroll
        for (int b = 0; b < 2; ++b)
#pragma unroll
            for (int m = 0; m < 4; ++m)
#pragma unroll
                for (int n = 0; n < 2; ++n) acc[a][b][m][n] = (f32x4){0.f, 0.f, 0.f, 0.f};
    bf16x8 At[4][2], B0[2][2], B1[2][2];
    const char* cA = cur.a; const char* cB = cur.b;
    PG8_STAGE(PG8_SB(0, 0), cB, voffB); PG8_STAGE(PG8_SB(0, 1), cB + hstepB, voffB); PG8_STAGE(PG8_SA(0, 0), cA, voffA); PG8_STAGE(PG8_SA(0, 1), cA + hstepA, voffA);
    if (wr == 1) PG8_BAR;
    PG8_WAIT_V(2); PG8_BAR;
    PG8_STAGE(PG8_SB(1, 0), cB + kstep, voffB); PG8_STAGE(PG8_SA(1, 0), cA + kstep, voffA); PG8_STAGE(PG8_SB(1, 1), cB + hstepB + kstep, voffB);
    PG8_WAIT_V(6); PG8_BAR;
    for (;;) {
        const bool has_next = S.next(ui + 1, nxt);
        const char* nA = has_next ? nxt.a : cA; const char* nB = has_next ? nxt.b : cB;
        for (int t = 0; t < nt; t += 2) {
            const bool last = (t == nt - 2);
            const char* a1 = cA + (size_t)(t + 1) * kstep;
            const char* a2 = last ? nA : cA + (size_t)(t + 2) * kstep; const char* b2 = last ? nB : cB + (size_t)(t + 2) * kstep;
            const char* a3 = a2 + kstep; const char* b3 = b2 + kstep;
            PG8_LDB(B0, 0, 0); PG8_LDB(B1, 0, 1); PG8_SCHED; PG8_LDA(At, 0, 0); PG8_STAGE(PG8_SA(1, 1), a1 + hstepA, voffA);
            PG8_WAIT_V(8); PG8_WAIT_L(0); PG8_BAR; PG8_MMA(0, 0, At, B0); PG8_MMA(0, 1, At, B1); PG8_BAR; PG8_SCHED;
            PG8_LDA(At, 0, 1); PG8_STAGE(PG8_SB(0, 0), b2, voffB); PG8_STAGE(PG8_SB(0, 1), b2 + hstepB, voffB); PG8_STAGE(PG8_SA(0, 0), a2, voffA);
            PG8_WAIT_V(8); PG8_WAIT_L(0); PG8_BAR; PG8_MMA(1, 0, At, B0); PG8_MMA(1, 1, At, B1); PG8_BAR; PG8_SCHED;
            PG8_LDB(B0, 1, 0); PG8_LDB(B1, 1, 1); PG8_SCHED; PG8_LDA(At, 1, 0); PG8_STAGE(PG8_SA(0, 1), a2 + hstepA, voffA);
            PG8_WAIT_V(8); PG8_WAIT_L(0); PG8_BAR; PG8_MMA(0, 0, At, B0); PG8_MMA(0, 1, At, B1); PG8_BAR; PG8_SCHED;
            PG8_LDA(At, 1, 1); PG8_STAGE(PG8_SB(1, 0), b3, voffB); PG8_STAGE(PG8_SB(1, 1), b3 + hstepB, voffB); PG8_STAGE(PG8_SA(1, 0), a3, voffA);
            PG8_WAIT_V(8); PG8_WAIT_L(0); PG8_BAR; PG8_MMA(1, 0, At, B0); PG8_MMA(1, 1, At, B1); PG8_BAR; PG8_SCHED;
        }
        if (wr == 0) PG8_BAR;
        { int fr2 = fr, fq2 = fq; asm volatile("" : "+v"(fr2), "+v"(fq2));
          if constexpr (Epi::FUSED) E(acc, cur, wr, wc, fr2, fq2, lds, wid, lane); else E(acc, cur, wr, wc, fr2, fq2); }
        if (!has_next) break;
#pragma unroll
        for (int a = 0; a < 2; ++a)
#pragma unroll
            for (int b = 0; b < 2; ++b)
#pragma unroll
                for (int m = 0; m < 4; ++m)
#pragma unroll
                    for (int n = 0; n < 2; ++n) acc[a][b][m][n] = (f32x4){0.f, 0.f, 0.f, 0.f};
        cur = nxt; cA = nA; cB = nB; ++ui;
        if (wr == 1) PG8_BAR;
    }
    PG8_WAIT_V(0);
    PG8_BAR;
#undef PG8_SA
#undef PG8_SB
#undef PG8_STAGE
#undef PG8_LDA
#undef PG8_LDB
#undef PG8_MMA
#undef PG8_WAIT_V
#undef PG8_WAIT_L
#undef PG8_BAR
#undef PG8_SCHED
}

DEVINL void transpose_item(const float* W, int ldw, bf16_t* WT, int ldt, LAS float* scr, int lane) {
    float tv[32];
    unsigned voff = (unsigned)(lane >> 5) * (unsigned)ldw + (unsigned)(lane & 31); asm volatile("" : "+v"(voff));
#pragma unroll
    for (int i = 0; i < 32; ++i) tv[i] = (W + (size_t)(2 * i) * ldw)[voff];
#pragma unroll
    for (int i = 0; i < 32; ++i) { const int kk = 2 * i + (lane >> 5); scr[kk * 33 + (lane & 31)] = tv[i]; }
    LDS_WAIT();
    const int c = lane & 7;
#pragma unroll
    for (int j = 0; j < 4; ++j) { const int n = (lane >> 3) + 8 * j; const LAS float* s = scr + (8 * c) * 33 + n;
        u32x4 o; o.x = cvtpk(s[0 * 33], s[1 * 33]); o.y = cvtpk(s[2 * 33], s[3 * 33]); o.z = cvtpk(s[4 * 33], s[5 * 33]); o.w = cvtpk(s[6 * 33], s[7 * 33]);
        *(u32x4*)(WT + (size_t)n * ldt + 8 * c) = o; }
    LDS_WAIT();
}

DEVINL void phase_convert(LAS unsigned char* lds, int l, int nskip, int mask) {
    PP q = get_params();
    const int tid = opaque_tid(), lane = tid & 63, wave = __builtin_amdgcn_readfirstlane(tid >> 6), G = gridDim.x, blk = blockIdx.x;
    unsigned char* ws = q->ws;
    const float* w_in = q->in[6] + (size_t)l * 1024 * 6144;
    LAS float* scr = (LAS float*)(lds + wave * 8448);
    if (nskip >= G) nskip = 0;
    if (blk < nskip) return;
    const int gw = (blk - nskip) * 8 + wave, NGW = (G - nskip) * 8;
    constexpr int N_RG = 1024, N_QK = 1024, N_V = 512, N_G = 1536, N_M = 1536, N_O = 512, N_1 = 1408, N_3 = 1408, N_2 = 1408, N_R = 256;
    constexpr int NIT = N_RG + N_QK + N_V + N_G + N_M + N_O + N_1 + N_3 + N_2 + N_R;
    for (int it = gw; it < NIT; it += NGW) {
        int r = it;
        { const int grp = it < 5632 ? 1 : it < 6144 ? 2 : it < 8960 ? 4 : it < 10368 ? 8 : 1; if (!(mask & grp)) continue; }
        if (r < N_RG) { const int kb = r >> 6, nb = r & 63; transpose_item(w_in + (size_t)kb * 64 * 6144 + nb * 32, 6144, (bf16_t*)(ws + W_RG) + (size_t)nb * 32 * 1024 + kb * 64, 1024, scr, lane); continue; } r -= N_RG;
        if (r < N_QK) { const int kb = r >> 6, nb = r & 63; const int isk = nb >> 5, cc = (nb & 31) * 32, hh = cc >> 7, c = (cc >> 6) & 1, half = (cc >> 5) & 1;
            const int drow = (isk * 4 + (hh >> 1)) * 256 + half * 128 + (hh & 1) * 64 + c * 32;
            transpose_item(w_in + (size_t)kb * 64 * 6144 + 3072 + nb * 32, 6144, (bf16_t*)(ws + W_QK) + (size_t)drow * 1024 + kb * 64, 1024, scr, lane); continue; } r -= N_QK;
        if (r < N_V) { const int kb = r >> 5, nb = r & 31; transpose_item(w_in + (size_t)kb * 64 * 6144 + 5120 + nb * 32, 6144, (bf16_t*)(ws + W_V) + (size_t)nb * 32 * 1024 + kb * 64, 1024, scr, lane); continue; } r -= N_V;
        if (r < N_G) { const int kb = r / 96, nb = r % 96; transpose_item(q->in[16] + (size_t)l * 1024 * 3072 + (size_t)kb * 64 * 3072 + nb * 32, 3072, (bf16_t*)(ws + W_G) + (size_t)nb * 32 * 1024 + kb * 64, 1024, scr, lane); continue; } r -= N_G;
        if (r < N_M) { const int i = r / 512, rr = r % 512, kb = rr >> 5, nb = rr & 31;
            transpose_item(q->in[15] + (size_t)l * 3072 * 1024 + ((size_t)i * 1024 + kb * 64) * 1024 + nb * 32, 1024, (bf16_t*)(ws + W_M) + ((size_t)i * 1024 + nb * 32) * 1024 + kb * 64, 1024, scr, lane); continue; } r -= N_M;
        if (r < N_O) { const int kb = r >> 5, nb = r & 31; transpose_item(q->in[18] + (size_t)l * 1024 * 1024 + (size_t)kb * 64 * 1024 + nb * 32, 1024, (bf16_t*)(ws + W_O) + (size_t)nb * 32 * 1024 + kb * 64, 1024, scr, lane); continue; } r -= N_O;
        if (r < N_1 + N_3) { const int w3 = r >= N_1; if (w3) r -= N_1; const int kb = r / 88, nb = r % 88; const float* src = (w3 ? q->in[20] : q->in[19]) + (size_t)l * 1024 * DFF + (size_t)kb * 64 * DFF + nb * 32;
            const int drow = (nb >> 2) * 256 + w3 * 128 + (nb & 3) * 32;
            transpose_item(src, DFF, (bf16_t*)(ws + W_13) + (size_t)drow * 1024 + kb * 64, 1024, scr, lane); continue; } r -= N_1 + N_3;
        if (r < N_2) { const int kb = r >> 5, nb = r & 31; transpose_item(q->in[21] + (size_t)l * DFF * 1024 + (size_t)kb * 64 * 1024 + nb * 32, 1024, (bf16_t*)(ws + W_2) + (size_t)nb * 32 * DFF + kb * 64, DFF, scr, lane); continue; } r -= N_2;
        {
            const int mat = r >> 3, sub = r & 7, kb = sub >> 2, nb = sub & 3; const int dir = mat >> 4, ri = (mat >> 3) & 1, g = mat & 7;
            const float* src = (ri ? q->in[11] : q->in[9]) + ((size_t)((l * 2 + dir) * 8 + g)) * 16384 + (size_t)kb * 64 * 128 + nb * 32;
            transpose_item(src, 128, (bf16_t*)(ws + W_RNN) + ((size_t)((dir * 2 + ri) * 8 + g)) * 16384 + (size_t)nb * 32 * 128 + kb * 64, 128, scr, lane);
        }
    }
    __syncthreads();
    LAS float* wt = (LAS float*)lds; LAS f32x2* ct = (LAS f32x2*)(wt + 128 * 33);
    for (int it = (mask & 16) ? blk - nskip : 256; it < 256; it += G - nskip) {
        const int g = it >> 5, k0 = (it & 31) * 32;
        __syncthreads();
#pragma unroll
        for (int i = 0; i < 8; ++i) { const int e = tid + 512 * i, kk = e >> 7, c = e & 127; wt[c * 33 + kk] = w_in[(size_t)(k0 + kk) * 6144 + 2048 + g * 128 + c]; }
        if (tid < 128) ct[tid] = (f32x2){cospif((float)tid * (1.f / 64.f)), sinpif((float)tid * (1.f / 64.f))};
        __syncthreads();
        const int kl = tid & 31, mg = tid >> 5;
        float ac[8], as[8];
#pragma unroll
        for (int i = 0; i < 8; ++i) { ac[i] = 0.f; as[i] = 0.f; }
#pragma unroll 4
        for (int c = 0; c < 128; ++c) { const float w = wt[c * 33 + kl];
#pragma unroll
            for (int mi = 0; mi < 8; ++mi) { const f32x2 cs = ct[((mg * 8 + mi) * c) & 127]; ac[mi] += w * cs.x; as[mi] += w * cs.y; } }
        bf16_t* wz = (bf16_t*)(ws + W_Z);
#pragma unroll
        for (int mi = 0; mi < 8; ++mi) { const int m = mg * 8 + mi; const unsigned pc = cvtpk(ac[mi] * 0.08838834764831845f, as[mi] * 0.08838834764831845f);
            wz[(size_t)(g * 128 + m) * 1024 + k0 + kl] = (bf16_t)(pc & 0xffffu); wz[(size_t)(1024 + g * 128 + m) * 1024 + k0 + kl] = (bf16_t)(pc >> 16); }
    }
    __syncthreads();
}

DEVINL void phase_init(LAS unsigned char* lds) {
    PP q = get_params();
    const int tid = opaque_tid(), G = gridDim.x, blk = blockIdx.x;
    const size_t gtid = (size_t)blk * 512 + tid, gsz = (size_t)G * 512;
    unsigned char* ws = q->ws;
    { float* cT = (float*)(ws + WS_COS); float* sT = (float*)(ws + WS_SIN);
      for (size_t i = gtid; i < 65536; i += gsz) { const int pos = (int)i >> 5, jj = (int)i & 31, f = jj & 15; const float inv = powf(10000.f, -(float)f * (1.f / 16.f));
          const float crd = (jj < 16) ? (float)(pos >> 6) : (float)(pos & 63); const float ang = crd * inv; cT[i] = cosf(ang); sT[i] = sinf(ang); } }
    { bf16_t* T = (bf16_t*)(ws + WS_T);
      for (size_t i = gtid; i < (size_t)2 * 1024 * 1024 / 2; i += gsz) { const int part = (int)(i >> 19), k = (int)(i >> 9) & 1023, col = ((int)i & 511) * 2; float v[2];
#pragma unroll
          for (int e = 0; e < 2; ++e) { const int n = col + e, m = (k * n) & 2047; const float x = (float)m * (1.f / 1024.f); v[e] = (part ? sinpif(x) : cospif(x)) * 0.022097086912079608f; }
          ((unsigned*)T)[i] = cvtpk(v[0], v[1]); } }
    { bf16_t* T = (bf16_t*)(ws + WS_TC);
      for (size_t i = gtid; i < (size_t)256 * 512 / 2; i += gsz) { const int k = (int)(i >> 8), col = ((int)i & 255) * 2; float v[2];
#pragma unroll
          for (int e = 0; e < 2; ++e) { const int cc = col + e, n = cc & 255, m = (k * n) & 255; const float x = (float)m * (1.f / 128.f); v[e] = (cc < 256 ? cospif(x) : -sinpif(x)) * 0.0625f; }
          ((unsigned*)T)[i] = cvtpk(v[0], v[1]); } }
    LAS float* sc = (LAS float*)lds; float* part = (float*)(ws + WS_S0);
    for (int item = blk; item < 384; item += G) {
        const int l = item / 192, rem = item % 192, kc = rem / 24, nb = rem % 24;
        __syncthreads();
        for (int e = tid; e < 9 * 128; e += 512) { const int r = e >> 7, kk = e & 127; const float c = (r < 8) ? q->in[1][r * 1024 + kc * 128 + kk] : q->in[3][kc * 128 + kk]; sc[e] = c / (1.f + __expf(-c)); }
        __syncthreads();
        const int n = nb * 256 + (tid & 255), kh = tid >> 8; const float* w = q->in[4] + ((size_t)l * 1024 + kc * 128 + kh * 64) * NMOD + n;
        float acc[9];
#pragma unroll
        for (int r = 0; r < 9; ++r) acc[r] = 0.f;
#pragma unroll 4
        for (int kk = 0; kk < 64; ++kk) { const float wv = w[(size_t)kk * NMOD];
#pragma unroll
            for (int r = 0; r < 9; ++r) acc[r] += sc[r * 128 + kh * 64 + kk] * wv; }
#pragma unroll
        for (int r = 0; r < 9; ++r) part[((size_t)((kc * 2 + kh) * 2 + l) * 9 + r) * NMOD + n] = acc[r];
    }
}

DEVINL void phase_modreduce() {
    PP q = get_params();
    const size_t gtid = (size_t)blockIdx.x * 512 + opaque_tid(), gsz = (size_t)gridDim.x * 512;
    const float* part = (const float*)(q->ws + WS_S0); float* mod = (float*)(q->ws + WS_MOD);
    for (size_t i = gtid; i < 2 * 9 * NMOD; i += gsz) { const int l = (int)(i / (9 * NMOD)), n = (int)(i % NMOD); float s = q->in[5][l * NMOD + n];
#pragma unroll
        for (int j = 0; j < 16; ++j) s += part[(size_t)j * 2 * 9 * NMOD + i];
        mod[i] = s; }
}

DEVINL void phase_modulate(int l, int shoff, int scoff, int ntok, bool from_input) {
    PP q = get_params(); const float* modl = (const float*)(q->ws + WS_MOD) + (size_t)l * 9 * NMOD; bf16_t* H = (bf16_t*)(q->ws + WS_S0);
    const int tid = opaque_tid(), lane = tid & 63, wave = tid >> 6; const int gw = blockIdx.x * 8 + wave, NGW = gridDim.x * 8;
    const float* Xlat = from_input ? q->in[0] : q->out; const float* Xctx = from_input ? q->in[2] : (const float*)(q->ws + WS_XCTX);
    for (int tb = gw; tb < ntok; tb += 3 * NGW) {
        f32x4 v[3][4]; float ss[3];
#pragma unroll
        for (int u = 0; u < 3; ++u) { const int t = tb + u * NGW; ss[u] = 0.f;
            if (t < ntok) { const float* xr = t < TL ? Xlat + (size_t)t * 1024 : Xctx + (size_t)(t - TL) * 1024;
#pragma unroll
                for (int j = 0; j < 4; ++j) v[u][j] = ((const f32x4*)xr)[lane + 64 * j]; } }
#pragma unroll
        for (int u = 0; u < 3; ++u) { const int t = tb + u * NGW;
            if (t < ntok) {
#pragma unroll
                for (int j = 0; j < 4; ++j) ss[u] += v[u][j].x * v[u][j].x + v[u][j].y * v[u][j].y + v[u][j].z * v[u][j].z + v[u][j].w * v[u][j].w;
                const float rinv = rsqrtf(wave_sum(ss[u], lane) * (1.f / 1024.f) + EPS); const int r = t < TL ? (t >> 11) : 8;
                u32x2* o = (u32x2*)(H + (size_t)t * 1024);
#pragma unroll
                for (int j = 0; j < 4; ++j) { const int col = (lane + 64 * j) * 4; const f32x4 sc = *(const f32x4*)(modl + r * NMOD + scoff + col), sh = *(const f32x4*)(modl + r * NMOD + shoff + col);
                    const f32x4 y = v[u][j] * rinv * (sc + 1.f) + sh; u32x2 w; w.x = cvtpk(y.x, y.y); w.y = cvtpk(y.z, y.w); o[lane + 64 * j] = w; } } }
    }
}

DEVINL void phase_final() {
    PP q = get_params();
    const int tid = opaque_tid(), lane = tid & 63, wave = tid >> 6; const int gw = blockIdx.x * 8 + wave, NGW = gridDim.x * 8;
    f32x4 g[4];
#pragma unroll
    for (int j = 0; j < 4; ++j) g[j] = ((const f32x4*)q->in[22])[lane + 64 * j];
    for (int tb = gw; tb < TL; tb += 4 * NGW) {
        f32x4 v[4][4]; float ss[4];
#pragma unroll
        for (int u = 0; u < 4; ++u) { const int t = tb + u * NGW; ss[u] = 0.f;
            if (t < TL) {
#pragma unroll
                for (int j = 0; j < 4; ++j) v[u][j] = ((const f32x4*)(q->out + (size_t)t * 1024))[lane + 64 * j]; } }
#pragma unroll
        for (int u = 0; u < 4; ++u) { const int t = tb + u * NGW;
            if (t < TL) {
#pragma unroll
                for (int j = 0; j < 4; ++j) ss[u] += v[u][j].x * v[u][j].x + v[u][j].y * v[u][j].y + v[u][j].z * v[u][j].z + v[u][j].w * v[u][j].w;
                const float rinv = rsqrtf(wave_sum(ss[u], lane) * (1.f / 1024.f) + EPS);
#pragma unroll
                for (int j = 0; j < 4; ++j) ((f32x4*)(q->out + (size_t)t * 1024))[lane + 64 * j] = v[u][j] * rinv * g[j]; } }
    }
}

constexpr size_t WS_ZTCTX = WS_T + 4 * MiB, WS_ZH = WS_T + 12 * MiB, WS_ALT = WS_ZH + 64 * 1024;
DEVINL void phase_sym() {
    PP q = get_params(); const bf16_t* H = (const bf16_t*)(q->ws + WS_S0); bf16_t* HP = (bf16_t*)(q->ws + WS_S2); bf16_t* HM = (bf16_t*)(q->ws + WS_S2 + 16 * MiB);
    const bf16_t* WZ = (const bf16_t*)(q->ws + W_Z); float* zh = (float*)(q->ws + WS_ZH);
    const int tid = opaque_tid(), lane = tid & 63, wave = tid >> 6; const int gw = blockIdx.x * 8 + wave, NGW = gridDim.x * 8;
    for (int rb = gw; rb < 8192; rb += 2 * NGW) {
        u32x4 xa[2][2], xb[2][2];
#pragma unroll
        for (int u = 0; u < 2; ++u) { const int r = rb + u * NGW; if (r < 8192) { const int b = r >> 10, n = r & 1023;
            const u32x4* h1 = (const u32x4*)(H + ((size_t)b * 2048 + n) * 1024); const u32x4* h2 = (const u32x4*)(H + ((size_t)b * 2048 + ((2048 - n) & 2047)) * 1024);
            xa[u][0] = h1[lane]; xa[u][1] = h1[lane + 64]; xb[u][0] = h2[lane]; xb[u][1] = h2[lane + 64]; } }
#pragma unroll
        for (int u = 0; u < 2; ++u) { const int r = rb + u * NGW; if (r < 8192) { const int n = r & 1023;
#pragma unroll
            for (int jj = 0; jj < 2; ++jj) { float x[8], y[8], pp[8], mm[8]; bf8_unpack(xa[u][jj], x); bf8_unpack(xb[u][jj], y);
#pragma unroll
                for (int e = 0; e < 8; ++e) { pp[e] = n ? x[e] + y[e] : x[e]; mm[e] = n ? x[e] - y[e] : 0.f; }
                ((u32x4*)(HP + (size_t)r * 1024))[lane + 64 * jj] = bf8_pack(pp); ((u32x4*)(HM + (size_t)r * 1024))[lane + 64 * jj] = bf8_pack(mm); } } }
    }
    for (int rb = gw; rb < 8192; rb += 2 * NGW) {
        u32x4 wv[2][2], hv[2][2];
#pragma unroll
        for (int u = 0; u < 2; ++u) { const int r = rb + u * NGW; if (r < 8192) { const int b = r >> 10, j = r & 1023; const u32x4* w = (const u32x4*)(WZ + (size_t)j * 1024); const u32x4* h = (const u32x4*)(H + ((size_t)b * 2048 + 1024) * 1024);
            wv[u][0] = w[lane]; wv[u][1] = w[lane + 64]; hv[u][0] = h[lane]; hv[u][1] = h[lane + 64]; } }
#pragma unroll
        for (int u = 0; u < 2; ++u) { const int r = rb + u * NGW; if (r < 8192) { float a = 0.f;
#pragma unroll
            for (int jj = 0; jj < 2; ++jj) { float x[8], y[8]; bf8_unpack(wv[u][jj], x); bf8_unpack(hv[u][jj], y);
#pragma unroll
                for (int e = 0; e < 8; ++e) a += x[e] * y[e]; }
            a = wave_sum(a, lane); if (lane == 0) zh[r] = a; } }
    }
}
DEVINL void phase_alt() {
    PP q = get_params(); const bf16_t* ZTc = (const bf16_t*)(q->ws + WS_S1); float* alt = (float*)(q->ws + WS_ALT);
    const int tid = opaque_tid(), lane = tid & 63, wave = tid >> 6; const int gw = blockIdx.x * 8 + wave, NGW = gridDim.x * 8;
    for (int r = gw; r < 8192; r += NGW) { const u32x4* z = (const u32x4*)(ZTc + (size_t)r * 1024); float a = 0.f;
#pragma unroll
        for (int jj = 0; jj < 2; ++jj) { float x[8]; bf8_unpack(z[lane + 64 * jj], x); a += (x[0] - x[1]) + (x[2] - x[3]) + (x[4] - x[5]) + (x[6] - x[7]); }
        a = wave_sum(a, lane); if (lane == 0) alt[r] = a; }
}
DEVINL void phase_combine() {
    PP q = get_params(); const bf16_t* E = (const bf16_t*)(q->ws + WS_S3); const bf16_t* Od = (const bf16_t*)(q->ws + WS_S3 + 16 * MiB); bf16_t* Yb = (bf16_t*)(q->ws + WS_S2);
    const float* zh = (const float*)(q->ws + WS_ZH); const float* alt = (const float*)(q->ws + WS_ALT);
    const int tid = opaque_tid(), lane = tid & 63, wave = tid >> 6; const int gw = blockIdx.x * 8 + wave, NGW = gridDim.x * 8;
    constexpr float SC = 0.022097086912079608f;
    for (int r = gw; r < 8 * 1025; r += NGW) { const int b = r / 1025, kk = r % 1025;
#pragma unroll
        for (int jj = 0; jj < 2; ++jj) { const int j0 = (lane + 64 * jj) * 8; float z[8];
            { const f32x4 z0 = *(const f32x4*)(zh + b * 1024 + j0), z1 = *(const f32x4*)(zh + b * 1024 + j0 + 4); z[0] = z0.x; z[1] = z0.y; z[2] = z0.z; z[3] = z0.w; z[4] = z1.x; z[5] = z1.y; z[6] = z1.z; z[7] = z1.w; }
            if (kk == 1024) { float y[8]; const f32x4 a0 = *(const f32x4*)(alt + b * 1024 + j0), a1 = *(const f32x4*)(alt + b * 1024 + j0 + 4); const float av[8] = {a0.x, a0.y, a0.z, a0.w, a1.x, a1.y, a1.z, a1.w};
#pragma unroll
                for (int e = 0; e < 8; ++e) y[e] = SC * (z[e] + av[e]);
                *(u32x4*)(Yb + ((size_t)b * 2048 + 1024) * 1024 + j0) = bf8_pack(y); }
            else { float ev[8], ov[8], y1[8], y2[8]; bf8_unpack(*(const u32x4*)(E + ((size_t)b * 1024 + kk) * 1024 + j0), ev); bf8_unpack(*(const u32x4*)(Od + ((size_t)b * 1024 + kk) * 1024 + j0), ov);
                const float sg = (kk & 1) ? -SC : SC;
#pragma unroll
                for (int e = 0; e < 8; ++e) { const float base = ev[e] + sg * z[e]; y1[e] = base - ov[e]; y2[e] = base + ov[e]; }
                *(u32x4*)(Yb + ((size_t)b * 2048 + kk) * 1024 + j0) = bf8_pack(y1);
                if (kk) *(u32x4*)(Yb + ((size_t)b * 2048 + 2048 - kk) * 1024 + j0) = bf8_pack(y2); } }
    }
}

constexpr int NCHUNK = 576;
DEVINL void rnn_decode(int ck, int& t0, int& s0, int& s1) {
    if (ck < 512) { const int b = ck >> 6, cc = ck & 63; s0 = b * 2048; s1 = s0 + 2048; t0 = s0 + cc * 32; }
    else { const int b = (ck - 512) >> 3, cc = (ck - 512) & 7; s0 = TL + b * 256; s1 = s0 + 256; t0 = s0 + cc * 32; }
}
DEVINL void phase_rnn(LAS unsigned char* lds, int l, int pass, bool skip_ctx) {
    PP q = get_params();
    const bf16_t* XR = (const bf16_t*)(q->ws + WS_S1); const bf16_t* GR = (const bf16_t*)(q->ws + WS_S2); bf16_t* Ya = (bf16_t*)(q->ws + WS_S3); f32x2* totals = (f32x2*)(q->ws + WS_S3); const float* carry = (const float*)(q->ws + WS_S4);
    const int tid = opaque_tid(), lane = tid & 63, wave = __builtin_amdgcn_readfirstlane(tid >> 6), cl = lane & 15, fq = lane >> 4;
    const int G = gridDim.x, blk = blockIdx.x;
    LAS unsigned char* Us = lds;
    LAS f32x2* coef = (LAS f32x2*)(lds + 16384);
    const bf16_t* wrn = (const bf16_t*)(q->ws + W_RNN);
    const int per = (8 * NCHUNK + G - 1) / G;
    const int it0 = blk * per, it1 = (it0 + per) < 8 * NCHUNK ? (it0 + per) : 8 * NCHUNK;
    const int ctok = tid >> 4, ch8 = (tid & 15) * 8;
    const int mch = wave * 16 + cl;
    int gcur = -1; bf16x8 bfr[4][4]; f32x4 cw[4][2], cbv[2]; float brv[2], biv[2], lslv[2];
    u32x4 xr[4];
#define RNN_NEXT(it_) do { ++(it_); } while ((it_) < it1 && skip_ctx && ((it_) % NCHUNK) >= 512)
#define RNN_LOADX(it_) do { const int g_ = (it_) / NCHUNK, ck_ = (it_) % NCHUNK; int t0_, s0_, s1_; rnn_decode(ck_, t0_, s0_, s1_); \
        _Pragma("unroll") for (int k = 0; k < 4; ++k) { const int t_ = t0_ + ctok + k - 2; xr[k] = (u32x4){0u, 0u, 0u, 0u}; if (t_ >= s0_ && t_ < s1_) xr[k] = *(const u32x4*)(XR + (size_t)t_ * 1024 + g_ * 128 + ch8); } } while (0)
    int it = it0 - 1; RNN_NEXT(it);
    if (it < it1) RNN_LOADX(it);
    while (it < it1) {
        const int g = it / NCHUNK, ck = it % NCHUNK;
        int t0, s0, s1; rnn_decode(ck, t0, s0, s1);
        if (g != gcur) { gcur = g;
#pragma unroll
            for (int ty = 0; ty < 4; ++ty)
#pragma unroll
                for (int ks = 0; ks < 4; ++ks) bfr[ty][ks] = *(const bf16x8*)(wrn + ((size_t)(ty * 8 + g)) * 16384 + (size_t)mch * 128 + ks * 32 + fq * 8);
            const int gc = g * 128 + ch8; const float* cb = q->in[8] + l * 1024 + gc; cbv[0] = *(const f32x4*)cb; cbv[1] = *(const f32x4*)(cb + 4);
#pragma unroll
            for (int k = 0; k < 4; ++k) { const float* cwp = q->in[7] + (size_t)(l * 4 + k) * 1024 + gc; cw[k][0] = *(const f32x4*)cwp; cw[k][1] = *(const f32x4*)(cwp + 4); }
#pragma unroll
            for (int dir = 0; dir < 2; ++dir) { const int pi = (l * 2 + dir) * 1024 + g * 128 + mch; brv[dir] = q->in[10][pi]; biv[dir] = q->in[12][pi]; lslv[dir] = -8.f * log1pf(__expf(-q->in[13][pi])); } }
        { float u[8] = {cbv[0].x, cbv[0].y, cbv[0].z, cbv[0].w, cbv[1].x, cbv[1].y, cbv[1].z, cbv[1].w};
#pragma unroll
          for (int k = 0; k < 4; ++k) { const u32x4 x = xr[k]; const f32x4 w0 = cw[k][0], w1 = cw[k][1];
              u[0] += w0.x * bflo(x.x); u[1] += w0.y * bfhi(x.x); u[2] += w0.z * bflo(x.y); u[3] += w0.w * bfhi(x.y); u[4] += w1.x * bflo(x.z); u[5] += w1.y * bfhi(x.z); u[6] += w1.z * bflo(x.w); u[7] += w1.w * bfhi(x.w); }
          u32x4 w; w.x = cvtpk(u[0], u[1]); w.y = cvtpk(u[2], u[3]); w.z = cvtpk(u[4], u[5]); w.w = cvtpk(u[6], u[7]); *(LAS u32x4*)(Us + ctok * 272 + ch8 * 2) = w; }
        int itn = it; RNN_NEXT(itn);
        if (itn < it1) RNN_LOADX(itn);
        u32x4 grv = {0u, 0u, 0u, 0u};
        const size_t yoff = (size_t)(t0 + ctok) * 1024 + g * 128 + ch8;
        if (pass == 2) grv = *(const u32x4*)(GR + yoff);
        float hcar = 0.f;
        if (pass == 2 && tid < 256) hcar = carry[((size_t)(tid >> 7) * NCHUNK + ck) * 1024 + g * 128 + (tid & 127)];
        LDS_BARRIER();
        f32x4 acc[4][2];
#pragma unroll
        for (int ty = 0; ty < 4; ++ty) { acc[ty][0] = (f32x4){0.f, 0.f, 0.f, 0.f}; acc[ty][1] = (f32x4){0.f, 0.f, 0.f, 0.f}; }
#pragma unroll
        for (int ks = 0; ks < 4; ++ks) {
            const bf16x8 a0 = *(const LAS bf16x8*)(Us + cl * 272 + (ks * 32 + fq * 8) * 2), a1 = *(const LAS bf16x8*)(Us + (16 + cl) * 272 + (ks * 32 + fq * 8) * 2);
#pragma unroll
            for (int ty = 0; ty < 4; ++ty) { acc[ty][0] = __builtin_amdgcn_mfma_f32_16x16x32_bf16(a0, bfr[ty][ks], acc[ty][0], 0, 0, 0); acc[ty][1] = __builtin_amdgcn_mfma_f32_16x16x32_bf16(a1, bfr[ty][ks], acc[ty][1], 0, 0, 0); } }
        { const f32x2 br2 = {brv[0], brv[1]}, bi2 = {biv[0], biv[1]}, lsl2 = {lslv[0] * 1.4426950408889634f, lslv[1] * 1.4426950408889634f};
#pragma unroll
          for (int mt = 0; mt < 2; ++mt)
#pragma unroll
            for (int r = 0; r < 4; ++r) { const int tok = mt * 16 + fq * 4 + r; const float u = bf2f(*(const LAS bf16_t*)(Us + tok * 272 + mch * 2));
                const f32x2 tr = ((f32x2){acc[0][mt][r], acc[2][mt][r]} + br2) * -1.4426950408889634f, ti = ((f32x2){acc[1][mt][r], acc[3][mt][r]} + bi2) * -1.4426950408889634f;
                const f32x2 dr = (f32x2){__builtin_amdgcn_exp2f(tr.x), __builtin_amdgcn_exp2f(tr.y)} + 1.f, di = (f32x2){__builtin_amdgcn_exp2f(ti.x), __builtin_amdgcn_exp2f(ti.y)} + 1.f;
                const f32x2 rr = {__builtin_amdgcn_rcpf(dr.x), __builtin_amdgcn_rcpf(dr.y)}, ii = {__builtin_amdgcn_rcpf(di.x), __builtin_amdgcn_rcpf(di.y)};
                const f32x2 la2 = lsl2 * rr, a2 = la2 * 2.f;
                const f32x2 om = __builtin_elementwise_max((f32x2){1.f, 1.f} - (f32x2){__builtin_amdgcn_exp2f(a2.x), __builtin_amdgcn_exp2f(a2.y)}, (f32x2){0.f, 0.f});
                const f32x2 bb = (f32x2){__builtin_amdgcn_sqrtf(om.x), __builtin_amdgcn_sqrtf(om.y)} * ii * u;
                coef[(0 * 32 + tok) * 128 + mch] = (f32x2){la2.x, bb.x}; coef[(1 * 32 + tok) * 128 + mch] = (f32x2){la2.y, bb.y}; } }
        LDS_BARRIER();
        if (tid < 256) { const int dir = wave >> 1, ch = tid & 127; LAS f32x2* cp = coef + dir * 32 * 128 + ch; float h = hcar, P2 = 0.f;
            f32x2 cf[16];
            if (dir == 0) {
#pragma unroll
                for (int hf = 0; hf < 2; ++hf) {
#pragma unroll
                    for (int s = 0; s < 16; ++s) cf[s] = cp[(hf * 16 + s) * 128];
#pragma unroll
                    for (int s = 0; s < 16; ++s) { h = __builtin_amdgcn_exp2f(cf[s].x) * h + cf[s].y; P2 += cf[s].x; if (pass == 2) cp[(hf * 16 + s) * 128].y = h; } }
            } else {
#pragma unroll
                for (int hf = 0; hf < 2; ++hf) {
#pragma unroll
                    for (int s = 0; s < 16; ++s) cf[s] = cp[(31 - hf * 16 - s) * 128];
#pragma unroll
                    for (int s = 0; s < 16; ++s) { h = __builtin_amdgcn_exp2f(cf[s].x) * h + cf[s].y; P2 += cf[s].x; if (pass == 2) cp[(31 - hf * 16 - s) * 128].y = h; } }
            }
            if (pass == 1) totals[((size_t)dir * NCHUNK + ck) * 1024 + g * 128 + ch] = (f32x2){P2, h}; }
        if (pass == 2) {
            LDS_BARRIER();
            float y[8]; const float gv[8] = {bflo(grv.x), bfhi(grv.x), bflo(grv.y), bfhi(grv.y), bflo(grv.z), bfhi(grv.z), bflo(grv.w), bfhi(grv.w)};
#pragma unroll
            for (int e = 0; e < 8; ++e) { const float hs = coef[(0 * 32 + ctok) * 128 + ch8 + e].y + coef[(1 * 32 + ctok) * 128 + ch8 + e].y; y[e] = hs * gelu_tanh(gv[e]); }
            u32x4 w; w.x = cvtpk(y[0], y[1]); w.y = cvtpk(y[2], y[3]); w.z = cvtpk(y[4], y[5]); w.w = cvtpk(y[6], y[7]); *(u32x4*)(Ya + yoff) = w;
        }
        LDS_BARRIER();
        it = itn;
    }
#undef RNN_NEXT
#undef RNN_LOADX
}

DEVINL void phase_rnn_carry() {
    PP q = get_params(); const f32x2* totals = (const f32x2*)(q->ws + WS_S3); float* carry = (float*)(q->ws + WS_S4);
    const int gtid = blockIdx.x * 512 + opaque_tid();
    if (gtid >= NB * 2 * 1024) return;
    const int b = gtid >> 11, dir = (gtid >> 10) & 1, gc = gtid & 1023;
    float st = 0.f;
#pragma unroll 1
    for (int s8 = 0; s8 < 72; s8 += 8) { size_t idx[8]; f32x2 t[8];
#pragma unroll
        for (int j = 0; j < 8; ++j) { const int s = s8 + j; int ck; if (s < 8) { const int cc = dir ? 7 - s : s; ck = 512 + b * 8 + cc; } else { const int cc = dir ? 63 - (s - 8) : (s - 8); ck = b * 64 + cc; }
            idx[j] = ((size_t)dir * NCHUNK + ck) * 1024 + gc; t[j] = totals[idx[j]]; }
#pragma unroll
        for (int j = 0; j < 8; ++j) { carry[idx[j]] = st; st = __builtin_amdgcn_exp2f(t[j].x) * st + t[j].y; } }
}

DEVINL void phase_attn(LAS unsigned char* lds, int l, bool do_ctx) {
    PP q = get_params(); bf16_t* Q = (bf16_t*)(q->ws + WS_S1); const bf16_t* K = (const bf16_t*)(q->ws + WS_S2); const bf16_t* VT = (const bf16_t*)(q->ws + WS_S3);
    const int tid = opaque_tid(), lane = tid & 63, wave = __builtin_amdgcn_readfirstlane(tid >> 6), r32 = lane & 31, hi = lane >> 5;
    const int G = gridDim.x, blk = blockIdx.x;
    const float* lv = q->in[14] + l * 256;
    const float s1 = wave_sum(lv[lane] * lv[64 + lane], lane), s2 = wave_sum(lv[128 + lane] * lv[192 + lane], lane);
    const float lam_init = 0.8f - 0.6f * expf(-0.3f * (float)l); const float lam = expf(s1) - expf(s2) + lam_init;
    const int nit = 1024 + (do_ctx ? 128 : 0);
    const int c = wave >> 2, qs = wave & 3;
    const int kperm = (r32 & ~12) | ((r32 & 4) << 1) | ((r32 & 8) >> 1);
    constexpr int STG = 35840, VOFF = 17408;
    const int vb = (G & 7) ? blk : (blk & 7) * (G >> 3) + (blk >> 3);
    for (int item = vb; item < nit; item += G) {
        int b, h, q0, kt0;
        if (item < 1024) { b = item >> 7; h = (item >> 4) & 7; q0 = b * 2048 + (item & 15) * 128; kt0 = 0; }
        else { const int j = item - 1024; b = j >> 4; h = (j >> 1) & 7; q0 = TL + b * 256 + (j & 1) * 128; kt0 = 32; }
        const int tq = q0 + qs * 32 + r32;
        bf16x8 qf[4];
#pragma unroll
        for (int ks = 0; ks < 4; ++ks) qf[ks] = *(const bf16x8*)(Q + (size_t)tq * 1024 + h * 128 + c * 64 + ks * 16 + hi * 8);
        f32x16 O[4];
#pragma unroll
        for (int n = 0; n < 4; ++n)
#pragma unroll
            for (int i = 0; i < 16; ++i) O[n][i] = 0.f;
        float mrun = 0.f, lsum = 0.f;
        const int kkey = tid >> 3, kpart = tid & 7, vvd = tid >> 2, vpart = tid & 3;
        u32x4 kr0, kr1, vr0, vr1;
#define ATT_LOAD(kt) do { const int tk_ = ((kt) < 32 ? b * 2048 + (kt) * 64 : TL + b * 256 + ((kt) - 32) * 64) + kkey; const bf16_t* ks_ = K + (size_t)tk_ * 1024 + h * 128 + kpart * 16; \
            kr0 = *(const u32x4*)ks_; kr1 = *(const u32x4*)(ks_ + 8); const bf16_t* vs_ = VT + ((size_t)(b * 1024 + h * 128 + vvd)) * 2304 + (kt) * 64 + vpart * 16; vr0 = *(const u32x4*)vs_; vr1 = *(const u32x4*)(vs_ + 8); } while (0)
        constexpr int KST = 17408, VBASE = 2 * 17408, VST = 18432;
#define ATT_STORE(ks_, vs_) do { LAS unsigned char* kb_ = lds + (ks_) * KST + kkey * 272 + kpart * 32; *(LAS u32x4*)kb_ = kr0; *(LAS u32x4*)(kb_ + 16) = kr1; \
            LAS unsigned char* vb_ = lds + VBASE + (vs_) * VST + vvd * 144 + vpart * 32; *(LAS u32x4*)vb_ = vr0; *(LAS u32x4*)(vb_ + 16) = vr1; } while (0)
#define ATT_VLD(dst, Vb_, n_) do { _Pragma("unroll") for (int j = 0; j < 4; ++j) dst[j] = *(const LAS bf16x8*)((Vb_) + ((n_) * 32 + r32) * 144 + (j * 16 + hi * 8) * 2); } while (0)
#define ATT_PVM(src, P_, n_) do { _Pragma("unroll") for (int j = 0; j < 4; ++j) O[n_] = __builtin_amdgcn_mfma_f32_32x32x16_bf16(src[j], P_[j >> 1][j & 1], O[n_], 0, 0, 0); } while (0)
#define ATT_PV(Vb_, P_) do { ATT_VLD(fb, Vb_, 1); __builtin_amdgcn_sched_barrier(0); ATT_PVM(fa, P_, 0); ATT_VLD(fa, Vb_, 2); __builtin_amdgcn_sched_barrier(0); \
            ATT_PVM(fb, P_, 1); ATT_VLD(fb, Vb_, 3); __builtin_amdgcn_sched_barrier(0); ATT_PVM(fa, P_, 2); ATT_PVM(fb, P_, 3); } while (0)
        ATT_LOAD(kt0); ATT_STORE(0, 0);
        LDS_BARRIER();
        bf16x8 pp[2][2];
#pragma unroll
        for (int a_ = 0; a_ < 2; ++a_)
#pragma unroll
            for (int b_ = 0; b_ < 2; ++b_) pp[a_][b_] = (bf16x8){0, 0, 0, 0, 0, 0, 0, 0};
        int vcur = 0;
        for (int kt = kt0; kt < 36; ++kt) {
            const int cur = (kt - kt0) & 1; const int vprev = vcur == 0 ? 2 : vcur - 1, vnext = vcur == 2 ? 0 : vcur + 1;
            if (kt + 1 < 36) ATT_LOAD(kt + 1);
            const LAS unsigned char* Kb = lds + cur * KST; const LAS unsigned char* Vb = lds + VBASE + vcur * VST;
            bf16x8 fa[4], fb[4];
            if (c == 1 && kt > kt0) {
                const LAS unsigned char* Vp = lds + VBASE + vprev * VST;
                ATT_VLD(fa, Vp, 0); __builtin_amdgcn_sched_barrier(0); ATT_PV(Vp, pp);
            }
            f32x16 S0, S1;
#pragma unroll
            for (int i = 0; i < 16; ++i) { S0[i] = -mrun; S1[i] = -mrun; }
            bf16x8 kf[8];
#pragma unroll
            for (int ks = 0; ks < 4; ++ks) { kf[2 * ks] = *(const LAS bf16x8*)(Kb + kperm * 272 + (c * 64 + ks * 16 + hi * 8) * 2); kf[2 * ks + 1] = *(const LAS bf16x8*)(Kb + (32 + kperm) * 272 + (c * 64 + ks * 16 + hi * 8) * 2); }
            __builtin_amdgcn_sched_barrier(0);
#pragma unroll
            for (int ks = 0; ks < 4; ++ks) { S0 = __builtin_amdgcn_mfma_f32_32x32x16_bf16(kf[2 * ks], qf[ks], S0, 0, 0, 0); S1 = __builtin_amdgcn_mfma_f32_32x32x16_bf16(kf[2 * ks + 1], qf[ks], S1, 0, 0, 0); }
            if (c == 0) ATT_VLD(fa, Vb, 0);
            __builtin_amdgcn_sched_barrier(0);
            float mxa = max3f_(S0[0], S1[0], S0[1]), mxb = max3f_(S1[1], S0[2], S1[2]);
#pragma unroll
            for (int i = 3; i < 15; i += 2) { mxa = max3f_(mxa, S0[i], S1[i]); mxb = max3f_(mxb, S0[i + 1], S1[i + 1]); }
            float mx = max3f_(mxa, mxb, fmaxf(S0[15], S1[15]));
            mx = fmaxf(mx, shflx(mx, 32, lane));
            const float dlt = (fabsf(mx) > 8.f) ? mx : 0.f;
            if (__builtin_amdgcn_ballot_w64(dlt != 0.f) != 0ull) {
                const float alpha = __builtin_amdgcn_exp2f(-dlt); mrun += dlt; lsum *= alpha;
#pragma unroll
                for (int i = 0; i < 16; ++i) { S0[i] -= dlt; S1[i] -= dlt; }
#pragma unroll
                for (int n = 0; n < 4; ++n)
#pragma unroll
                    for (int i = 0; i < 16; ++i) O[n][i] *= alpha;
            }
            f32x2 ps2 = {0.f, 0.f};
#pragma unroll
            for (int i = 0; i < 16; i += 2) { S0[i] = __builtin_amdgcn_exp2f(S0[i]); S0[i + 1] = __builtin_amdgcn_exp2f(S0[i + 1]); S1[i] = __builtin_amdgcn_exp2f(S1[i]); S1[i + 1] = __builtin_amdgcn_exp2f(S1[i + 1]);
                ps2 += (f32x2){S0[i], S0[i + 1]} + (f32x2){S1[i], S1[i + 1]}; }
            lsum += ps2.x + ps2.y;
            bf16x8 pf[2][2];
#pragma unroll
            for (int s = 0; s < 2; ++s) { u32x4 w0, w1;
                w0.x = cvtpk(S0[8 * s + 0], S0[8 * s + 1]); w0.y = cvtpk(S0[8 * s + 2], S0[8 * s + 3]); w0.z = cvtpk(S0[8 * s + 4], S0[8 * s + 5]); w0.w = cvtpk(S0[8 * s + 6], S0[8 * s + 7]);
                w1.x = cvtpk(S1[8 * s + 0], S1[8 * s + 1]); w1.y = cvtpk(S1[8 * s + 2], S1[8 * s + 3]); w1.z = cvtpk(S1[8 * s + 4], S1[8 * s + 5]); w1.w = cvtpk(S1[8 * s + 6], S1[8 * s + 7]);
                pf[0][s] = __builtin_bit_cast(bf16x8, w0); pf[1][s] = __builtin_bit_cast(bf16x8, w1); }
            __builtin_amdgcn_sched_barrier(0);
            if (c == 0) { ATT_PV(Vb, pf); }
            else {
#pragma unroll
                for (int a_ = 0; a_ < 2; ++a_)
#pragma unroll
                    for (int b_ = 0; b_ < 2; ++b_) pp[a_][b_] = pf[a_][b_]; }
            if (kt + 1 < 36) ATT_STORE(cur ^ 1, vnext);
            LDS_BARRIER();
            vcur = vnext;
        }
        if (c == 1) { const LAS unsigned char* Vl = lds + VBASE + (vcur == 0 ? 2 : vcur - 1) * VST; bf16x8 fa[4], fb[4];
            ATT_VLD(fa, Vl, 0); __builtin_amdgcn_sched_barrier(0); ATT_PV(Vl, pp); }
        LDS_BARRIER();
#undef ATT_VLD
#undef ATT_PVM
#undef ATT_PV
#undef ATT_LOAD
#undef ATT_STORE
        lsum += shflx(lsum, 32, lane);
        const float inv = 1.f / lsum;
        LAS float* xb = (LAS float*)lds + qs * (32 * 132) + r32 * 132;
        if (c == 1) { const float f = inv * lam;
#pragma unroll
            for (int n = 0; n < 4; ++n)
#pragma unroll
                for (int gq = 0; gq < 4; ++gq) { const int vd = n * 32 + 8 * gq + 4 * hi; *(LAS f32x4*)(xb + vd) = (f32x4){O[n][4 * gq] * f, O[n][4 * gq + 1] * f, O[n][4 * gq + 2] * f, O[n][4 * gq + 3] * f}; } }
        LDS_BARRIER();
        if (c == 0) { float ss = 0.f;
#pragma unroll
            for (int n = 0; n < 4; ++n)
#pragma unroll
                for (int gq = 0; gq < 4; ++gq) { const int vd = n * 32 + 8 * gq + 4 * hi; const f32x4 o1 = *(const LAS f32x4*)(xb + vd);
#pragma unroll
                    for (int j = 0; j < 4; ++j) { const float o = O[n][4 * gq + j] * inv - o1[j]; O[n][4 * gq + j] = o; ss += o * o; } }
            ss += shflx(ss, 32, lane);
            const float rn = rsqrtf(ss * (1.f / 128.f) + EPS) * (1.f - lam_init);
            bf16_t* dst = Q + (size_t)tq * 1024 + h * 128;
#pragma unroll
            for (int n = 0; n < 4; ++n)
#pragma unroll
                for (int gq = 0; gq < 4; ++gq) { const int vd = n * 32 + 8 * gq + 4 * hi; u32x2 w; w.x = cvtpk(O[n][4 * gq] * rn, O[n][4 * gq + 1] * rn); w.y = cvtpk(O[n][4 * gq + 2] * rn, O[n][4 * gq + 3] * rn); *(u32x2*)(dst + vd) = w; } }
        LDS_BARRIER();
    }
}

#define XB_TMO      128
#define XB_XCNT(j)  (256  + 64 * (j))
#define XB_XSUB(j)  (1280 + 64 * (j))
#define XB_XGEN(j)  (2304 + 64 * (j))
#define XB_TOP      3328
#define XB_TOPGEN   3392
#define XCD_BAR_WORDS 3456
#define XB_SPIN_CAP (1u << 18)

__device__ __forceinline__ unsigned xb_ld(unsigned* p)              { return __hip_atomic_load(p, __ATOMIC_RELAXED, __HIP_MEMORY_SCOPE_AGENT); }
__device__ __forceinline__ unsigned xb_add(unsigned* p, unsigned v) { return __hip_atomic_fetch_add(p, v, __ATOMIC_RELAXED, __HIP_MEMORY_SCOPE_AGENT); }
__device__ __forceinline__ unsigned xb_xcc_id() { return (unsigned)__builtin_amdgcn_s_getreg((3 << 11) | 20) & 0xFu; }
#define XB_SPIN(cond, bar) do { unsigned _sp = 0; while (cond) { __builtin_amdgcn_s_sleep(1); \
    if ((++_sp & 255u) == 0u) { if (xb_ld(&(bar)[XB_TMO])) break; if (_sp > XB_SPIN_CAP) { atomicAdd(&(bar)[XB_TMO], 1u); break; } } } } while (0)

struct XcdBarrier {
    unsigned* bar; unsigned x;
    volatile LAS unsigned* st;
};

__device__ __forceinline__ XcdBarrier xcd_barrier_post(unsigned* bar, volatile LAS unsigned* st) {
    XcdBarrier b; b.bar = bar; b.x = xb_xcc_id(); b.st = st;
    if (opaque_tid() == 0) (void)xb_add(&bar[XB_XCNT(b.x)], 1u);
    return b;
}
__device__ __forceinline__ void xcd_barrier_complete(unsigned* bar, unsigned x, unsigned& nloc, unsigned& nx) {
    const unsigned G = gridDim.x * gridDim.y * gridDim.z;
    unsigned sum, cnt, mine, sp = 0u;
    for (;;) {
        sum = 0u; cnt = 0u; mine = 0u;
#pragma unroll
        for (unsigned j = 0; j < 16; ++j) { const unsigned c = xb_ld(&bar[XB_XCNT(j)]); sum += c; cnt += (c > 0u) ? 1u : 0u; mine = (j == x) ? c : mine; }
        if (sum == G) break;
        __builtin_amdgcn_s_sleep(1);
        if ((++sp & 255u) == 0u) { if (xb_ld(&bar[XB_TMO])) break; if (sp > XB_SPIN_CAP) { atomicAdd(&bar[XB_TMO], 1u); break; } }
    }
    nloc = mine > 0u ? mine : 1u; nx = cnt > 0u ? cnt : 1u;
}

__device__ __forceinline__ void xcd_barrier(const XcdBarrier& b) {
    asm volatile("s_waitcnt vmcnt(0)" ::: "memory");
    __syncthreads();
    if (opaque_tid() == 0) {
        unsigned* bar = (unsigned*)(get_params()->ws + WS_BAR);
        unsigned bx = xb_xcc_id(); asm volatile("" : "+s"(bx));
        __builtin_amdgcn_s_waitcnt(0);
        unsigned nloc = b.st[0], nx = b.st[1];
        if (nloc == 0u) { xcd_barrier_complete(bar, bx, nloc, nx); b.st[0] = nloc; b.st[1] = nx; }
        const unsigned old = xb_add(&bar[XB_XSUB(bx)], 1u);
        const unsigned gen = old / nloc;
        if (old + 1u == (gen + 1u) * nloc) {
            __builtin_amdgcn_fence(__ATOMIC_RELEASE, "agent");
            asm volatile("s_waitcnt vmcnt(0)" ::: "memory");
            const unsigned og = xb_add(&bar[XB_TOP], 1u);
            const unsigned tg = og / nx;
            if (og + 1u == (tg + 1u) * nx) xb_add(&bar[XB_TOPGEN], 1u);
            else XB_SPIN(xb_ld(&bar[XB_TOPGEN]) == tg, bar);
            __builtin_amdgcn_fence(__ATOMIC_ACQUIRE, "agent");
            xb_add(&bar[XB_XGEN(bx)], 1u);
            asm volatile("s_waitcnt vmcnt(0)" ::: "memory");
        } else {
            XB_SPIN(xb_ld(&bar[XB_XGEN(bx)]) == gen, bar);
            __builtin_amdgcn_fence(__ATOMIC_ACQUIRE, "agent");
            asm volatile("s_waitcnt vmcnt(0)" ::: "memory");
        }
    }
    __syncthreads();
}


__global__ void __launch_bounds__(512) mega_fwd(Params p_unused) {
    extern __shared__ __attribute__((aligned(16))) unsigned char lds_raw[];
    LAS unsigned char* lds = (LAS unsigned char*)lds_raw;
    cg::grid_group grid = cg::this_grid();
    volatile LAS unsigned* bst = (volatile LAS unsigned*)(lds + 131072);
    { const int t_ = opaque_tid(); if (t_ < 64) bst[t_] = 0u; }
    __syncthreads();
    XcdBarrier gbar;
    { PP q_ = get_params(); gbar = xcd_barrier_post((unsigned*)(q_->ws + WS_BAR), bst); }
#if PROBE
    int n_stamp = 0;
#define SYNC() do { xcd_barrier(gbar); if (opaque_blk() == 0 && opaque_tid() == 0) { PP q_ = get_params(); ((unsigned long long*)(q_->ws + 1280 * 1024))[n_stamp] = __builtin_amdgcn_s_memrealtime(); } ++n_stamp; } while (0)
#else
#define SYNC() xcd_barrier(gbar)
#endif
#define GSETUP PP q = get_params(); unsigned char* ws = q->ws; const int G = gridDim.x, blk = opaque_blk(); (void)ws; (void)G; (void)blk
#define SL(i) (ws + WS_S0 + (size_t)(i) * SLOT)

#if PROBE
    SYNC();
#endif
    phase_init(lds);
    grid.sync();
    phase_modreduce();
    SYNC();

#pragma unroll 1
    for (int l = 0; l < 2; ++l) {
        const bool last = (l == 1);
        const int nMt = last ? 64 : 72;
        phase_convert(lds, l, 0, l == 0 ? 0x1F : 0x8);
        if (l == 0 || gridDim.x != 256) { phase_modulate(l, 0, 1024, TT, l == 0); SYNC(); }
        {
            GSETUP; SchedG S{last ? 13 : 1, (const char*)SL(0), (const char*)(ws + W_RG), (char*)SL(1), (char*)SL(2), 1024, 1024, 72, 8, G, blk};
            gemm_phase(lds, GemmK{1024, 1024, 1024}, S, EpiStore{});
        }
        SYNC();
        phase_rnn(lds, l, 1, false);
        SYNC();
        phase_rnn_carry();
        SYNC();
        phase_rnn(lds, l, 2, last);
        SYNC();
        phase_sym();
        {
            GSETUP; SchedG S{9, (const char*)SL(0), (const char*)(ws + W_G + 0 * MiB), (char*)SL(3), (char*)(ws + W_M + 0 * MiB), 1024, 1024, nMt, 4, G, blk, (G == 256 && !last) ? 1 : 0};
            gemm_phase(lds, GemmK{1024, 1024, 1024}, S, EpiGateMerge{(bf16_t*)SL(1), q->in[17] + l * 3072 + 0 * 1024, (bf16_t*)SL(4), 1, (unsigned*)(ws + WS_CNT + 20480) + 0 * 32 * 16});
        }
        if (!last) {
            GSETUP; const int ns = (G >= 128) ? 64 : 0; if (blk >= ns) { SchedG S{7, (const char*)(ws + W_Z), (const char*)SL(0), nullptr, (char*)(ws + WS_ZTCTX), 1024, 1024, 0, 0, G - ns, blk - ns};
                gemm_phase(lds, GemmK{1024, 1024, 1024}, S, EpiStore{}); }
        }
        SYNC();
        {
            GSETUP; SchedG S{6, (const char*)(ws + W_Z), (const char*)SL(2), (char*)SL(1), (char*)(ws + WS_ZTCTX), 1024, 1024, 0, 0, G, blk};
            gemm_phase(lds, GemmK{1024, 1024, 1024}, S, EpiStoreAlt{(float*)(ws + WS_ALT16)});
        }
        SYNC();
        if (gridDim.x != 256) phase_alt();
        {
            GSETUP; const int fuse = (G == 256) ? 1 : 0; SchedG S{8, (const char*)(ws + WS_T), (const char*)SL(1), (char*)SL(3), nullptr, 1024, 1024, 0, 0, G, blk};
            gemm_phase(lds, GemmK{1024, 1024, 1024}, S, EpiEO{(bf16_t*)SL(3), (bf16_t*)SL(2), (const float*)(ws + WS_ZH), (const float*)(ws + WS_ALT16), (unsigned*)(ws + WS_CNT + 28672) + (size_t)l * 128 * 16, fuse});
        }
        if (!last) { GSETUP; SchedG Sc{5, (const char*)(ws + WS_TC), (const char*)(ws + WS_ZTCTX), (char*)SL(2), nullptr, 512, 512, 0, 0, G, (blk + 128) % G};
            gemm_phase(lds, GemmK{512, 512, 512}, Sc, EpiStore{}); }
        SYNC();
        if (gridDim.x != 256) { phase_combine(); SYNC(); }
        {
            GSETUP; SchedG S{9, (const char*)SL(0), (const char*)(ws + W_G + 2 * MiB), (char*)SL(2), (char*)(ws + W_M + 2 * MiB), 1024, 1024, nMt, 4, G, blk, (G == 256 && !last) ? 1 : 0};
            gemm_phase(lds, GemmK{1024, 1024, 1024}, S, EpiGateMerge{(bf16_t*)SL(1), q->in[17] + l * 3072 + 1 * 1024, (bf16_t*)SL(4), 0, (unsigned*)(ws + WS_CNT + 20480) + 1 * 32 * 16});
        }
        SYNC();
        {
            GSETUP; SchedG S{last ? 14 : 0, (const char*)SL(0), (const char*)(ws + W_QK), nullptr, nullptr, 1024, 1024, 72, 8, G, blk};
            gemm_phase(lds, GemmK{1024, 1024, 1024}, S, EpiQK{(bf16_t*)SL(1), (bf16_t*)SL(2), (const float*)(ws + WS_COS), (const float*)(ws + WS_SIN)});
        }
        {
            GSETUP; SchedG Sv{3, (const char*)(ws + W_V), (const char*)SL(0), (char*)SL(3), nullptr, 1024, 1024, 4, 72, G, (G - 1) - blk};
            gemm_phase(lds, GemmK{1024, 1024, 1024}, Sv, EpiStore{});
        }
        SYNC();
        phase_attn(lds, l, !last);
        SYNC();
        {
            GSETUP; SchedG S{9, (const char*)SL(0), (const char*)(ws + W_G + 4 * MiB), (char*)SL(1), (char*)(ws + W_M + 4 * MiB), 1024, 1024, nMt, 4, G, blk, (G == 256 && !last) ? 1 : 0};
            gemm_phase(lds, GemmK{1024, 1024, 1024}, S, EpiGateMerge{(bf16_t*)SL(2), q->in[17] + l * 3072 + 2 * 1024, (bf16_t*)SL(4), 0, (unsigned*)(ws + WS_CNT + 20480) + 2 * 32 * 16});
        }
        SYNC();
        {
            GSETUP; const int fuse = (G == 256) ? 1 : 0; const float* modl_ = (const float*)(ws + WS_MOD) + (size_t)l * 9 * NMOD;
            SchedG S{fuse ? 10 : 0, (const char*)SL(4), (const char*)(ws + W_O), nullptr, nullptr, 1024, 1024, nMt, 4, G, blk};
            gemm_phase(lds, GemmK{1024, 1024, 1024}, S, EpiResidNorm{q->out, (float*)(ws + WS_XCTX), modl_ + 2048, l == 0 ? q->in[0] : (const float*)q->out, l == 0 ? q->in[2] : (const float*)(ws + WS_XCTX),
                fuse, (bf16_t*)SL(0), modl_, 3072, 4096, (float*)(ws + WS_XSTAT), (unsigned*)(ws + WS_CNT) + (size_t)(l * 2 + 0) * 72 * 16, nullptr});
        }
        if (!last) phase_convert(lds, 1, 32, 0x1);
        SYNC();
        if (gridDim.x != 256) { phase_modulate(l, 3072, 4096, last ? TL : TT, false); SYNC(); }
        {
            GSETUP; SchedG S{0, (const char*)SL(0), (const char*)(ws + W_13), nullptr, nullptr, 1024, 1024, nMt, 22, G, blk};
            gemm_phase(lds, GemmK{1024, 1024, 1024}, S, EpiSwiGLU{(bf16_t*)SL(1)});
        }
        if (!last) phase_convert(lds, 1, 48, 0x2);
        SYNC();
        {
            GSETUP; const int fuse = (G == 256) ? 1 : 0; const float* modl_ = (const float*)(ws + WS_MOD) + (size_t)l * 9 * NMOD; const float* modn_ = (const float*)(ws + WS_MOD) + (size_t)(last ? l : l + 1) * 9 * NMOD;
            SchedG S{fuse ? 10 : 0, (const char*)SL(1), (const char*)(ws + W_2), nullptr, nullptr, DFF, DFF, nMt, 4, G, blk};
            gemm_phase(lds, GemmK{DFF, DFF, DFF}, S, EpiResidNorm{q->out, (float*)(ws + WS_XCTX), modl_ + 5120, (const float*)q->out, (const float*)(ws + WS_XCTX),
                fuse, (bf16_t*)SL(0), modn_, 0, 1024, (float*)(ws + WS_XSTAT), (unsigned*)(ws + WS_CNT) + (size_t)(l * 2 + 1) * 72 * 16, last ? q->in[22] : nullptr});
        }
        if (!last) phase_convert(lds, 1, 32, 0x14);
        if (!last || gridDim.x != 256) SYNC();
    }
    if (gridDim.x != 256) phase_final();
#if PROBE
    grid.sync();
    if (opaque_blk() == 0 && opaque_tid() == 0) { PP q_ = get_params(); const unsigned long long* ts = (const unsigned long long*)(q_->ws + 1280 * 1024);
        float x1 = 0.f, x2 = 0.f;
        PROBE_EXPR
        ((float*)(q_->ws + 1280 * 1024))[1024] = x2; q_->out[0] += x1; }
    __syncthreads();
    if (opaque_blk() == 0) { PP q_ = get_params(); const float x2 = ((const float*)(q_->ws + 1280 * 1024))[1024] * 0.1f; for (int i = opaque_tid(); i < 65536; i += 512) q_->out[8000 * 1024 + i] += x2; }
#endif
}

extern "C" void kernel_launch(void* const* d_in, const int* in_sizes, int n_in, void* d_out, int out_size, void* d_ws, size_t ws_size, hipStream_t stream) {
    static int grid = 0;
    if (grid == 0) {
        int dev = 0, cus = 0, per_cu = 0;
        (void)hipGetDevice(&dev);
        (void)hipDeviceGetAttribute(&cus, hipDeviceAttributeMultiprocessorCount, dev);
        (void)hipFuncSetAttribute((const void*)mega_fwd, hipFuncAttributeMaxDynamicSharedMemorySize, LDS_BYTES);
        (void)hipOccupancyMaxActiveBlocksPerMultiprocessor(&per_cu, (const void*)mega_fwd, 512, LDS_BYTES);
        if (per_cu < 1) { fprintf(stderr, "kernel_launch: occupancy query says %d blocks per CU\n", per_cu); per_cu = 1; }
        if (per_cu > 1) per_cu = 1;
        grid = cus * per_cu;
        if (n_in != 23 || ws_size < 253 * MiB) fprintf(stderr, "kernel_launch: unexpected n_in %d / ws_size %zu\n", n_in, ws_size);
    }
    Params p{};
    for (int i = 0; i < 23; ++i) p.in[i] = (const float*)d_in[i];
    p.out = (float*)d_out; p.ws = (unsigned char*)d_ws;
    (void)hipMemsetAsync((unsigned char*)d_ws + WS_BAR, 0, 65536, stream);
    void* args[] = {&p};
    hipError_t e = hipLaunchCooperativeKernel((const void*)mega_fwd, dim3(grid), dim3(512), args, LDS_BYTES, stream);
    if (e != hipSuccess) fprintf(stderr, "cooperative launch failed: %s (grid %d)\n", hipGetErrorString(e), grid);
}
```

```cpp
#include <hip/hip_runtime.h>
#include <hip/hip_cooperative_groups.h>
#include <cstdio>
#include <cstdint>
namespace cg = cooperative_groups;
#define PROBE 0
#define DT(a, b) ((float)(ts[b] - ts[a]) * 1e-4f)
#define PROBE_EXPR x1 = DT(2 + 20, 2 + 21); x2 = DT(2 + 21, 2 + 22);

#define LAS __attribute__((address_space(3)))
#define DEVINL __device__ __forceinline__
typedef unsigned short bf16_t;
typedef short bf16x8 __attribute__((ext_vector_type(8)));
typedef float f32x2 __attribute__((ext_vector_type(2)));
typedef float f32x4 __attribute__((ext_vector_type(4)));
typedef float f32x16 __attribute__((ext_vector_type(16)));
typedef unsigned u32x2 __attribute__((ext_vector_type(2)));
typedef unsigned u32x4 __attribute__((ext_vector_type(4)));
typedef __bf16 bf16x2_t __attribute__((ext_vector_type(2)));

constexpr int DM = 1024, NB = 8, SEQ = 2048, CTX = 256, TL = NB * SEQ, TC = NB * CTX, TT = TL + TC;
constexpr int DFF = 2816, NMOD = 6144;
constexpr float EPS = 1e-6f;
constexpr float C2 = 0.125f * 1.4426950408889634f;

constexpr size_t MiB = 1u << 20;
constexpr size_t WS_MOD = 0;
constexpr size_t WS_COS = 512 * 1024, WS_SIN = 768 * 1024;
constexpr size_t WS_BAR = 1536 * 1024;
constexpr size_t WS_XCTX = 2 * MiB;
constexpr size_t WS_T = 10 * MiB;
constexpr size_t WS_TC = 26 * MiB;
constexpr size_t WS_W = 27 * MiB;
constexpr size_t W_RG = WS_W, W_QK = WS_W + 4 * MiB, W_V = WS_W + 8 * MiB, W_Z = WS_W + 10 * MiB, W_G = WS_W + 14 * MiB,
                 W_M = WS_W + 20 * MiB, W_O = WS_W + 26 * MiB, W_13 = WS_W + 28 * MiB, W_2 = WS_W + 39 * MiB, W_RNN = WS_W + 44 * MiB + 512 * 1024;
constexpr size_t SLOT = 36 * MiB;
constexpr size_t WS_S0 = 73 * MiB, WS_S1 = WS_S0 + SLOT, WS_S2 = WS_S1 + SLOT, WS_S3 = WS_S2 + SLOT, WS_S4 = WS_S3 + SLOT;
constexpr int LDS_BYTES = 131072 + 8192;
constexpr size_t WS_CNT = WS_BAR + 16384;
constexpr size_t WS_ALT16 = WS_T + 12 * MiB + 128 * 1024;
constexpr size_t WS_XSTAT = WS_T + 13 * MiB;

struct Params { const float* in[23]; float* out; unsigned char* ws; };

DEVINL unsigned cvtpk(float lo, float hi) { f32x2 v = {lo, hi}; bf16x2_t b = __builtin_convertvector(v, bf16x2_t); return __builtin_bit_cast(unsigned, b); }
DEVINL float bf2f(unsigned short b) { return __builtin_bit_cast(float, (unsigned)b << 16); }
DEVINL float bflo(unsigned w) { return __builtin_bit_cast(float, w << 16); }
DEVINL float bfhi(unsigned w) { return __builtin_bit_cast(float, w & 0xffff0000u); }
DEVINL void bf8_unpack(const u32x4 x, float* f) { f[0] = bflo(x.x); f[1] = bfhi(x.x); f[2] = bflo(x.y); f[3] = bfhi(x.y); f[4] = bflo(x.z); f[5] = bfhi(x.z); f[6] = bflo(x.w); f[7] = bfhi(x.w); }
DEVINL u32x4 bf8_pack(const float* f) { u32x4 w; w.x = cvtpk(f[0], f[1]); w.y = cvtpk(f[2], f[3]); w.z = cvtpk(f[4], f[5]); w.w = cvtpk(f[6], f[7]); return w; }
DEVINL float shflx(float v, int mask, int lane) { return __builtin_bit_cast(float, __builtin_amdgcn_ds_bpermute((lane ^ mask) << 2, __builtin_bit_cast(int, v))); }
DEVINL float wave_sum(float v, int lane) {
#pragma unroll
    for (int o = 1; o < 64; o <<= 1) v += shflx(v, o, lane);
    return v;
}
DEVINL float max3f_(float a, float b, float c) { float r; asm("v_max3_f32 %0, %1, %2, %3" : "=v"(r) : "v"(a), "v"(b), "v"(c)); return r; }
DEVINL float sigmoidf_(float x) { return __builtin_amdgcn_rcpf(1.f + __expf(-x)); }
DEVINL float gelu_tanh(float x) { const float u = 0.7978845608028654f * (x + 0.044715f * x * x * x); const float e = __expf(2.f * u); const float t = 1.f - 2.f * __builtin_amdgcn_rcpf(e + 1.f); return 0.5f * x * (1.f + t); }
#define LDS_WAIT() asm volatile("s_waitcnt lgkmcnt(0)" ::: "memory")
DEVINL void st16_wt(void* p, u32x4 v) { asm volatile("global_store_dwordx4 %0, %1, off sc1\n\ts_nop 1" :: "v"(p), "v"(v) : "memory"); }
#define LDS_BARRIER() asm volatile("s_waitcnt lgkmcnt(0)\n\ts_barrier" ::: "memory")
DEVINL int opaque_tid() { int t = threadIdx.x; asm volatile("" : "+v"(t)); return t; }
DEVINL int opaque_blk() { int t = blockIdx.x; asm volatile("" : "+s"(t)); return t; }
typedef const __attribute__((address_space(4))) Params* PP;
DEVINL PP get_params() { PP q = (PP)__builtin_amdgcn_kernarg_segment_ptr(); asm volatile("" : "+s"(q)); return q; }

constexpr int BM = 256, BK = 64, HALF = 128, HTB = HALF * BK * 2;
DEVINL int lds_byte(int r, int c) { const int st = (r >> 4) * 2 + (c >> 5), rr = r & 15, cc = c & 31, ob = rr * 64 + cc * 2; return st * 1024 + (ob ^ (((ob >> 9) & 1) << 5)); }
DEVINL void stage_rc(int b, int& R, int& C) { const int st = b / 1024, sb = b % 1024, swz = sb ^ (((sb >> 9) & 1) << 5); R = (st >> 1) * 16 + swz / 64; C = (st & 1) * 32 + (swz % 64) / 2; }
DEVINL int perm32(int rho) { const int n = rho >> 4, i = rho & 15; return 8 * (i >> 2) + 4 * n + (i & 3); }

struct Unit { const char* a; const char* b; char* o; int ldo, pm, pn; };
struct GemmK { int lda, ldb, K; };

DEVINL bool tile_order(int i, int G, int c, int nM, int nN, int& pm, int& pn) {
    const long L = (long)i * G + c; const int nwg = nM * nN; if (L >= nwg) return false;
    int wgid = (int)L; { const int q = nwg / 8, r = nwg % 8, xcd = wgid % 8, off = wgid / 8; wgid = (xcd < r ? xcd * (q + 1) : r * (q + 1) + (xcd - r) * q) + off; }
    const int nig = 8 * nN, gid = wgid / nig, fm = gid * 8, gsz = (nM - fm) < 8 ? (nM - fm) : 8;
    pm = fm + ((wgid % nig) % gsz); pn = (wgid % nig) / gsz; return true;
}

struct SchedG {
    int kind; const char* A; const char* B; char* O; char* O2; int lda, ldb, nM, nN, G, c, pm0;
    DEVINL bool next(int i, Unit& u) const {
        int pm, pn;
        if (kind >= 4 && kind < 9) {
            const long L = (long)i * G + c;
            if (kind == 7) {
                if (L >= 64) return false; const int Lc = (int)L; pm = Lc >> 3; const int b = Lc & 7, part = pm >> 2, j0 = (pm & 3) * 256; pn = b;
                u.a = A + (size_t)pm * 256 * 1024 * 2; u.b = B + ((size_t)TL + b * 256) * 1024 * 2; u.o = O2 + ((((size_t)b * 1024 + j0) * 2 + part) * 256) * 2; u.ldo = 512;
            } else if (kind == 6) {
                if (L < 256) { const int part = (int)L >> 7; pm = ((int)L >> 5) & 3; pn = (int)L & 31; const int b = pn >> 2, n0 = (pn & 3) * 256;
                    u.a = A + ((size_t)part * 1024 + pm * 256) * 1024 * 2; u.b = B + (size_t)part * 16 * MiB + (size_t)pn * 256 * 1024 * 2;
                    u.o = O + (size_t)part * 16 * MiB + (((size_t)b * 1024 + pm * 256) * 1024 + n0) * 2; u.ldo = 1024; pn += 32 * part; }
                else if (L < 256 + nN) { const int Lc = (int)L - 256; pm = Lc >> 3; const int b = Lc & 7, part = pm >> 2, j0 = (pm & 3) * 256; pn = b;
                    u.a = A + (size_t)pm * 256 * 1024 * 2; u.b = B - 2 * SLOT + ((size_t)TL + b * 256) * 1024 * 2;
                    u.o = O2 + ((((size_t)b * 1024 + j0) * 2 + part) * 256) * 2; u.ldo = 512; }
                else return false;
            } else if (kind == 8) {
                if (L >= 256) return false; const int part = (int)L >> 7, b = ((int)L >> 4) & 7; pm = ((int)L >> 2) & 3; pn = (int)L & 3;
                u.a = A + (size_t)part * 2 * MiB + (size_t)pm * 256 * 1024 * 2; u.b = B + (size_t)part * 16 * MiB + ((size_t)b * 1024 + pn * 256) * 1024 * 2;
                u.o = O + (size_t)part * 16 * MiB + (((size_t)b * 1024 + pm * 256) * 1024 + pn * 256) * 2; u.ldo = 1024; pn |= (b << 2) | (part << 5); }
            else { if (L >= 32) return false; const int b = (int)L >> 2; pm = 0; pn = (int)L & 3;
                u.a = A; u.b = B + ((size_t)b * 1024 + pn * 256) * 512 * 2; u.o = O + (((size_t)TL + b * 256) * 1024 + pn * 256) * 2; u.ldo = 1024; }
            u.pm = pm; u.pn = pn; return true;
        }
        if (kind == 10) {
            if (i == 0) { pm = (c & 7) * 8 + (c >> 5); pn = (c >> 3) & 3; }
            else if (i == 1 && nM == 72 && c < 32) { pm = 64 + (c & 7); pn = c >> 3; }
            else return false;
            u.pm = pm; u.pn = pn; u.a = A + (size_t)pm * 256 * lda * 2; u.b = B + (size_t)pn * 256 * ldb * 2; u.o = O; u.ldo = 1024; return true;
        }
        if (kind == 9) {
            int sub;
            if (pm0) {
                if (i < 2) { if (!tile_order(0, G, c, 64, nN, pm, pn)) return false; sub = i; }
                else if (i == 2 && c < 64) { const int p = c & 31; pm = 64 + (p >> 2); pn = p & 3; sub = (c < 32) ? 2 : 3; }
                else return false;
            } else { if (!tile_order(i >> 1, G, c, nM, nN, pm, pn)) return false; sub = i & 1; }
            u.pm = pm; u.pn = pn; u.ldo = sub; u.o = nullptr;
            u.a = ((sub & 1) ? (const char*)O : A) + (size_t)pm * 256 * lda * 2; u.b = ((sub & 1) ? (const char*)O2 : B) + (size_t)pn * 256 * ldb * 2; return true;
        }
        if (!tile_order(i, G, c, nM, nN, pm, pn)) return false;
        pm += pm0; u.pm = pm; u.pn = pn; u.a = A + (size_t)pm * 256 * lda * 2; u.b = B + (size_t)pn * 256 * ldb * 2; u.o = O; u.ldo = 1024;
        if (kind == 1) { u.o = (pn < 4 ? O : O2) + ((size_t)pm * 256 * 1024 + (pn & 3) * 256) * 2; }
        else if (kind == 2) {
            const int part = pm >> 2, j0 = (pm & 3) * 256;
            if (pn < 64) { const int b = pn >> 3, n0 = (pn & 7) * 256; u.o = O + ((((size_t)b * 1024 + j0) * 2 + part) * 2048 + n0) * 2; u.ldo = 4096; }
            else { const int b = pn - 64; u.o = O2 + ((((size_t)b * 1024 + j0) * 2 + part) * 256) * 2; u.ldo = 512; }
        } else if (kind == 3) {
            int b, key0; if (pn < 64) { b = pn >> 3; key0 = (pn & 7) * 256; } else { b = pn - 64; key0 = 2048; }
            u.o = O + (((size_t)b * 1024 + pm * 256) * 2304 + key0) * 2; u.ldo = 2304;
        }
        return true;
    }
};

typedef f32x4 AccT[2][2][4][2];
struct EpiStore {
    static constexpr bool FUSED = false;
    DEVINL void operator()(const AccT& acc, const Unit& u, int wr, int wc, int fr, int fq) const {
#pragma unroll
        for (int ai = 0; ai < 2; ++ai)
#pragma unroll
            for (int m = 0; m < 4; ++m) { bf16_t* rowp = (bf16_t*)u.o + (size_t)(ai * 128 + wr * 64 + m * 16 + fr) * u.ldo + wc * 32 + 8 * fq;
#pragma unroll
                for (int bj = 0; bj < 2; ++bj) { const f32x4 v0 = acc[ai][bj][m][0], v1 = acc[ai][bj][m][1]; u32x4 w;
                    w.x = cvtpk(v0[0], v0[1]); w.y = cvtpk(v0[2], v0[3]); w.z = cvtpk(v1[0], v1[1]); w.w = cvtpk(v1[2], v1[3]); *(u32x4*)(rowp + bj * 128) = w; } }
    }
};
struct EpiQK {
    static constexpr bool FUSED = false;
    bf16_t* Q; bf16_t* K; const float* cosT; const float* sinT;
    DEVINL void operator()(const AccT& acc, const Unit& u, int wr, int wc, int fr, int fq) const {
        const bool isq = u.pn < 4; bf16_t* base = isq ? Q : K; const float sc = isq ? C2 : 1.f;
        const int hp = (u.pn & 3) * 2 + (wc >> 1), c = wc & 1, jj0 = 8 * fq;
#pragma unroll
        for (int ai = 0; ai < 2; ++ai)
#pragma unroll
            for (int m = 0; m < 4; ++m) { const int t = u.pm * 256 + ai * 128 + wr * 64 + m * 16 + fr; const bool lat = t < TL; const int pos = t & 2047;
                bf16_t* dst = base + (size_t)t * 1024 + hp * 128 + c * 64 + jj0; f32x4 o1[2], o2[2];
#pragma unroll
                for (int n = 0; n < 2; ++n) { f32x4 cs = {1.f, 1.f, 1.f, 1.f}, sn = {0.f, 0.f, 0.f, 0.f};
                    if (lat) { cs = *(const f32x4*)(cosT + pos * 32 + jj0 + 4 * n); sn = *(const f32x4*)(sinT + pos * 32 + jj0 + 4 * n); }
                    const f32x4 t1 = acc[ai][0][m][n], t2 = acc[ai][1][m][n]; o1[n] = (t1 * cs - t2 * sn) * sc; o2[n] = (t1 * sn + t2 * cs) * sc; }
                u32x4 w; w.x = cvtpk(o1[0][0], o1[0][1]); w.y = cvtpk(o1[0][2], o1[0][3]); w.z = cvtpk(o1[1][0], o1[1][1]); w.w = cvtpk(o1[1][2], o1[1][3]); *(u32x4*)dst = w;
                w.x = cvtpk(o2[0][0], o2[0][1]); w.y = cvtpk(o2[0][2], o2[0][3]); w.z = cvtpk(o2[1][0], o2[1][1]); w.w = cvtpk(o2[1][2], o2[1][3]); *(u32x4*)(dst + 32) = w; }
    }
};
struct EpiGate {
    static constexpr bool FUSED = false;
    bf16_t* Gd; const float* bias; int wt;
    DEVINL void operator()(const AccT& acc, const Unit& u, int wr, int wc, int fr, int fq) const {
        const int col0 = u.pn * 256 + wc * 32 + 8 * fq;
#pragma unroll
        for (int bj = 0; bj < 2; ++bj) { const f32x4 b0 = *(const f32x4*)(bias + col0 + bj * 128), b1 = *(const f32x4*)(bias + col0 + bj * 128 + 4);
#pragma unroll
            for (int ai = 0; ai < 2; ++ai)
#pragma unroll
                for (int m = 0; m < 4; ++m) { const int t = u.pm * 256 + ai * 128 + wr * 64 + m * 16 + fr; const f32x4 v0 = acc[ai][bj][m][0] + b0, v1 = acc[ai][bj][m][1] + b1; u32x4 w;
                    w.x = cvtpk(sigmoidf_(v0[0]), sigmoidf_(v0[1])); w.y = cvtpk(sigmoidf_(v0[2]), sigmoidf_(v0[3])); w.z = cvtpk(sigmoidf_(v1[0]), sigmoidf_(v1[1])); w.w = cvtpk(sigmoidf_(v1[2]), sigmoidf_(v1[3]));
                    if (wt) st16_wt(Gd + (size_t)t * 1024 + col0 + bj * 128, w); else *(u32x4*)(Gd + (size_t)t * 1024 + col0 + bj * 128) = w; } }
    }
};
struct EpiMerge {
    static constexpr bool FUSED = false;
    const bf16_t* Gs; bf16_t* Md; int first;
    DEVINL void operator()(const AccT& acc, const Unit& u, int wr, int wc, int fr, int fq) const {
        const int col0 = u.pn * 256 + wc * 32 + 8 * fq;
#pragma unroll
        for (int ai = 0; ai < 2; ++ai)
#pragma unroll
            for (int m = 0; m < 4; ++m) { const int t = u.pm * 256 + ai * 128 + wr * 64 + m * 16 + fr;
#pragma unroll
                for (int bj = 0; bj < 2; ++bj) { const size_t off = (size_t)t * 1024 + col0 + bj * 128; const u32x4 g = *(const u32x4*)(Gs + off); const f32x4 v0 = acc[ai][bj][m][0], v1 = acc[ai][bj][m][1];
                    float r0 = bflo(g.x) * v0[0], r1 = bfhi(g.x) * v0[1], r2 = bflo(g.y) * v0[2], r3 = bfhi(g.y) * v0[3], r4 = bflo(g.z) * v1[0], r5 = bfhi(g.z) * v1[1], r6 = bflo(g.w) * v1[2], r7 = bfhi(g.w) * v1[3];
                    if (!first) { const u32x4 o = *(const u32x4*)(Md + off); r0 += bflo(o.x); r1 += bfhi(o.x); r2 += bflo(o.y); r3 += bfhi(o.y); r4 += bflo(o.z); r5 += bfhi(o.z); r6 += bflo(o.w); r7 += bfhi(o.w); }
                    u32x4 w; w.x = cvtpk(r0, r1); w.y = cvtpk(r2, r3); w.z = cvtpk(r4, r5); w.w = cvtpk(r6, r7); *(u32x4*)(Md + off) = w; } }
    }
};
struct EpiGateMerge {
    static constexpr bool FUSED = true;
    bf16_t* Gd; const float* bias; bf16_t* Md; int first; unsigned* cnt;
    DEVINL void operator()(AccT& acc, const Unit& u, int wr, int wc, int fr, int fq, LAS unsigned char* lds, int wid, int lane) const {
        (void)lds;
        const int role = u.ldo; unsigned* cw = cnt + 16 * ((u.pm - 64) * 4 + u.pn);
        if (role == 0) { EpiGate g{Gd, bias, 0}; g(acc, u, wr, wc, fr, fq); }
        else if (role == 2) { EpiGate g{Gd, bias, 1}; g(acc, u, wr, wc, fr, fq);
            asm volatile("s_waitcnt vmcnt(0)" ::: "memory");
            if (lane == 0) __hip_atomic_fetch_add(cw, 1u, __ATOMIC_RELAXED, __HIP_MEMORY_SCOPE_AGENT); }
        else {
            if (role == 3) {
                if (wid == 0) { unsigned spins = 0;
                    while ((unsigned)__builtin_amdgcn_readfirstlane((int)__hip_atomic_load(cw, __ATOMIC_RELAXED, __HIP_MEMORY_SCOPE_AGENT)) < 8u) { __builtin_amdgcn_s_sleep(2); if (++spins > (1u << 22)) break; }
                    __builtin_amdgcn_fence(__ATOMIC_ACQUIRE, "agent"); }
                asm volatile("s_waitcnt vmcnt(0) lgkmcnt(0)\n\ts_barrier" ::: "memory");
            }
            EpiMerge m{Gd, Md, first}; m(acc, u, wr, wc, fr, fq); }
    }
};
struct EpiResid {
    static constexpr bool FUSED = false;
    float* Xlat; float* Xctx; const float* gmod; const float* Rlat; const float* Rctx;
    DEVINL void operator()(const AccT& acc, const Unit& u, int wr, int wc, int fr, int fq) const {
        const int col0 = u.pn * 256 + wc * 32 + 8 * fq; const int mr = u.pm < 64 ? (u.pm >> 3) : 8;
        float* xb = u.pm < 64 ? Xlat + (size_t)u.pm * 256 * 1024 : Xctx + (size_t)(u.pm - 64) * 256 * 1024;
        const float* rb = u.pm < 64 ? Rlat + (size_t)u.pm * 256 * 1024 : Rctx + (size_t)(u.pm - 64) * 256 * 1024;
#pragma unroll
        for (int bj = 0; bj < 2; ++bj) { const f32x4 g0 = *(const f32x4*)(gmod + mr * NMOD + col0 + bj * 128), g1 = *(const f32x4*)(gmod + mr * NMOD + col0 + bj * 128 + 4);
#pragma unroll
            for (int ai = 0; ai < 2; ++ai)
#pragma unroll
                for (int m = 0; m < 4; ++m) { const size_t xo = (size_t)(ai * 128 + wr * 64 + m * 16 + fr) * 1024 + col0 + bj * 128; float* xp = xb + xo;
                    f32x4 x0 = *(const f32x4*)(rb + xo), x1 = *(const f32x4*)(rb + xo + 4); x0 += g0 * acc[ai][bj][m][0]; x1 += g1 * acc[ai][bj][m][1]; *(f32x4*)xp = x0; *(f32x4*)(xp + 4) = x1; } }
    }
};
struct EpiResidNorm {
    static constexpr bool FUSED = true;
    float* Xlat; float* Xctx; const float* gmod; const float* Rlat; const float* Rctx;
    int fuse; bf16_t* H; const float* nmod; int shoff, scoff; float* xstat; unsigned* cnt; const float* fg;
    DEVINL void operator()(AccT& acc, const Unit& u, int wr, int wc, int fr, int fq, LAS unsigned char* lds, int wid, int lane) const {
        const int col0 = u.pn * 256 + wc * 32 + 8 * fq; const int mr = u.pm < 64 ? (u.pm >> 3) : 8;
        float* xb = u.pm < 64 ? Xlat + (size_t)u.pm * 256 * 1024 : Xctx + (size_t)(u.pm - 64) * 256 * 1024;
        const float* rb = u.pm < 64 ? Rlat + (size_t)u.pm * 256 * 1024 : Rctx + (size_t)(u.pm - 64) * 256 * 1024;
#pragma unroll
        for (int bj = 0; bj < 2; ++bj) { const f32x4 g0 = *(const f32x4*)(gmod + mr * NMOD + col0 + bj * 128), g1 = *(const f32x4*)(gmod + mr * NMOD + col0 + bj * 128 + 4);
#pragma unroll
            for (int ai = 0; ai < 2; ++ai)
#pragma unroll
                for (int m = 0; m < 4; ++m) { const size_t xo = (size_t)(ai * 128 + wr * 64 + m * 16 + fr) * 1024 + col0 + bj * 128; float* xp = xb + xo;
                    f32x4 x0 = *(const f32x4*)(rb + xo), x1 = *(const f32x4*)(rb + xo + 4); x0 += g0 * acc[ai][bj][m][0]; x1 += g1 * acc[ai][bj][m][1];
                    acc[ai][bj][m][0] = x0; acc[ai][bj][m][1] = x1; if (!(fuse && fg)) { *(f32x4*)xp = x0; *(f32x4*)(xp + 4) = x1; } } }
        if (!fuse) return;
        LAS float* P = (LAS float*)(lds + 131072 + 1024);
        LAS float* S = (LAS float*)(lds + 131072 + 5120);
#pragma unroll
        for (int ai = 0; ai < 2; ++ai)
#pragma unroll
            for (int m = 0; m < 4; ++m) { float sq = 0.f;
#pragma unroll
                for (int bj = 0; bj < 2; ++bj)
#pragma unroll
                    for (int n = 0; n < 2; ++n) { const f32x4 x = acc[ai][bj][m][n]; sq += (x[0] * x[0] + x[1] * x[1]) + (x[2] * x[2] + x[3] * x[3]); }
                sq += shflx(sq, 16, lane); sq += shflx(sq, 32, lane);
                if (fq == 0) P[(ai * 128 + wr * 64 + m * 16 + fr) * 4 + wc] = sq; }
        LDS_BARRIER();
        const int row = wid * 32 + (lane & 31);
        if (lane < 32) { const float t = (P[row * 4 + 0] + P[row * 4 + 1]) + (P[row * 4 + 2] + P[row * 4 + 3]);
            __hip_atomic_store((unsigned*)xstat + ((size_t)(u.pm * 256 + row) * 4 + u.pn), __builtin_bit_cast(unsigned, t), __ATOMIC_RELAXED, __HIP_MEMORY_SCOPE_AGENT); }
        asm volatile("s_waitcnt vmcnt(0)" ::: "memory");
        if (lane == 0) __hip_atomic_fetch_add(cnt + 16 * u.pm, 1u, __ATOMIC_RELAXED, __HIP_MEMORY_SCOPE_AGENT);
        if (wid == 0) { unsigned spins = 0;
            while ((unsigned)__builtin_amdgcn_readfirstlane((int)__hip_atomic_load(cnt + 16 * u.pm, __ATOMIC_RELAXED, __HIP_MEMORY_SCOPE_AGENT)) < 32u) { __builtin_amdgcn_s_sleep(2); if (++spins > (1u << 22)) break; }
            __builtin_amdgcn_fence(__ATOMIC_ACQUIRE, "agent"); }
        asm volatile("s_waitcnt vmcnt(0) lgkmcnt(0)\n\ts_barrier" ::: "memory");
        if (lane < 32) { const unsigned* sl = (const unsigned*)xstat + (size_t)(u.pm * 256 + row) * 4; float tot = 0.f;
#pragma unroll
            for (int t = 0; t < 4; ++t) tot += __builtin_bit_cast(float, __hip_atomic_load(sl + t, __ATOMIC_RELAXED, __HIP_MEMORY_SCOPE_AGENT));
            S[row] = rsqrtf(tot * (1.f / 1024.f) + EPS); }
        LDS_BARRIER();
        if (fg) {
#pragma unroll
            for (int bj = 0; bj < 2; ++bj) { const f32x4 g0 = *(const f32x4*)(fg + col0 + bj * 128), g1 = *(const f32x4*)(fg + col0 + bj * 128 + 4);
#pragma unroll
                for (int ai = 0; ai < 2; ++ai)
#pragma unroll
                    for (int m = 0; m < 4; ++m) { const int r = ai * 128 + wr * 64 + m * 16 + fr; const float rinv = S[r]; float* xp = xb + (size_t)r * 1024 + col0 + bj * 128;
                        *(f32x4*)xp = acc[ai][bj][m][0] * rinv * g0; *(f32x4*)(xp + 4) = acc[ai][bj][m][1] * rinv * g1; } }
            return;
        }
#pragma unroll
        for (int bj = 0; bj < 2; ++bj) { const float* mp = nmod + mr * NMOD + col0 + bj * 128;
            const f32x4 sc0 = *(const f32x4*)(mp + scoff) + 1.f, sc1 = *(const f32x4*)(mp + scoff + 4) + 1.f, sh0 = *(const f32x4*)(mp + shoff), sh1 = *(const f32x4*)(mp + shoff + 4);
#pragma unroll
            for (int ai = 0; ai < 2; ++ai)
#pragma unroll
                for (int m = 0; m < 4; ++m) { const int r = ai * 128 + wr * 64 + m * 16 + fr; const float rinv = S[r];
                    const f32x4 y0 = acc[ai][bj][m][0] * rinv * sc0 + sh0, y1 = acc[ai][bj][m][1] * rinv * sc1 + sh1; u32x4 w;
                    w.x = cvtpk(y0[0], y0[1]); w.y = cvtpk(y0[2], y0[3]); w.z = cvtpk(y1[0], y1[1]); w.w = cvtpk(y1[2], y1[3]);
                    *(u32x4*)(H + (size_t)(u.pm * 256 + r) * 1024 + col0 + bj * 128) = w; } }
    }
};
struct EpiStoreAlt {
    static constexpr bool FUSED = false;
    float* alt16;
    DEVINL void operator()(const AccT& acc, const Unit& u, int wr, int wc, int fr, int fq) const {
        EpiStore st; st(acc, u, wr, wc, fr, fq);
        if (u.pn < 32) { const int b = u.pn >> 2, q4 = u.pn & 3, lane = fq * 16 + fr;
#pragma unroll
            for (int ai = 0; ai < 2; ++ai)
#pragma unroll
                for (int m = 0; m < 4; ++m) { float sa = 0.f;
#pragma unroll
                    for (int bj = 0; bj < 2; ++bj)
#pragma unroll
                        for (int n = 0; n < 2; ++n) { const f32x4 x = acc[ai][bj][m][n]; sa += (x[0] - x[1]) + (x[2] - x[3]); }
                    sa += shflx(sa, 16, lane); sa += shflx(sa, 32, lane);
                    if (fq == 0) alt16[((size_t)(b * 1024 + u.pm * 256 + ai * 128 + wr * 64 + m * 16 + fr)) * 16 + q4 * 4 + wc] = sa; } }
    }
};
struct EpiEO {
    static constexpr bool FUSED = true;
    bf16_t* EO; bf16_t* Yb; const float* zh; const float* alt16; unsigned* cnt; int fuse;
    DEVINL void operator()(AccT& acc, const Unit& u, int wr, int wc, int fr, int fq, LAS unsigned char* lds, int wid, int lane) const {
        (void)lds;
        const int pn = u.pn & 3, b = (u.pn >> 2) & 7, part = u.pn >> 5; const int col0 = pn * 256 + wc * 32 + 8 * fq;
        const size_t tbase = ((size_t)b * 1024 + u.pm * 256) * 1024 + col0;
        bf16_t* mine = EO + (size_t)part * 8 * MiB + tbase; const bf16_t* other = EO + (size_t)(part ^ 1) * 8 * MiB + tbase;
#pragma unroll
        for (int ai = 0; ai < 2; ++ai)
#pragma unroll
            for (int m = 0; m < 4; ++m) { const int row = ai * 128 + wr * 64 + m * 16 + fr;
#pragma unroll
                for (int bj = 0; bj < 2; ++bj) { const f32x4 v0 = acc[ai][bj][m][0], v1 = acc[ai][bj][m][1]; u32x4 w;
                    w.x = cvtpk(v0[0], v0[1]); w.y = cvtpk(v0[2], v0[3]); w.z = cvtpk(v1[0], v1[1]); w.w = cvtpk(v1[2], v1[3]);
                    if (fuse) st16_wt(mine + (size_t)row * 1024 + bj * 128, w); else *(u32x4*)(mine + (size_t)row * 1024 + bj * 128) = w; } }
        if (!fuse) return;
        unsigned* cw = cnt + 16 * ((b * 4 + u.pm) * 4 + pn);
        asm volatile("s_waitcnt vmcnt(0)" ::: "memory");
        if (lane == 0) __hip_atomic_fetch_add(cw, 1u, __ATOMIC_RELAXED, __HIP_MEMORY_SCOPE_AGENT);
        if (wid == 0) { unsigned spins = 0;
            while ((unsigned)__builtin_amdgcn_readfirstlane((int)__hip_atomic_load(cw, __ATOMIC_RELAXED, __HIP_MEMORY_SCOPE_AGENT)) < 16u) { __builtin_amdgcn_s_sleep(2); if (++spins > (1u << 22)) break; }
            __builtin_amdgcn_fence(__ATOMIC_ACQUIRE, "agent"); }
        asm volatile("s_waitcnt vmcnt(0) lgkmcnt(0)\n\ts_barrier" ::: "memory");
        constexpr float SC = 0.022097086912079608f;
#pragma unroll
        for (int bj = 0; bj < 2; ++bj) { const float* zp = zh + b * 1024 + col0 + bj * 128; const f32x4 z0 = *(const f32x4*)zp, z1 = *(const f32x4*)(zp + 4);
            const float zv[8] = {z0.x, z0.y, z0.z, z0.w, z1.x, z1.y, z1.z, z1.w};
#pragma unroll
            for (int ai = 0; ai < 2; ++ai)
#pragma unroll
                for (int m = 0; m < 4; ++m) { const int row = ai * 128 + wr * 64 + m * 16 + fr, k = u.pm * 256 + row; const float sg = (k & 1) ? -SC : SC;
                    float ov[8], y[8]; bf8_unpack(*(const u32x4*)(other + (size_t)row * 1024 + bj * 128), ov);
                    const f32x4 a0 = acc[ai][bj][m][0], a1 = acc[ai][bj][m][1]; const float av[8] = {a0[0], a0[1], a0[2], a0[3], a1[0], a1[1], a1[2], a1[3]};
                    int dest;
                    if (part == 0) { dest = k;
#pragma unroll
                        for (int e = 0; e < 8; ++e) y[e] = (av[e] + sg * zv[e]) - ov[e]; }
                    else if (k != 0) { dest = 2048 - k;
#pragma unroll
                        for (int e = 0; e < 8; ++e) y[e] = (ov[e] + sg * zv[e]) + av[e]; }
                    else { dest = 1024;
#pragma unroll
                        for (int e = 0; e < 8; ++e) { const float* ap = alt16 + ((size_t)(b * 1024 + col0 + bj * 128 + e)) * 16; float al = 0.f;
#pragma unroll
                            for (int t = 0; t < 16; ++t) al += ap[t];
                            y[e] = SC * (zv[e] + al); } }
                    *(u32x4*)(Yb + ((size_t)b * 2048 + dest) * 1024 + col0 + bj * 128) = bf8_pack(y); } }
    }
};
struct EpiSwiGLU {
    static constexpr bool FUSED = false;
    bf16_t* Ud;
    DEVINL void operator()(const AccT& acc, const Unit& u, int wr, int wc, int fr, int fq) const {
        const int col0 = u.pn * 128 + wc * 32 + 8 * fq;
#pragma unroll
        for (int ai = 0; ai < 2; ++ai)
#pragma unroll
            for (int m = 0; m < 4; ++m) { const int t = u.pm * 256 + ai * 128 + wr * 64 + m * 16 + fr; float r[8];
#pragma unroll
                for (int n = 0; n < 2; ++n)
#pragma unroll
                    for (int j = 0; j < 4; ++j) { const float a = acc[ai][0][m][n][j], b = acc[ai][1][m][n][j]; r[n * 4 + j] = a * sigmoidf_(a) * b; }
                u32x4 w; w.x = cvtpk(r[0], r[1]); w.y = cvtpk(r[2], r[3]); w.z = cvtpk(r[4], r[5]); w.w = cvtpk(r[6], r[7]); *(u32x4*)(Ud + (size_t)t * DFF + col0) = w; }
    }
};

template <class Epi, class Sched>
DEVINL void gemm_phase(LAS unsigned char* lds, const GemmK g, const Sched& S, const Epi& E) {
    const int tid = opaque_tid(), wid = __builtin_amdgcn_readfirstlane(tid >> 6), lane = tid & 63, wr = wid >> 2, wc = wid & 3, fr = lane & 15, fq = lane >> 4;
    const int nt = g.K / BK;
    unsigned voffA[2], voffB[2];
#pragma unroll
    for (int i = 0; i < 2; ++i) { int R, C; stage_rc(tid * 16 + i * 8192, R, C); const int Rb = (R & ~31) + perm32(R & 31);
        voffA[i] = (unsigned)(R * g.lda + C) * 2u; voffB[i] = (unsigned)(Rb * g.ldb + C) * 2u; }
    const size_t kstep = (size_t)(BK * 2);
    const size_t hstepA = (size_t)HALF * g.lda * 2, hstepB = (size_t)HALF * g.ldb * 2;
    const unsigned ldsw = (unsigned)wid * 1024u;
    const int aoff = lds_byte(wr * 64 + fr, fq * 8), boff = lds_byte(wc * 32 + fr, fq * 8);
#define PG8_SA(b, h) (((b) * 2 + (h)) * HTB)
#define PG8_SB(b, h) ((4 + (b) * 2 + (h)) * HTB)
#define PG8_STAGE(bufoff, gbase, voff) do { _Pragma("unroll") for (int _i = 0; _i < 2; ++_i) \
        __builtin_amdgcn_global_load_lds((const unsigned*)((const char*)(gbase) + (voff)[_i]), (LAS unsigned*)(lds + (bufoff) + ldsw + _i * 8192), 16, 0, 0); } while (0)
#define PG8_LDA(dst, b, h) do { _Pragma("unroll") for (int m = 0; m < 4; ++m) _Pragma("unroll") for (int k = 0; k < 2; ++k) dst[m][k] = *(const LAS bf16x8*)(lds + PG8_SA(b, h) + aoff + m * 2048 + k * 1024); } while (0)
#define PG8_LDB(dst, b, h) do { _Pragma("unroll") for (int n = 0; n < 2; ++n) _Pragma("unroll") for (int k = 0; k < 2; ++k) dst[n][k] = *(const LAS bf16x8*)(lds + PG8_SB(b, h) + boff + n * 2048 + k * 1024); } while (0)
#define PG8_MMA(ai, bj, At, Bt) do { __builtin_amdgcn_s_setprio(1); _Pragma("unroll") for (int m = 0; m < 4; ++m) _Pragma("unroll") for (int n = 0; n < 2; ++n) _Pragma("unroll") for (int k = 0; k < 2; ++k) \
        acc[ai][bj][m][n] = __builtin_amdgcn_mfma_f32_16x16x32_bf16(Bt[n][k], At[m][k], acc[ai][bj][m][n], 0, 0, 0); __builtin_amdgcn_s_setprio(0); } while (0)
#define PG8_WAIT_V(n) asm volatile("s_waitcnt vmcnt(" #n ")" ::: "memory")
#define PG8_WAIT_L(n) asm volatile("s_waitcnt lgkmcnt(" #n ")" ::: "memory")
#define PG8_BAR __builtin_amdgcn_s_barrier()
#define PG8_SCHED __builtin_amdgcn_sched_barrier(0)
    Unit cur, nxt; int ui = 0;
    if (!S.next(0, cur)) return;
    f32x4 acc[2][2][4][2];
#pragma unroll
    for (int a = 0; a < 2; ++a)
#pragma unroll
        for (int b = 0; b < 2; ++b)
#pragma unroll
            for (int m = 0; m < 4; ++m)
#pragma unroll
                for (int n = 0; n < 2; ++n) acc[a][b][m][n] = (f32x4){0.f, 0.f, 0.f, 0.f};
    bf16x8 At[4][2], B0[2][2], B1[2][2];
    const char* cA = cur.a; const char* cB = cur.b;
    PG8_STAGE(PG8_SB(0, 0), cB, voffB); PG8_STAGE(PG8_SB(0, 1), cB + hstepB, voffB); PG8_STAGE(PG8_SA(0, 0), cA, voffA); PG8_STAGE(PG8_SA(0, 1), cA + hstepA, voffA);
    if (wr == 1) PG8_BAR;
    PG8_WAIT_V(2); PG8_BAR;
    PG8_STAGE(PG8_SB(1, 0), cB + kstep, voffB); PG8_STAGE(PG8_SA(1, 0), cA + kstep, voffA); PG8_STAGE(PG8_SB(1, 1), cB + hstepB + kstep, voffB);
    PG8_WAIT_V(6); PG8_BAR;
    for (;;) {
        const bool has_next = S.next(ui + 1, nxt);
        const char* nA = has_next ? nxt.a : cA; const char* nB = has_next ? nxt.b : cB;
        for (int t = 0; t < nt; t += 2) {
            const bool last = (t == nt - 2);
            const char* a1 = cA + (size_t)(t + 1) * kstep;
            const char* a2 = last ? nA : cA + (size_t)(t + 2) * kstep; const char* b2 = last ? nB : cB + (size_t)(t + 2) * kstep;
            const char* a3 = a2 + kstep; const char* b3 = b2 + kstep;
            PG8_LDB(B0, 0, 0); PG8_LDB(B1, 0, 1); PG8_SCHED; PG8_LDA(At, 0, 0); PG8_STAGE(PG8_SA(1, 1), a1 + hstepA, voffA);
            PG8_WAIT_V(8); PG8_WAIT_L(0); PG8_BAR; PG8_MMA(0, 0, At, B0); PG8_MMA(0, 1, At, B1); PG8_BAR; PG8_SCHED;
            PG8_LDA(At, 0, 1); PG8_STAGE(PG8_SB(0, 0), b2, voffB); PG8_STAGE(PG8_SB(0, 1), b2 + hstepB, voffB); PG8_STAGE(PG8_SA(0, 0), a2, voffA);
            PG8_WAIT_V(8); PG8_WAIT_L(0); PG8_BAR; PG8_MMA(1, 0, At, B0); PG8_MMA(1, 1, At, B1); PG8_BAR; PG8_SCHED;
            PG8_LDB(B0, 1, 0); PG8_LDB(B1, 1, 1); PG8_SCHED; PG8_LDA(At, 1, 0); PG8_STAGE(PG8_SA(0, 1), a2 + hstepA, voffA);
            PG8_WAIT_V(8); PG8_WAIT_L(0); PG8_BAR; PG8_MMA(0, 0, At, B0); PG8_MMA(0, 1, At, B1); PG8_BAR; PG8_SCHED;
            PG8_LDA(At, 1, 1); PG8_STAGE(PG8_SB(1, 0), b3, voffB); PG8_STAGE(PG8_SB(1, 1), b3 + hstepB, voffB); PG8_STAGE(PG8_SA(1, 0), a3, voffA);
            PG8_WAIT_V(8); PG8_WAIT_L(0); PG8_BAR; PG8_MMA(1, 0, At, B0); PG8_MMA(1, 1, At, B1); PG8_BAR; PG8_SCHED;
        }
        if (wr == 0) PG8_BAR;
        { int fr2 = fr, fq2 = fq; asm volatile("" : "+v"(fr2), "+v"(fq2));
          if constexpr (Epi::FUSED) E(acc, cur, wr, wc, fr2, fq2, lds, wid, lane); else E(acc, cur, wr, wc, fr2, fq2); }
        if (!has_next) break;
#pragma unroll
        for (int a = 0; a < 2; ++a)
#pragma unroll
            for (int b = 0; b < 2; ++b)
#pragma unroll
                for (int m = 0; m < 4; ++m)
#pragma unroll
                    for (int n = 0; n < 2; ++n) acc[a][b][m][n] = (f32x4){0.f, 0.f, 0.f, 0.f};
        cur = nxt; cA = nA; cB = nB; ++ui;
        if (wr == 1) PG8_BAR;
    }
    PG8_WAIT_V(0);
    PG8_BAR;
#undef PG8_SA
#undef PG8_SB
#undef PG8_STAGE
#undef PG8_LDA
#undef PG8_LDB
#undef PG8_MMA
#undef PG8_WAIT_V
#undef PG8_WAIT_L
#undef PG8_BAR
#undef PG8_SCHED
}

DEVINL void transpose_item(const float* W, int ldw, bf16_t* WT, int ldt, LAS float* scr, int lane) {
    float tv[32];
    unsigned voff = (unsigned)(lane >> 5) * (unsigned)ldw + (unsigned)(lane & 31); asm volatile("" : "+v"(voff));
#pragma unroll
    for (int i = 0; i < 32; ++i) tv[i] = (W + (size_t)(2 * i) * ldw)[voff];
#pragma unroll
    for (int i = 0; i < 32; ++i) { const int kk = 2 * i + (lane >> 5); scr[kk * 33 + (lane & 31)] = tv[i]; }
    LDS_WAIT();
    const int c = lane & 7;
#pragma unroll
    for (int j = 0; j < 4; ++j) { const int n = (lane >> 3) + 8 * j; const LAS float* s = scr + (8 * c) * 33 + n;
        u32x4 o; o.x = cvtpk(s[0 * 33], s[1 * 33]); o.y = cvtpk(s[2 * 33], s[3 * 33]); o.z = cvtpk(s[4 * 33], s[5 * 33]); o.w = cvtpk(s[6 * 33], s[7 * 33]);
        *(u32x4*)(WT + (size_t)n * ldt + 8 * c) = o; }
    LDS_WAIT();
}

DEVINL void phase_convert(LAS unsigned char* lds, int l, int nskip, int mask) {
    PP q = get_params();
    const int tid = opaque_tid(), lane = tid & 63, wave = __builtin_amdgcn_readfirstlane(tid >> 6), G = gridDim.x, blk = blockIdx.x;
    unsigned char* ws = q->ws;
    const float* w_in = q->in[6] + (size_t)l * 1024 * 6144;
    LAS float* scr = (LAS float*)(lds + wave * 8448);
    if (nskip >= G) nskip = 0;
    if (blk < nskip) return;
    const int gw = (blk - nskip) * 8 + wave, NGW = (G - nskip) * 8;
    constexpr int N_RG = 1024, N_QK = 1024, N_V = 512, N_G = 1536, N_M = 1536, N_O = 512, N_1 = 1408, N_3 = 1408, N_2 = 1408, N_R = 256;
    constexpr int NIT = N_RG + N_QK + N_V + N_G + N_M + N_O + N_1 + N_3 + N_2 + N_R;
    for (int it = gw; it < NIT; it += NGW) {
        int r = it;
        { const int grp = it < 5632 ? 1 : it < 6144 ? 2 : it < 8960 ? 4 : it < 10368 ? 8 : 1; if (!(mask & grp)) continue; }
        if (r < N_RG) { const int kb = r >> 6, nb = r & 63; transpose_item(w_in + (size_t)kb * 64 * 6144 + nb * 32, 6144, (bf16_t*)(ws + W_RG) + (size_t)nb * 32 * 1024 + kb * 64, 1024, scr, lane); continue; } r -= N_RG;
        if (r < N_QK) { const int kb = r >> 6, nb = r & 63; const int isk = nb >> 5, cc = (nb & 31) * 32, hh = cc >> 7, c = (cc >> 6) & 1, half = (cc >> 5) & 1;
            const int drow = (isk * 4 + (hh >> 1)) * 256 + half * 128 + (hh & 1) * 64 + c * 32;
            transpose_item(w_in + (size_t)kb * 64 * 6144 + 3072 + nb * 32, 6144, (bf16_t*)(ws + W_QK) + (size_t)drow * 1024 + kb * 64, 1024, scr, lane); continue; } r -= N_QK;
        if (r < N_V) { const int kb = r >> 5, nb = r & 31; transpose_item(w_in + (size_t)kb * 64 * 6144 + 5120 + nb * 32, 6144, (bf16_t*)(ws + W_V) + (size_t)nb * 32 * 1024 + kb * 64, 1024, scr, lane); continue; } r -= N_V;
        if (r < N_G) { const int kb = r / 96, nb = r % 96; transpose_item(q->in[16] + (size_t)l * 1024 * 3072 + (size_t)kb * 64 * 3072 + nb * 32, 3072, (bf16_t*)(ws + W_G) + (size_t)nb * 32 * 1024 + kb * 64, 1024, scr, lane); continue; } r -= N_G;
        if (r < N_M) { const int i = r / 512, rr = r % 512, kb = rr >> 5, nb = rr & 31;
            transpose_item(q->in[15] + (size_t)l * 3072 * 1024 + ((size_t)i * 1024 + kb * 64) * 1024 + nb * 32, 1024, (bf16_t*)(ws + W_M) + ((size_t)i * 1024 + nb * 32) * 1024 + kb * 64, 1024, scr, lane); continue; } r -= N_M;
        if (r < N_O) { const int kb = r >> 5, nb = r & 31; transpose_item(q->in[18] + (size_t)l * 1024 * 1024 + (size_t)kb * 64 * 1024 + nb * 32, 1024, (bf16_t*)(ws + W_O) + (size_t)nb * 32 * 1024 + kb * 64, 1024, scr, lane); continue; } r -= N_O;
        if (r < N_1 + N_3) { const int w3 = r >= N_1; if (w3) r -= N_1; const int kb = r / 88, nb = r % 88; const float* src = (w3 ? q->in[20] : q->in[19]) + (size_t)l * 1024 * DFF + (size_t)kb * 64 * DFF + nb * 32;
            const int drow = (nb >> 2) * 256 + w3 * 128 + (nb & 3) * 32;
            transpose_item(src, DFF, (bf16_t*)(ws + W_13) + (size_t)drow * 1024 + kb * 64, 1024, scr, lane); continue; } r -= N_1 + N_3;
        if (r < N_2) { const int kb = r >> 5, nb = r & 31; transpose_item(q->in[21] + (size_t)l * DFF * 1024 + (size_t)kb * 64 * 1024 + nb * 32, 1024, (bf16_t*)(ws + W_2) + (size_t)nb * 32 * DFF + kb * 64, DFF, scr, lane); continue; } r -= N_2;
        {
            const int mat = r >> 3, sub = r & 7, kb = sub >> 2, nb = sub & 3; const int dir = mat >> 4, ri = (mat >> 3) & 1, g = mat & 7;
            const float* src = (ri ? q->in[11] : q->in[9]) + ((size_t)((l * 2 + dir) * 8 + g)) * 16384 + (size_t)kb * 64 * 128 + nb * 32;
            transpose_item(src, 128, (bf16_t*)(ws + W_RNN) + ((size_t)((dir * 2 + ri) * 8 + g)) * 16384 + (size_t)nb * 32 * 128 + kb * 64, 128, scr, lane);
        }
    }
    __syncthreads();
    LAS float* wt = (LAS float*)lds; LAS f32x2* ct = (LAS f32x2*)(wt + 128 * 33);
    for (int it = (mask & 16) ? blk - nskip : 256; it < 256; it += G - nskip) {
        const int g = it >> 5, k0 = (it & 31) * 32;
        __syncthreads();
#pragma unroll
        for (int i = 0; i < 8; ++i) { const int e = tid + 512 * i, kk = e >> 7, c = e & 127; wt[c * 33 + kk] = w_in[(size_t)(k0 + kk) * 6144 + 2048 + g * 128 + c]; }
        if (tid < 128) ct[tid] = (f32x2){cospif((float)tid * (1.f / 64.f)), sinpif((float)tid * (1.f / 64.f))};
        __syncthreads();
        const int kl = tid & 31, mg = tid >> 5;
        float ac[8], as[8];
#pragma unroll
        for (int i = 0; i < 8; ++i) { ac[i] = 0.f; as[i] = 0.f; }
#pragma unroll 4
        for (int c = 0; c < 128; ++c) { const float w = wt[c * 33 + kl];
#pragma unroll
            for (int mi = 0; mi < 8; ++mi) { const f32x2 cs = ct[((mg * 8 + mi) * c) & 127]; ac[mi] += w * cs.x; as[mi] += w * cs.y; } }
        bf16_t* wz = (bf16_t*)(ws + W_Z);
#pragma unroll
        for (int mi = 0; mi < 8; ++mi) { const int m = mg * 8 + mi; const unsigned pc = cvtpk(ac[mi] * 0.08838834764831845f, as[mi] * 0.08838834764831845f);
            wz[(size_t)(g * 128 + m) * 1024 + k0 + kl] = (bf16_t)(pc & 0xffffu); wz[(size_t)(1024 + g * 128 + m) * 1024 + k0 + kl] = (bf16_t)(pc >> 16); }
    }
    __syncthreads();
}

DEVINL void phase_init(LAS unsigned char* lds) {
    PP q = get_params();
    const int tid = opaque_tid(), G = gridDim.x, blk = blockIdx.x;
    const size_t gtid = (size_t)blk * 512 + tid, gsz = (size_t)G * 512;
    unsigned char* ws = q->ws;
    { float* cT = (float*)(ws + WS_COS); float* sT = (float*)(ws + WS_SIN);
      for (size_t i = gtid; i < 65536; i += gsz) { const int pos = (int)i >> 5, jj = (int)i & 31, f = jj & 15; const float inv = powf(10000.f, -(float)f * (1.f / 16.f));
          const float crd = (jj < 16) ? (float)(pos >> 6) : (float)(pos & 63); const float ang = crd * inv; cT[i] = cosf(ang); sT[i] = sinf(ang); } }
    { bf16_t* T = (bf16_t*)(ws + WS_T);
      for (size_t i = gtid; i < (size_t)2 * 1024 * 1024 / 2; i += gsz) { const int part = (int)(i >> 19), k = (int)(i >> 9) & 1023, col = ((int)i & 511) * 2; float v[2];
#pragma unroll
          for (int e = 0; e < 2; ++e) { const int n = col + e, m = (k * n) & 2047; const float x = (float)m * (1.f / 1024.f); v[e] = (part ? sinpif(x) : cospif(x)) * 0.022097086912079608f; }
          ((unsigned*)T)[i] = cvtpk(v[0], v[1]); } }
    { bf16_t* T = (bf16_t*)(ws + WS_TC);
      for (size_t i = gtid; i < (size_t)256 * 512 / 2; i += gsz) { const int k = (int)(i >> 8), col = ((int)i & 255) * 2; float v[2];
#pragma unroll
          for (int e = 0; e < 2; ++e) { const int cc = col + e, n = cc & 255, m = (k * n) & 255; const float x = (float)m * (1.f / 128.f); v[e] = (cc < 256 ? cospif(x) : -sinpif(x)) * 0.0625f; }
          ((unsigned*)T)[i] = cvtpk(v[0], v[1]); } }
    LAS float* sc = (LAS float*)lds; float* part = (float*)(ws + WS_S0);
    for (int item = blk; item < 384; item += G) {
        const int l = item / 192, rem = item % 192, kc = rem / 24, nb = rem % 24;
        __syncthreads();
        for (int e = tid; e < 9 * 128; e += 512) { const int r = e >> 7, kk = e & 127; const float c = (r < 8) ? q->in[1][r * 1024 + kc * 128 + kk] : q->in[3][kc * 128 + kk]; sc[e] = c / (1.f + __expf(-c)); }
        __syncthreads();
        const int n = nb * 256 + (tid & 255), kh = tid >> 8; const float* w = q->in[4] + ((size_t)l * 1024 + kc * 128 + kh * 64) * NMOD + n;
        float acc[9];
#pragma unroll
        for (int r = 0; r < 9; ++r) acc[r] = 0.f;
#pragma unroll 4
        for (int kk = 0; kk < 64; ++kk) { const float wv = w[(size_t)kk * NMOD];
#pragma unroll
            for (int r = 0; r < 9; ++r) acc[r] += sc[r * 128 + kh * 64 + kk] * wv; }
#pragma unroll
        for (int r = 0; r < 9; ++r) part[((size_t)((kc * 2 + kh) * 2 + l) * 9 + r) * NMOD + n] = acc[r];
    }
}

DEVINL void phase_modreduce() {
    PP q = get_params();
    const size_t gtid = (size_t)blockIdx.x * 512 + opaque_tid(), gsz = (size_t)gridDim.x * 512;
    const float* part = (const float*)(q->ws + WS_S0); float* mod = (float*)(q->ws + WS_MOD);
    for (size_t i = gtid; i < 2 * 9 * NMOD; i += gsz) { const int l = (int)(i / (9 * NMOD)), n = (int)(i % NMOD); float s = q->in[5][l * NMOD + n];
#pragma unroll
        for (int j = 0; j < 16; ++j) s += part[(size_t)j * 2 * 9 * NMOD + i];
        mod[i] = s; }
}

DEVINL void phase_modulate(int l, int shoff, int scoff, int ntok, bool from_input) {
    PP q = get_params(); const float* modl = (const float*)(q->ws + WS_MOD) + (size_t)l * 9 * NMOD; bf16_t* H = (bf16_t*)(q->ws + WS_S0);
    const int tid = opaque_tid(), lane = tid & 63, wave = tid >> 6; const int gw = blockIdx.x * 8 + wave, NGW = gridDim.x * 8;
    const float* Xlat = from_input ? q->in[0] : q->out; const float* Xctx = from_input ? q->in[2] : (const float*)(q->ws + WS_XCTX);
    for (int tb = gw; tb < ntok; tb += 3 * NGW) {
        f32x4 v[3][4]; float ss[3];
#pragma unroll
        for (int u = 0; u < 3; ++u) { const int t = tb + u * NGW; ss[u] = 0.f;
            if (t < ntok) { const float* xr = t < TL ? Xlat + (size_t)t * 1024 : Xctx + (size_t)(t - TL) * 1024;
#pragma unroll
                for (int j = 0; j < 4; ++j) v[u][j] = ((const f32x4*)xr)[lane + 64 * j]; } }
#pragma unroll
        for (int u = 0; u < 3; ++u) { const int t = tb + u * NGW;
            if (t < ntok) {
#pragma unroll
                for (int j = 0; j < 4; ++j) ss[u] += v[u][j].x * v[u][j].x + v[u][j].y * v[u][j].y + v[u][j].z * v[u][j].z + v[u][j].w * v[u][j].w;
                const float rinv = rsqrtf(wave_sum(ss[u], lane) * (1.f / 1024.f) + EPS); const int r = t < TL ? (t >> 11) : 8;
                u32x2* o = (u32x2*)(H + (size_t)t * 1024);
#pragma unroll
                for (int j = 0; j < 4; ++j) { const int col = (lane + 64 * j) * 4; const f32x4 sc = *(const f32x4*)(modl + r * NMOD + scoff + col), sh = *(const f32x4*)(modl + r * NMOD + shoff + col);
                    const f32x4 y = v[u][j] * rinv * (sc + 1.f) + sh; u32x2 w; w.x = cvtpk(y.x, y.y); w.y = cvtpk(y.z, y.w); o[lane + 64 * j] = w; } } }
    }
}

DEVINL void phase_final() {
    PP q = get_params();
    const int tid = opaque_tid(), lane = tid & 63, wave = tid >> 6; const int gw = blockIdx.x * 8 + wave, NGW = gridDim.x * 8;
    f32x4 g[4];
#pragma unroll
    for (int j = 0; j < 4; ++j) g[j] = ((const f32x4*)q->in[22])[lane + 64 * j];
    for (int tb = gw; tb < TL; tb += 4 * NGW) {
        f32x4 v[4][4]; float ss[4];
#pragma unroll
        for (int u = 0; u < 4; ++u) { const int t = tb + u * NGW; ss[u] = 0.f;
            if (t < TL) {
#pragma unroll
                for (int j = 0; j < 4; ++j) v[u][j] = ((const f32x4*)(q->out + (size_t)t * 1024))[lane + 64 * j]; } }
#pragma unroll
        for (int u = 0; u < 4; ++u) { const int t = tb + u * NGW;
            if (t < TL) {
#pragma unroll
                for (int j = 0; j < 4; ++j) ss[u] += v[u][j].x * v[u][j].x + v[u][j].y * v[u][j].y + v[u][j].z * v[u][j].z + v[u][j].w * v[u][j].w;
                const float rinv = rsqrtf(wave_sum(ss[u], lane) * (1.f / 1024.f) + EPS);
#pragma unroll
                for (int j = 0; j < 4; ++j) ((f32x4*)(q->out + (size_t)t * 1024))[lane + 64 * j] = v[u][j] * rinv * g[j]; } }
    }
}

constexpr size_t WS_ZTCTX = WS_T + 4 * MiB, WS_ZH = WS_T + 12 * MiB, WS_ALT = WS_ZH + 64 * 1024;
DEVINL void phase_sym() {
    PP q = get_params(); const bf16_t* H = (const bf16_t*)(q->ws + WS_S0); bf16_t* HP = (bf16_t*)(q->ws + WS_S2); bf16_t* HM = (bf16_t*)(q->ws + WS_S2 + 16 * MiB);
    const bf16_t* WZ = (const bf16_t*)(q->ws + W_Z); float* zh = (float*)(q->ws + WS_ZH);
    const int tid = opaque_tid(), lane = tid & 63, wave = tid >> 6; const int gw = blockIdx.x * 8 + wave, NGW = gridDim.x * 8;
    for (int rb = gw; rb < 8192; rb += 2 * NGW) {
        u32x4 xa[2][2], xb[2][2];
#pragma unroll
        for (int u = 0; u < 2; ++u) { const int r = rb + u * NGW; if (r < 8192) { const int b = r >> 10, n = r & 1023;
            const u32x4* h1 = (const u32x4*)(H + ((size_t)b * 2048 + n) * 1024); const u32x4* h2 = (const u32x4*)(H + ((size_t)b * 2048 + ((2048 - n) & 2047)) * 1024);
            xa[u][0] = h1[lane]; xa[u][1] = h1[lane + 64]; xb[u][0] = h2[lane]; xb[u][1] = h2[lane + 64]; } }
#pragma unroll
        for (int u = 0; u < 2; ++u) { const int r = rb + u * NGW; if (r < 8192) { const int n = r & 1023;
#pragma unroll
            for (int jj = 0; jj < 2; ++jj) { float x[8], y[8], pp[8], mm[8]; bf8_unpack(xa[u][jj], x); bf8_unpack(xb[u][jj], y);
#pragma unroll
                for (int e = 0; e < 8; ++e) { pp[e] = n ? x[e] + y[e] : x[e]; mm[e] = n ? x[e] - y[e] : 0.f; }
                ((u32x4*)(HP + (size_t)r * 1024))[lane + 64 * jj] = bf8_pack(pp); ((u32x4*)(HM + (size_t)r * 1024))[lane + 64 * jj] = bf8_pack(mm); } } }
    }
    for (int rb = gw; rb < 8192; rb += 2 * NGW) {
        u32x4 wv[2][2], hv[2][2];
#pragma unroll
        for (int u = 0; u < 2; ++u) { const int r = rb + u * NGW; if (r < 8192) { const int b = r >> 10, j = r & 1023; const u32x4* w = (const u32x4*)(WZ + (size_t)j * 1024); const u32x4* h = (const u32x4*)(H + ((size_t)b * 2048 + 1024) * 1024);
            wv[u][0] = w[lane]; wv[u][1] = w[lane + 64]; hv[u][0] = h[lane]; hv[u][1] = h[lane + 64]; } }
#pragma unroll
        for (int u = 0; u < 2; ++u) { const int r = rb + u * NGW; if (r < 8192) { float a = 0.f;
#pragma unroll
            for (int jj = 0; jj < 2; ++jj) { float x[8], y[8]; bf8_unpack(wv[u][jj], x); bf8_unpack(hv[u][jj], y);
#pragma unroll
                for (int e = 0; e < 8; ++e) a += x[e] * y[e]; }
            a = wave_sum(a, lane); if (lane == 0) zh[r] = a; } }
    }
}
DEVINL void phase_alt() {
    PP q = get_params(); const bf16_t* ZTc = (const bf16_t*)(q->ws + WS_S1); float* alt = (float*)(q->ws + WS_ALT);
    const int tid = opaque_tid(), lane = tid & 63, wave = tid >> 6; const int gw = blockIdx.x * 8 + wave, NGW = gridDim.x * 8;
    for (int r = gw; r < 8192; r += NGW) { const u32x4* z = (const u32x4*)(ZTc + (size_t)r * 1024); float a = 0.f;
#pragma unroll
        for (int jj = 0; jj < 2; ++jj) { float x[8]; bf8_unpack(z[lane + 64 * jj], x); a += (x[0] - x[1]) + (x[2] - x[3]) + (x[4] - x[5]) + (x[6] - x[7]); }
        a = wave_sum(a, lane); if (lane == 0) alt[r] = a; }
}
DEVINL void phase_combine() {
    PP q = get_params(); const bf16_t* E = (const bf16_t*)(q->ws + WS_S3); const bf16_t* Od = (const bf16_t*)(q->ws + WS_S3 + 16 * MiB); bf16_t* Yb = (bf16_t*)(q->ws + WS_S2);
    const float* zh = (const float*)(q->ws + WS_ZH); const float* alt = (const float*)(q->ws + WS_ALT);
    const int tid = opaque_tid(), lane = tid & 63, wave = tid >> 6; const int gw = blockIdx.x * 8 + wave, NGW = gridDim.x * 8;
    constexpr float SC = 0.022097086912079608f;
    for (int r = gw; r < 8 * 1025; r += NGW) { const int b = r / 1025, kk = r % 1025;
#pragma unroll
        for (int jj = 0; jj < 2; ++jj) { const int j0 = (lane + 64 * jj) * 8; float z[8];
            { const f32x4 z0 = *(const f32x4*)(zh + b * 1024 + j0), z1 = *(const f32x4*)(zh + b * 1024 + j0 + 4); z[0] = z0.x; z[1] = z0.y; z[2] = z0.z; z[3] = z0.w; z[4] = z1.x; z[5] = z1.y; z[6] = z1.z; z[7] = z1.w; }
            if (kk == 1024) { float y[8]; const f32x4 a0 = *(const f32x4*)(alt + b * 1024 + j0), a1 = *(const f32x4*)(alt + b * 1024 + j0 + 4); const float av[8] = {a0.x, a0.y, a0.z, a0.w, a1.x, a1.y, a1.z, a1.w};
#pragma unroll
                for (int e = 0; e < 8; ++e) y[e] = SC * (z[e] + av[e]);
                *(u32x4*)(Yb + ((size_t)b * 2048 + 1024) * 1024 + j0) = bf8_pack(y); }
            else { float ev[8], ov[8], y1[8], y2[8]; bf8_unpack(*(const u32x4*)(E + ((size_t)b * 1024 + kk) * 1024 + j0), ev); bf8_unpack(*(const u32x4*)(Od + ((size_t)b * 1024 + kk) * 1024 + j0), ov);
                const float sg = (kk & 1) ? -SC : SC;
#pragma unroll
                for (int e = 0; e < 8; ++e) { const float base = ev[e] + sg * z[e]; y1[e] = base - ov[e]; y2[e] = base + ov[e]; }
                *(u32x4*)(Yb + ((size_t)b * 2048 + kk) * 1024 + j0) = bf8_pack(y1);
                if (kk) *(u32x4*)(Yb + ((size_t)b * 2048 + 2048 - kk) * 1024 + j0) = bf8_pack(y2); } }
    }
}

constexpr int NCHUNK = 576;
DEVINL void rnn_decode(int ck, int& t0, int& s0, int& s1) {
    if (ck < 512) { const int b = ck >> 6, cc = ck & 63; s0 = b * 2048; s1 = s0 + 2048; t0 = s0 + cc * 32; }
    else { const int b = (ck - 512) >> 3, cc = (ck - 512) & 7; s0 = TL + b * 256; s1 = s0 + 256; t0 = s0 + cc * 32; }
}
DEVINL void phase_rnn(LAS unsigned char* lds, int l, int pass, bool skip_ctx) {
    PP q = get_params();
    const bf16_t* XR = (const bf16_t*)(q->ws + WS_S1); const bf16_t* GR = (const bf16_t*)(q->ws + WS_S2); bf16_t* Ya = (bf16_t*)(q->ws + WS_S3); f32x2* totals = (f32x2*)(q->ws + WS_S3); const float* carry = (const float*)(q->ws + WS_S4);
    const int tid = opaque_tid(), lane = tid & 63, wave = __builtin_amdgcn_readfirstlane(tid >> 6), cl = lane & 15, fq = lane >> 4;
    const int G = gridDim.x, blk = blockIdx.x;
    LAS unsigned char* Us = lds;
    LAS f32x2* coef = (LAS f32x2*)(lds + 16384);
    const bf16_t* wrn = (const bf16_t*)(q->ws + W_RNN);
    const int per = (8 * NCHUNK + G - 1) / G;
    const int it0 = blk * per, it1 = (it0 + per) < 8 * NCHUNK ? (it0 + per) : 8 * NCHUNK;
    const int ctok = tid >> 4, ch8 = (tid & 15) * 8;
    const int mch = wave * 16 + cl;
    int gcur = -1; bf16x8 bfr[4][4]; f32x4 cw[4][2], cbv[2]; float brv[2], biv[2], lslv[2];
    u32x4 xr[4];
#define RNN_NEXT(it_) do { ++(it_); } while ((it_) < it1 && skip_ctx && ((it_) % NCHUNK) >= 512)
#define RNN_LOADX(it_) do { const int g_ = (it_) / NCHUNK, ck_ = (it_) % NCHUNK; int t0_, s0_, s1_; rnn_decode(ck_, t0_, s0_, s1_); \
        _Pragma("unroll") for (int k = 0; k < 4; ++k) { const int t_ = t0_ + ctok + k - 2; xr[k] = (u32x4){0u, 0u, 0u, 0u}; if (t_ >= s0_ && t_ < s1_) xr[k] = *(const u32x4*)(XR + (size_t)t_ * 1024 + g_ * 128 + ch8); } } while (0)
    int it = it0 - 1; RNN_NEXT(it);
    if (it < it1) RNN_LOADX(it);
    while (it < it1) {
        const int g = it / NCHUNK, ck = it % NCHUNK;
        int t0, s0, s1; rnn_decode(ck, t0, s0, s1);
        if (g != gcur) { gcur = g;
#pragma unroll
            for (int ty = 0; ty < 4; ++ty)
#pragma unroll
                for (int ks = 0; ks < 4; ++ks) bfr[ty][ks] = *(const bf16x8*)(wrn + ((size_t)(ty * 8 + g)) * 16384 + (size_t)mch * 128 + ks * 32 + fq * 8);
            const int gc = g * 128 + ch8; const float* cb = q->in[8] + l * 1024 + gc; cbv[0] = *(const f32x4*)cb; cbv[1] = *(const f32x4*)(cb + 4);
#pragma unroll
            for (int k = 0; k < 4; ++k) { const float* cwp = q->in[7] + (size_t)(l * 4 + k) * 1024 + gc; cw[k][0] = *(const f32x4*)cwp; cw[k][1] = *(const f32x4*)(cwp + 4); }
#pragma unroll
            for (int dir = 0; dir < 2; ++dir) { const int pi = (l * 2 + dir) * 1024 + g * 128 + mch; brv[dir] = q->in[10][pi]; biv[dir] = q->in[12][pi]; lslv[dir] = -8.f * log1pf(__expf(-q->in[13][pi])); } }
        { float u[8] = {cbv[0].x, cbv[0].y, cbv[0].z, cbv[0].w, cbv[1].x, cbv[1].y, cbv[1].z, cbv[1].w};
#pragma unroll
          for (int k = 0; k < 4; ++k) { const u32x4 x = xr[k]; const f32x4 w0 = cw[k][0], w1 = cw[k][1];
              u[0] += w0.x * bflo(x.x); u[1] += w0.y * bfhi(x.x); u[2] += w0.z * bflo(x.y); u[3] += w0.w * bfhi(x.y); u[4] += w1.x * bflo(x.z); u[5] += w1.y * bfhi(x.z); u[6] += w1.z * bflo(x.w); u[7] += w1.w * bfhi(x.w); }
          u32x4 w; w.x = cvtpk(u[0], u[1]); w.y = cvtpk(u[2], u[3]); w.z = cvtpk(u[4], u[5]); w.w = cvtpk(u[6], u[7]); *(LAS u32x4*)(Us + ctok * 272 + ch8 * 2) = w; }
        int itn = it; RNN_NEXT(itn);
        if (itn < it1) RNN_LOADX(itn);
        u32x4 grv = {0u, 0u, 0u, 0u};
        const size_t yoff = (size_t)(t0 + ctok) * 1024 + g * 128 + ch8;
        if (pass == 2) grv = *(const u32x4*)(GR + yoff);
        float hcar = 0.f;
        if (pass == 2 && tid < 256) hcar = carry[((size_t)(tid >> 7) * NCHUNK + ck) * 1024 + g * 128 + (tid & 127)];
        LDS_BARRIER();
        f32x4 acc[4][2];
#pragma unroll
        for (int ty = 0; ty < 4; ++ty) { acc[ty][0] = (f32x4){0.f, 0.f, 0.f, 0.f}; acc[ty][1] = (f32x4){0.f, 0.f, 0.f, 0.f}; }
#pragma unroll
        for (int ks = 0; ks < 4; ++ks) {
            const bf16x8 a0 = *(const LAS bf16x8*)(Us + cl * 272 + (ks * 32 + fq * 8) * 2), a1 = *(const LAS bf16x8*)(Us + (16 + cl) * 272 + (ks * 32 + fq * 8) * 2);
#pragma unroll
            for (int ty = 0; ty < 4; ++ty) { acc[ty][0] = __builtin_amdgcn_mfma_f32_16x16x32_bf16(a0, bfr[ty][ks], acc[ty][0], 0, 0, 0); acc[ty][1] = __builtin_amdgcn_mfma_f32_16x16x32_bf16(a1, bfr[ty][ks], acc[ty][1], 0, 0, 0); } }
        { const f32x2 br2 = {brv[0], brv[1]}, bi2 = {biv[0], biv[1]}, lsl2 = {lslv[0] * 1.4426950408889634f, lslv[1] * 1.4426950408889634f};
#pragma unroll
          for (int mt = 0; mt < 2; ++mt)
#pragma unroll
            for (int r = 0; r < 4; ++r) { const int tok = mt * 16 + fq * 4 + r; const float u = bf2f(*(const LAS bf16_t*)(Us + tok * 272 + mch * 2));
                const f32x2 tr = ((f32x2){acc[0][mt][r], acc[2][mt][r]} + br2) * -1.4426950408889634f, ti = ((f32x2){acc[1][mt][r], acc[3][mt][r]} + bi2) * -1.4426950408889634f;
                const f32x2 dr = (f32x2){__builtin_amdgcn_exp2f(tr.x), __builtin_amdgcn_exp2f(tr.y)} + 1.f, di = (f32x2){__builtin_amdgcn_exp2f(ti.x), __builtin_amdgcn_exp2f(ti.y)} + 1.f;
                const f32x2 rr = {__builtin_amdgcn_rcpf(dr.x), __builtin_amdgcn_rcpf(dr.y)}, ii = {__builtin_amdgcn_rcpf(di.x), __builtin_amdgcn_rcpf(di.y)};
                const f32x2 la2 = lsl2 * rr, a2 = la2 * 2.f;
                const f32x2 om = __builtin_elementwise_max((f32x2){1.f, 1.f} - (f32x2){__builtin_amdgcn_exp2f(a2.x), __builtin_amdgcn_exp2f(a2.y)}, (f32x2){0.f, 0.f});
                const f32x2 bb = (f32x2){__builtin_amdgcn_sqrtf(om.x), __builtin_amdgcn_sqrtf(om.y)} * ii * u;
                coef[(0 * 32 + tok) * 128 + mch] = (f32x2){la2.x, bb.x}; coef[(1 * 32 + tok) * 128 + mch] = (f32x2){la2.y, bb.y}; } }
        LDS_BARRIER();
        if (tid < 256) { const int dir = wave >> 1, ch = tid & 127; LAS f32x2* cp = coef + dir * 32 * 128 + ch; float h = hcar, P2 = 0.f;
            f32x2 cf[16];
            if (dir == 0) {
#pragma unroll
                for (int hf = 0; hf < 2; ++hf) {
#pragma unroll
                    for (int s = 0; s < 16; ++s) cf[s] = cp[(hf * 16 + s) * 128];
#pragma unroll
                    for (int s = 0; s < 16; ++s) { h = __builtin_amdgcn_exp2f(cf[s].x) * h + cf[s].y; P2 += cf[s].x; if (pass == 2) cp[(hf * 16 + s) * 128].y = h; } }
            } else {
#pragma unroll
                for (int hf = 0; hf < 2; ++hf) {
#pragma unroll
                    for (int s = 0; s < 16; ++s) cf[s] = cp[(31 - hf * 16 - s) * 128];
#pragma unroll
                    for (int s = 0; s < 16; ++s) { h = __builtin_amdgcn_exp2f(cf[s].x) * h + cf[s].y; P2 += cf[s].x; if (pass == 2) cp[(31 - hf * 16 - s) * 128].y = h; } }
            }
            if (pass == 1) totals[((size_t)dir * NCHUNK + ck) * 1024 + g * 128 + ch] = (f32x2){P2, h}; }
        if (pass == 2) {
            LDS_BARRIER();
            float y[8]; const float gv[8] = {bflo(grv.x), bfhi(grv.x), bflo(grv.y), bfhi(grv.y), bflo(grv.z), bfhi(grv.z), bflo(grv.w), bfhi(grv.w)};
#pragma unroll
            for (int e = 0; e < 8; ++e) { const float hs = coef[(0 * 32 + ctok) * 128 + ch8 + e].y + coef[(1 * 32 + ctok) * 128 + ch8 + e].y; y[e] = hs * gelu_tanh(gv[e]); }
            u32x4 w; w.x = cvtpk(y[0], y[1]); w.y = cvtpk(y[2], y[3]); w.z = cvtpk(y[4], y[5]); w.w = cvtpk(y[6], y[7]); *(u32x4*)(Ya + yoff) = w;
        }
        LDS_BARRIER();
        it = itn;
    }
#undef RNN_NEXT
#undef RNN_LOADX
}

DEVINL void phase_rnn_carry() {
    PP q = get_params(); const f32x2* totals = (const f32x2*)(q->ws + WS_S3); float* carry = (float*)(q->ws + WS_S4);
    const int gtid = blockIdx.x * 512 + opaque_tid();
    if (gtid >= NB * 2 * 1024) return;
    const int b = gtid >> 11, dir = (gtid >> 10) & 1, gc = gtid & 1023;
    float st = 0.f;
#pragma unroll 1
    for (int s8 = 0; s8 < 72; s8 += 8) { size_t idx[8]; f32x2 t[8];
#pragma unroll
        for (int j = 0; j < 8; ++j) { const int s = s8 + j; int ck; if (s < 8) { const int cc = dir ? 7 - s : s; ck = 512 + b * 8 + cc; } else { const int cc = dir ? 63 - (s - 8) : (s - 8); ck = b * 64 + cc; }
            idx[j] = ((size_t)dir * NCHUNK + ck) * 1024 + gc; t[j] = totals[idx[j]]; }
#pragma unroll
        for (int j = 0; j < 8; ++j) { carry[idx[j]] = st; st = __builtin_amdgcn_exp2f(t[j].x) * st + t[j].y; } }
}

DEVINL void phase_attn(LAS unsigned char* lds, int l, bool do_ctx) {
    PP q = get_params(); bf16_t* Q = (bf16_t*)(q->ws + WS_S1); const bf16_t* K = (const bf16_t*)(q->ws + WS_S2); const bf16_t* VT = (const bf16_t*)(q->ws + WS_S3);
    const int tid = opaque_tid(), lane = tid & 63, wave = __builtin_amdgcn_readfirstlane(tid >> 6), r32 = lane & 31, hi = lane >> 5;
    const int G = gridDim.x, blk = blockIdx.x;
    const float* lv = q->in[14] + l * 256;
    const float s1 = wave_sum(lv[lane] * lv[64 + lane], lane), s2 = wave_sum(lv[128 + lane] * lv[192 + lane], lane);
    const float lam_init = 0.8f - 0.6f * expf(-0.3f * (float)l); const float lam = expf(s1) - expf(s2) + lam_init;
    const int nit = 1024 + (do_ctx ? 128 : 0);
    const int c = wave >> 2, qs = wave & 3;
    const int kperm = (r32 & ~12) | ((r32 & 4) << 1) | ((r32 & 8) >> 1);
    constexpr int STG = 35840, VOFF = 17408;
    const int vb = (G & 7) ? blk : (blk & 7) * (G >> 3) + (blk >> 3);
    for (int item = vb; item < nit; item += G) {
        int b, h, q0, kt0;
        if (item < 1024) { b = item >> 7; h = (item >> 4) & 7; q0 = b * 2048 + (item & 15) * 128; kt0 = 0; }
        else { const int j = item - 1024; b = j >> 4; h = (j >> 1) & 7; q0 = TL + b * 256 + (j & 1) * 128; kt0 = 32; }
        const int tq = q0 + qs * 32 + r32;
        bf16x8 qf[4];
#pragma unroll
        for (int ks = 0; ks < 4; ++ks) qf[ks] = *(const bf16x8*)(Q + (size_t)tq * 1024 + h * 128 + c * 64 + ks * 16 + hi * 8);
        f32x16 O[4];
#pragma unroll
        for (int n = 0; n < 4; ++n)
#pragma unroll
            for (int i = 0; i < 16; ++i) O[n][i] = 0.f;
        float mrun = 0.f, lsum = 0.f;
        const int kkey = tid >> 3, kpart = tid & 7, vvd = tid >> 2, vpart = tid & 3;
        u32x4 kr0, kr1, vr0, vr1;
#define ATT_LOAD(kt) do { const int tk_ = ((kt) < 32 ? b * 2048 + (kt) * 64 : TL + b * 256 + ((kt) - 32) * 64) + kkey; const bf16_t* ks_ = K + (size_t)tk_ * 1024 + h * 128 + kpart * 16; \
            kr0 = *(const u32x4*)ks_; kr1 = *(const u32x4*)(ks_ + 8); const bf16_t* vs_ = VT + ((size_t)(b * 1024 + h * 128 + vvd)) * 2304 + (kt) * 64 + vpart * 16; vr0 = *(const u32x4*)vs_; vr1 = *(const u32x4*)(vs_ + 8); } while (0)
        constexpr int KST = 17408, VBASE = 2 * 17408, VST = 18432;
#define ATT_STORE(ks_, vs_) do { LAS unsigned char* kb_ = lds + (ks_) * KST + kkey * 272 + kpart * 32; *(LAS u32x4*)kb_ = kr0; *(LAS u32x4*)(kb_ + 16) = kr1; \
            LAS unsigned char* vb_ = lds + VBASE + (vs_) * VST + vvd * 144 + vpart * 32; *(LAS u32x4*)vb_ = vr0; *(LAS u32x4*)(vb_ + 16) = vr1; } while (0)
#define ATT_VLD(dst, Vb_, n_) do { _Pragma("unroll") for (int j = 0; j < 4; ++j) dst[j] = *(const LAS bf16x8*)((Vb_) + ((n_) * 32 + r32) * 144 + (j * 16 + hi * 8) * 2); } while (0)
#define ATT_PVM(src, P_, n_) do { _Pragma("unroll") for (int j = 0; j < 4; ++j) O[n_] = __builtin_amdgcn_mfma_f32_32x32x16_bf16(src[j], P_[j >> 1][j & 1], O[n_], 0, 0, 0); } while (0)
#define ATT_PV(Vb_, P_) do { ATT_VLD(fb, Vb_, 1); __builtin_amdgcn_sched_barrier(0); ATT_PVM(fa, P_, 0); ATT_VLD(fa, Vb_, 2); __builtin_amdgcn_sched_barrier(0); \
            ATT_PVM(fb, P_, 1); ATT_VLD(fb, Vb_, 3); __builtin_amdgcn_sched_barrier(0); ATT_PVM(fa, P_, 2); ATT_PVM(fb, P_, 3); } while (0)
        ATT_LOAD(kt0); ATT_STORE(0, 0);
        LDS_BARRIER();
        bf16x8 pp[2][2];
#pragma unroll
        for (int a_ = 0; a_ < 2; ++a_)
#pragma unroll
            for (int b_ = 0; b_ < 2; ++b_) pp[a_][b_] = (bf16x8){0, 0, 0, 0, 0, 0, 0, 0};
        int vcur = 0;
        for (int kt = kt0; kt < 36; ++kt) {
            const int cur = (kt - kt0) & 1; const int vprev = vcur == 0 ? 2 : vcur - 1, vnext = vcur == 2 ? 0 : vcur + 1;
            if (kt + 1 < 36) ATT_LOAD(kt + 1);
            const LAS unsigned char* Kb = lds + cur * KST; const LAS unsigned char* Vb = lds + VBASE + vcur * VST;
            bf16x8 fa[4], fb[4];
            if (c == 1 && kt > kt0) {
                const LAS unsigned char* Vp = lds + VBASE + vprev * VST;
                ATT_VLD(fa, Vp, 0); __builtin_amdgcn_sched_barrier(0); ATT_PV(Vp, pp);
            }
            f32x16 S0, S1;
#pragma unroll
            for (int i = 0; i < 16; ++i) { S0[i] = -mrun; S1[i] = -mrun; }
            bf16x8 kf[8];
#pragma unroll
            for (int ks = 0; ks < 4; ++ks) { kf[2 * ks] = *(const LAS bf16x8*)(Kb + kperm * 272 + (c * 64 + ks * 16 + hi * 8) * 2); kf[2 * ks + 1] = *(const LAS bf16x8*)(Kb + (32 + kperm) * 272 + (c * 64 + ks * 16 + hi * 8) * 2); }
            __builtin_amdgcn_sched_barrier(0);
#pragma unroll
            for (int ks = 0; ks < 4; ++ks) { S0 = __builtin_amdgcn_mfma_f32_32x32x16_bf16(kf[2 * ks], qf[ks], S0, 0, 0, 0); S1 = __builtin_amdgcn_mfma_f32_32x32x16_bf16(kf[2 * ks + 1], qf[ks], S1, 0, 0, 0); }
            if (c == 0) ATT_VLD(fa, Vb, 0);
            __builtin_amdgcn_sched_barrier(0);
            float mxa = max3f_(S0[0], S1[0], S0[1]), mxb = max3f_(S1[1], S0[2], S1[2]);
#pragma unroll
            for (int i = 3; i < 15; i += 2) { mxa = max3f_(mxa, S0[i], S1[i]); mxb = max3f_(mxb, S0[i + 1], S1[i + 1]); }
            float mx = max3f_(mxa, mxb, fmaxf(S0[15], S1[15]));
            mx = fmaxf(mx, shflx(mx, 32, lane));
            const float dlt = (fabsf(mx) > 8.f) ? mx : 0.f;
            if (__builtin_amdgcn_ballot_w64(dlt != 0.f) != 0ull) {
                const float alpha = __builtin_amdgcn_exp2f(-dlt); mrun += dlt; lsum *= alpha;
#pragma unroll
                for (int i = 0; i < 16; ++i) { S0[i] -= dlt; S1[i] -= dlt; }
#pragma unroll
                for (int n = 0; n < 4; ++n)
#pragma unroll
                    for (int i = 0; i < 16; ++i) O[n][i] *= alpha;
            }
            f32x2 ps2 = {0.f, 0.f};
#pragma unroll
            for (int i = 0; i < 16; i += 2) { S0[i] = __builtin_amdgcn_exp2f(S0[i]); S0[i + 1] = __builtin_amdgcn_exp2f(S0[i + 1]); S1[i] = __builtin_amdgcn_exp2f(S1[i]); S1[i + 1] = __builtin_amdgcn_exp2f(S1[i + 1]);
                ps2 += (f32x2){S0[i], S0[i + 1]} + (f32x2){S1[i], S1[i + 1]}; }
            lsum += ps2.x + ps2.y;
            bf16x8 pf[2][2];
#pragma unroll
            for (int s = 0; s < 2; ++s) { u32x4 w0, w1;
                w0.x = cvtpk(S0[8 * s + 0], S0[8 * s + 1]); w0.y = cvtpk(S0[8 * s + 2], S0[8 * s + 3]); w0.z = cvtpk(S0[8 * s + 4], S0[8 * s + 5]); w0.w = cvtpk(S0[8 * s + 6], S0[8 * s + 7]);
                w1.x = cvtpk(S1[8 * s + 0], S1[8 * s + 1]); w1.y = cvtpk(S1[8 * s + 2], S1[8 * s + 3]); w1.z = cvtpk(S1[8 * s + 4], S1[8 * s + 5]); w1.w = cvtpk(S1[8 * s + 6], S1[8 * s + 7]);
                pf[0][s] = __builtin_bit_cast(bf16x8, w0); pf[1][s] = __builtin_bit_cast(bf16x8, w1); }
            __builtin_amdgcn_sched_barrier(0);
            if (c == 0) { ATT_PV(Vb, pf); }
            else {
#pragma unroll
                for (int a_ = 0; a_ < 2; ++a_)
#pragma unroll
                    for (int b_ = 0; b_ < 2; ++b_) pp[a_][b_] = pf[a_][b_]; }
            if (kt + 1 < 36) ATT_STORE(cur ^ 1, vnext);
            LDS_BARRIER();
            vcur = vnext;
        }
        if (c == 1) { const LAS unsigned char* Vl = lds + VBASE + (vcur == 0 ? 2 : vcur - 1) * VST; bf16x8 fa[4], fb[4];
            ATT_VLD(fa, Vl, 0); __builtin_amdgcn_sched_barrier(0); ATT_PV(Vl, pp); }
        LDS_BARRIER();
#undef ATT_VLD
#undef ATT_PVM
#undef ATT_PV
#undef ATT_LOAD
#undef ATT_STORE
        lsum += shflx(lsum, 32, lane);
        const float inv = 1.f / lsum;
        LAS float* xb = (LAS float*)lds + qs * (32 * 132) + r32 * 132;
        if (c == 1) { const float f = inv * lam;
#pragma unroll
            for (int n = 0; n < 4; ++n)
#pragma unroll
                for (int gq = 0; gq < 4; ++gq) { const int vd = n * 32 + 8 * gq + 4 * hi; *(LAS f32x4*)(xb + vd) = (f32x4){O[n][4 * gq] * f, O[n][4 * gq + 1] * f, O[n][4 * gq + 2] * f, O[n][4 * gq + 3] * f}; } }
        LDS_BARRIER();
        if (c == 0) { float ss = 0.f;
#pragma unroll
            for (int n = 0; n < 4; ++n)
#pragma unroll
                for (int gq = 0; gq < 4; ++gq) { const int vd = n * 32 + 8 * gq + 4 * hi; const f32x4 o1 = *(const LAS f32x4*)(xb + vd);
#pragma unroll
                    for (int j = 0; j < 4; ++j) { const float o = O[n][4 * gq + j] * inv - o1[j]; O[n][4 * gq + j] = o; ss += o * o; } }
            ss += shflx(ss, 32, lane);
            const float rn = rsqrtf(ss * (1.f / 128.f) + EPS) * (1.f - lam_init);
            bf16_t* dst = Q + (size_t)tq * 1024 + h * 128;
#pragma unroll
            for (int n = 0; n < 4; ++n)
#pragma unroll
                for (int gq = 0; gq < 4; ++gq) { const int vd = n * 32 + 8 * gq + 4 * hi; u32x2 w; w.x = cvtpk(O[n][4 * gq] * rn, O[n][4 * gq + 1] * rn); w.y = cvtpk(O[n][4 * gq + 2] * rn, O[n][4 * gq + 3] * rn); *(u32x2*)(dst + vd) = w; } }
        LDS_BARRIER();
    }
}

#define XB_TMO      128
#define XB_XCNT(j)  (256  + 64 * (j))
#define XB_XSUB(j)  (1280 + 64 * (j))
#define XB_XGEN(j)  (2304 + 64 * (j))
#define XB_TOP      3328
#define XB_TOPGEN   3392
#define XCD_BAR_WORDS 3456
#define XB_SPIN_CAP (1u << 18)

__device__ __forceinline__ unsigned xb_ld(unsigned* p)              { return __hip_atomic_load(p, __ATOMIC_RELAXED, __HIP_MEMORY_SCOPE_AGENT); }
__device__ __forceinline__ unsigned xb_add(unsigned* p, unsigned v) { return __hip_atomic_fetch_add(p, v, __ATOMIC_RELAXED, __HIP_MEMORY_SCOPE_AGENT); }
__device__ __forceinline__ unsigned xb_xcc_id() { return (unsigned)__builtin_amdgcn_s_getreg((3 << 11) | 20) & 0xFu; }
#define XB_SPIN(cond, bar) do { unsigned _sp = 0; while (cond) { __builtin_amdgcn_s_sleep(1); \
    if ((++_sp & 255u) == 0u) { if (xb_ld(&(bar)[XB_TMO])) break; if (_sp > XB_SPIN_CAP) { atomicAdd(&(bar)[XB_TMO], 1u); break; } } } } while (0)

struct XcdBarrier {
    unsigned* bar; unsigned x;
    volatile LAS unsigned* st;
};

__device__ __forceinline__ XcdBarrier xcd_barrier_post(unsigned* bar, volatile LAS unsigned* st) {
    XcdBarrier b; b.bar = bar; b.x = xb_xcc_id(); b.st = st;
    if (opaque_tid() == 0) (void)xb_add(&bar[XB_XCNT(b.x)], 1u);
    return b;
}
__device__ __forceinline__ void xcd_barrier_complete(unsigned* bar, unsigned x, unsigned& nloc, unsigned& nx) {
    const unsigned G = gridDim.x * gridDim.y * gridDim.z;
    unsigned sum, cnt, mine, sp = 0u;
    for (;;) {
        sum = 0u; cnt = 0u; mine = 0u;
#pragma unroll
        for (unsigned j = 0; j < 16; ++j) { const unsigned c = xb_ld(&bar[XB_XCNT(j)]); sum += c; cnt += (c > 0u) ? 1u : 0u; mine = (j == x) ? c : mine; }
        if (sum == G) break;
        __builtin_amdgcn_s_sleep(1);
        if ((++sp & 255u) == 0u) { if (xb_ld(&bar[XB_TMO])) break; if (sp > XB_SPIN_CAP) { atomicAdd(&bar[XB_TMO], 1u); break; } }
    }
    nloc = mine > 0u ? mine : 1u; nx = cnt > 0u ? cnt : 1u;
}

__device__ __forceinline__ void xcd_barrier(const XcdBarrier& b) {
    asm volatile("s_waitcnt vmcnt(0)" ::: "memory");
    __syncthreads();
    if (opaque_tid() == 0) {
        unsigned* bar = (unsigned*)(get_params()->ws + WS_BAR);
        unsigned bx = xb_xcc_id(); asm volatile("" : "+s"(bx));
        __builtin_amdgcn_s_waitcnt(0);
        unsigned nloc = b.st[0], nx = b.st[1];
        if (nloc == 0u) { xcd_barrier_complete(bar, bx, nloc, nx); b.st[0] = nloc; b.st[1] = nx; }
        const unsigned old = xb_add(&bar[XB_XSUB(bx)], 1u);
        const unsigned gen = old / nloc;
        if (old + 1u == (gen + 1u) * nloc) {
            __builtin_amdgcn_fence(__ATOMIC_RELEASE, "agent");
            asm volatile("s_waitcnt vmcnt(0)" ::: "memory");
            const unsigned og = xb_add(&bar[XB_TOP], 1u);
            const unsigned tg = og / nx;
            if (og + 1u == (tg + 1u) * nx) xb_add(&bar[XB_TOPGEN], 1u);
            else XB_SPIN(xb_ld(&bar[XB_TOPGEN]) == tg, bar);
            __builtin_amdgcn_fence(__ATOMIC_ACQUIRE, "agent");
            xb_add(&bar[XB_XGEN(bx)], 1u);
            asm volatile("s_waitcnt vmcnt(0)" ::: "memory");
        } else {
            XB_SPIN(xb_ld(&bar[XB_XGEN(bx)]) == gen, bar);
            __builtin_amdgcn_fence(__ATOMIC_ACQUIRE, "agent");
            asm volatile("s_waitcnt vmcnt(0)" ::: "memory");
        }
    }
    __syncthreads();
}


__global__ void __launch_bounds__(512) mega_fwd(Params p_unused) {
    extern __shared__ __attribute__((aligned(16))) unsigned char lds_raw[];
    LAS unsigned char* lds = (LAS unsigned char*)lds_raw;
    cg::grid_group grid = cg::this_grid();
    volatile LAS unsigned* bst = (volatile LAS unsigned*)(lds + 131072);
    { const int t_ = opaque_tid(); if (t_ < 64) bst[t_] = 0u; }
    __syncthreads();
    XcdBarrier gbar;
    { PP q_ = get_params(); gbar = xcd_barrier_post((unsigned*)(q_->ws + WS_BAR), bst); }
#if PROBE
    int n_stamp = 0;
#define SYNC() do { xcd_barrier(gbar); if (opaque_blk() == 0 && opaque_tid() == 0) { PP q_ = get_params(); ((unsigned long long*)(q_->ws + 1280 * 1024))[n_stamp] = __builtin_amdgcn_s_memrealtime(); } ++n_stamp; } while (0)
#else
#define SYNC() xcd_barrier(gbar)
#endif
#define GSETUP PP q = get_params(); unsigned char* ws = q->ws; const int G = gridDim.x, blk = opaque_blk(); (void)ws; (void)G; (void)blk
#define SL(i) (ws + WS_S0 + (size_t)(i) * SLOT)

#if PROBE
    SYNC();
#endif
    phase_init(lds);
    __syncthreads();
    phase_convert(lds, 0, 0, 0x1F);
    grid.sync();
    phase_modreduce();
    SYNC();

#pragma unroll 1
    for (int l = 0; l < 2; ++l) {
        const bool last = (l == 1);
        const int nMt = last ? 64 : 72;
        if (l == 1) phase_convert(lds, 1, 0, 0x8);
        if (l == 0 || gridDim.x != 256) { phase_modulate(l, 0, 1024, TT, l == 0); SYNC(); }
        {
            GSETUP; SchedG S{1, (const char*)SL(0), (const char*)(ws + W_RG), (char*)SL(1), (char*)SL(2), 1024, 1024, 72, 8, G, blk};
            gemm_phase(lds, GemmK{1024, 1024, 1024}, S, EpiStore{});
        }
        SYNC();
        phase_rnn(lds, l, 1, false);
        SYNC();
        phase_rnn_carry();
        SYNC();
        phase_rnn(lds, l, 2, last);
        SYNC();
        phase_sym();
        {
            GSETUP; SchedG S{9, (const char*)SL(0), (const char*)(ws + W_G + 0 * MiB), (char*)SL(3), (char*)(ws + W_M + 0 * MiB), 1024, 1024, nMt, 4, G, blk, (G == 256 && !last) ? 1 : 0};
            gemm_phase(lds, GemmK{1024, 1024, 1024}, S, EpiGateMerge{(bf16_t*)SL(1), q->in[17] + l * 3072 + 0 * 1024, (bf16_t*)SL(4), 1, (unsigned*)(ws + WS_CNT + 20480) + 0 * 32 * 16});
        }
        if (!last) {
            GSETUP; const int ns = (G >= 128) ? 64 : 0; if (blk >= ns) { SchedG S{7, (const char*)(ws + W_Z), (const char*)SL(0), nullptr, (char*)(ws + WS_ZTCTX), 1024, 1024, 0, 0, G - ns, blk - ns};
                gemm_phase(lds, GemmK{1024, 1024, 1024}, S, EpiStore{}); }
        }
        SYNC();
        {
            GSETUP; SchedG S{6, (const char*)(ws + W_Z), (const char*)SL(2), (char*)SL(1), (char*)(ws + WS_ZTCTX), 1024, 1024, 0, 0, G, blk};
            gemm_phase(lds, GemmK{1024, 1024, 1024}, S, EpiStoreAlt{(float*)(ws + WS_ALT16)});
        }
        SYNC();
        if (gridDim.x != 256) phase_alt();
        {
            GSETUP; const int fuse = (G == 256) ? 1 : 0; SchedG S{8, (const char*)(ws + WS_T), (const char*)SL(1), (char*)SL(3), nullptr, 1024, 1024, 0, 0, G, blk};
            gemm_phase(lds, GemmK{1024, 1024, 1024}, S, EpiEO{(bf16_t*)SL(3), (bf16_t*)SL(2), (const float*)(ws + WS_ZH), (const float*)(ws + WS_ALT16), (unsigned*)(ws + WS_CNT + 28672) + (size_t)l * 128 * 16, fuse});
        }
        if (!last) { GSETUP; SchedG Sc{5, (const char*)(ws + WS_TC), (const char*)(ws + WS_ZTCTX), (char*)SL(2), nullptr, 512, 512, 0, 0, G, (blk + 128) % G};
            gemm_phase(lds, GemmK{512, 512, 512}, Sc, EpiStore{}); }
        SYNC();
        if (gridDim.x != 256) { phase_combine(); SYNC(); }
        {
            GSETUP; SchedG S{9, (const char*)SL(0), (const char*)(ws + W_G + 2 * MiB), (char*)SL(2), (char*)(ws + W_M + 2 * MiB), 1024, 1024, nMt, 4, G, blk, (G == 256 && !last) ? 1 : 0};
            gemm_phase(lds, GemmK{1024, 1024, 1024}, S, EpiGateMerge{(bf16_t*)SL(1), q->in[17] + l * 3072 + 1 * 1024, (bf16_t*)SL(4), 0, (unsigned*)(ws + WS_CNT + 20480) + 1 * 32 * 16});
        }
        SYNC();
        {
            GSETUP; SchedG S{0, (const char*)SL(0), (const char*)(ws + W_QK), nullptr, nullptr, 1024, 1024, 72, 8, G, blk};
            gemm_phase(lds, GemmK{1024, 1024, 1024}, S, EpiQK{(bf16_t*)SL(1), (bf16_t*)SL(2), (const float*)(ws + WS_COS), (const float*)(ws + WS_SIN)});
        }
        {
            GSETUP; SchedG Sv{3, (const char*)(ws + W_V), (const char*)SL(0), (char*)SL(3), nullptr, 1024, 1024, 4, 72, G, (G - 1) - blk};
            gemm_phase(lds, GemmK{1024, 1024, 1024}, Sv, EpiStore{});
        }
        SYNC();
        phase_attn(lds, l, !last);
        SYNC();
        {
            GSETUP; SchedG S{9, (const char*)SL(0), (const char*)(ws + W_G + 4 * MiB), (char*)SL(1), (char*)(ws + W_M + 4 * MiB), 1024, 1024, nMt, 4, G, blk, (G == 256 && !last) ? 1 : 0};
            gemm_phase(lds, GemmK{1024, 1024, 1024}, S, EpiGateMerge{(bf16_t*)SL(2), q->in[17] + l * 3072 + 2 * 1024, (bf16_t*)SL(4), 0, (unsigned*)(ws + WS_CNT + 20480) + 2 * 32 * 16});
        }
        SYNC();
        {
            GSETUP; const int fuse = (G == 256) ? 1 : 0; const float* modl_ = (const float*)(ws + WS_MOD) + (size_t)l * 9 * NMOD;
            SchedG S{fuse ? 10 : 0, (const char*)SL(4), (const char*)(ws + W_O), nullptr, nullptr, 1024, 1024, nMt, 4, G, blk};
            gemm_phase(lds, GemmK{1024, 1024, 1024}, S, EpiResidNorm{q->out, (float*)(ws + WS_XCTX), modl_ + 2048, l == 0 ? q->in[0] : (const float*)q->out, l == 0 ? q->in[2] : (const float*)(ws + WS_XCTX),
                fuse, (bf16_t*)SL(0), modl_, 3072, 4096, (float*)(ws + WS_XSTAT), (unsigned*)(ws + WS_CNT) + (size_t)(l * 2 + 0) * 72 * 16, nullptr});
        }
        if (!last) phase_convert(lds, 1, 32, 0x1);
        SYNC();
        if (gridDim.x != 256) { phase_modulate(l, 3072, 4096, last ? TL : TT, false); SYNC(); }
        {
            GSETUP; SchedG S{0, (const char*)SL(0), (const char*)(ws + W_13), nullptr, nullptr, 1024, 1024, nMt, 22, G, blk};
            gemm_phase(lds, GemmK{1024, 1024, 1024}, S, EpiSwiGLU{(bf16_t*)SL(1)});
        }
        if (!last) phase_convert(lds, 1, 48, 0x2);
        SYNC();
        {
            GSETUP; const int fuse = (G == 256) ? 1 : 0; const float* modl_ = (const float*)(ws + WS_MOD) + (size_t)l * 9 * NMOD; const float* modn_ = (const float*)(ws + WS_MOD) + (size_t)(last ? l : l + 1) * 9 * NMOD;
            SchedG S{fuse ? 10 : 0, (const char*)SL(1), (const char*)(ws + W_2), nullptr, nullptr, DFF, DFF, nMt, 4, G, blk};
            gemm_phase(lds, GemmK{DFF, DFF, DFF}, S, EpiResidNorm{q->out, (float*)(ws + WS_XCTX), modl_ + 5120, (const float*)q->out, (const float*)(ws + WS_XCTX),
                fuse, (bf16_t*)SL(0), modn_, 0, 1024, (float*)(ws + WS_XSTAT), (unsigned*)(ws + WS_CNT) + (size_t)(l * 2 + 1) * 72 * 16, last ? q->in[22] : nullptr});
        }
        if (!last) phase_convert(lds, 1, 32, 0x14);
        if (!last || gridDim.x != 256) SYNC();
    }
    if (gridDim.x != 256) phase_final();
#if PROBE
    grid.sync();
    if (opaque_blk() == 0 && opaque_tid() == 0) { PP q_ = get_params(); const unsigned long long* ts = (const unsigned long long*)(q_->ws + 1280 * 1024);
        float x1 = 0.f, x2 = 0.f;
        PROBE_EXPR
        ((float*)(q_->ws + 1280 * 1024))[1024] = x2; q_->out[0] += x1; }
    __syncthreads();
    if (opaque_blk() == 0) { PP q_ = get_params(); const float x2 = ((const float*)(q_->ws + 1280 * 1024))[1024] * 0.1f; for (int i = opaque_tid(); i < 65536; i += 512) q_->out[8000 * 1024 + i] += x2; }
#endif
}

extern "C" void kernel_launch(void* const* d_in, const int* in_sizes, int n_in, void* d_out, int out_size, void* d_ws, size_t ws_size, hipStream_t stream) {
    static int grid = 0;
    if (grid == 0) {
        int dev = 0, cus = 0, per_cu = 0;
        (void)hipGetDevice(&dev);
        (void)hipDeviceGetAttribute(&cus, hipDeviceAttributeMultiprocessorCount, dev);
        (void)hipFuncSetAttribute((const void*)mega_fwd, hipFuncAttributeMaxDynamicSharedMemorySize, LDS_BYTES);
        (void)hipOccupancyMaxActiveBlocksPerMultiprocessor(&per_cu, (const void*)mega_fwd, 512, LDS_BYTES);
        if (per_cu < 1) { fprintf(stderr, "kernel_launch: occupancy query says %d blocks per CU\n", per_cu); per_cu = 1; }
        if (per_cu > 1) per_cu = 1;
        grid = cus * per_cu;
        if (n_in != 23 || ws_size < 253 * MiB) fprintf(stderr, "kernel_launch: unexpected n_in %d / ws_size %zu\n", n_in, ws_size);
    }
    Params p{};
    for (int i = 0; i < 23; ++i) p.in[i] = (const float*)d_in[i];
    p.out = (float*)d_out; p.ws = (unsigned char*)d_ws;
    (void)hipMemsetAsync((unsigned char*)d_ws + WS_BAR, 0, 65536, stream);
    void* args[] = {&p};
    hipError_t e = hipLaunchCooperativeKernel((const void*)mega_fwd, dim3(grid), dim3(512), args, LDS_BYTES, stream);
    if (e != hipSuccess) fprintf(stderr, "cooperative launch failed: %s (grid %d)\n", hipGetErrorString(e), grid);
}
```
